# Optimizing an MI355X kernel written in HIP

```python
import math
import jax, jax.numpy as jnp
from jax import lax
import numpy as np

D_MODEL = 1024
BATCH = 8
SEQ = 2048
DEPTH = 2
DEC_BATCH = 128
DEC_SEQ = 8
PAST_LEN = 16384
PAGE_SIZE = 128

N_META = 16
D_MIX = D_MODEL
D_A = D_MIX // 2
D_B = D_MIX - D_A
H_A = 4
HD_A = D_A // H_A
H_B = 8
HD_B = D_B // H_B
CONV_A_W = 31
CONV_B_W = 4
RG_C = 8.0
D_FF = 2816
FFN_RES = 0.5
EPS = 1e-6

kernel_name = "hymba_conformer_hawk_macaron_step"


def rmsnorm(x, g):
    xf = x.astype(jnp.float32)
    y = xf * lax.rsqrt(jnp.mean(xf * xf, axis=-1, keepdims=True) + EPS) * g.astype(jnp.float32)
    return y.astype(x.dtype)


def swiglu(h, wg, wu, wd):
    return (jax.nn.silu(h @ wg) * (h @ wu)) @ wd


def causal_dwconv(u, buf, w, b):
    k = w.shape[0]
    c = u.shape[-1]
    full = jnp.concatenate([buf.astype(u.dtype), u], axis=1)
    y = lax.conv_general_dilated(full, w[:, None, :].astype(u.dtype), window_strides=(1,),
                                 padding='VALID', dimension_numbers=('NWC', 'WIO', 'NWC'),
                                 feature_group_count=c)
    return y + b.astype(u.dtype), full[:, full.shape[1] - (k - 1):]


def group_layernorm(x, g, b):
    bsz, t, _ = x.shape
    xf = x.astype(jnp.float32).reshape(bsz, t, H_A, HD_A)
    mu = jnp.mean(xf, axis=-1, keepdims=True)
    var = jnp.mean(jnp.square(xf - mu), axis=-1, keepdims=True)
    y = ((xf - mu) * lax.rsqrt(var + EPS)).reshape(bsz, t, D_A)
    return (y * g.astype(jnp.float32) + b.astype(jnp.float32)).astype(x.dtype)


def rglru(xb, h0, w_ra, b_ra, w_ix, b_ix, lam):
    bsz, t, _ = xb.shape
    xf = xb.astype(jnp.float32)
    xh = xf.reshape(bsz, t, H_B, HD_B)
    r = jax.nn.sigmoid(jnp.einsum('bthi,hij->bthj', xh, w_ra.astype(jnp.float32)).reshape(bsz, t, D_B)
                       + b_ra.astype(jnp.float32))
    i = jax.nn.sigmoid(jnp.einsum('bthi,hij->bthj', xh, w_ix.astype(jnp.float32)).reshape(bsz, t, D_B)
                       + b_ix.astype(jnp.float32))
    log_a = -RG_C * r * jax.nn.softplus(-lam.astype(jnp.float32))
    a = jnp.exp(log_a)
    bterm = jnp.sqrt(-jnp.expm1(2.0 * log_a)) * (i * xf)
    bterm = bterm.at[:, 0].add(a[:, 0] * h0.astype(jnp.float32))

    def combine(left, right):
        return (left[0] * right[0], right[0] * left[1] + right[1])

    _, h = lax.associative_scan(combine, (a, bterm), axis=1)
    return h.astype(xb.dtype), h[:, -1].astype(xb.dtype)


def layer(x, buf_a, buf_b, h0,
          g_ffn1, w1_gate, w1_up, w1_down, g_mix, w_in, conv_a_w, conv_a_b, ln_a_g, ln_a_b,
          conv_b_w, conv_b_b, w_rgate, b_rgate, w_igate, b_igate, lam, w_out,
          g_ffn2, w2_gate, w2_up, w2_down):
    x = x + FFN_RES * swiglu(rmsnorm(x, g_ffn1), w1_gate, w1_up, w1_down)
    h = rmsnorm(x, g_mix)
    p = h @ w_in
    a_val, a_gate, b_x, b_gate = jnp.split(p, [D_A, 2 * D_A, 2 * D_A + D_B], axis=-1)
    u = a_val * jax.nn.sigmoid(a_gate)
    ca, new_buf_a = causal_dwconv(u, buf_a, conv_a_w, conv_a_b)
    ya = jax.nn.silu(group_layernorm(ca, ln_a_g, ln_a_b))
    cb, new_buf_b = causal_dwconv(b_x, buf_b, conv_b_w, conv_b_b)
    hb, h_last = rglru(cb, h0, w_rgate, b_rgate, w_igate, b_igate, lam)
    yb = hb * jax.nn.gelu(b_gate)
    x = x + jnp.concatenate([ya, yb], axis=-1) @ w_out
    x = x + FFN_RES * swiglu(rmsnorm(x, g_ffn2), w2_gate, w2_up, w2_down)
    return x, new_buf_a, new_buf_b, h_last


def trunk(x, bufs_a, bufs_b, hs, g_ffn1, w1_gate, w1_up, w1_down, g_mix, w_in, conv_a_w, conv_a_b,
          ln_a_g, ln_a_b, conv_b_w, conv_b_b, w_rgate, b_rgate, w_igate, b_igate, lam, w_out,
          g_ffn2, w2_gate, w2_up, w2_down, g_final):
    out_a, out_b, out_h = [], [], []
    for l in range(DEPTH):
        x, na, nb, nh = layer(x, bufs_a[l], bufs_b[l], hs[l],
                              g_ffn1[l], w1_gate[l], w1_up[l], w1_down[l], g_mix[l], w_in[l],
                              conv_a_w[l], conv_a_b[l], ln_a_g[l], ln_a_b[l], conv_b_w[l], conv_b_b[l],
                              w_rgate[l], b_rgate[l], w_igate[l], b_igate[l], lam[l], w_out[l],
                              g_ffn2[l], w2_gate[l], w2_up[l], w2_down[l])
        out_a.append(na)
        out_b.append(nb)
        out_h.append(nh)
    return rmsnorm(x, g_final), jnp.stack(out_a), jnp.stack(out_b), jnp.stack(out_h)


def setup_inputs(seed: int = 0) -> dict:
    key = jax.random.key(seed)
    ks = iter(jax.random.split(key, 40))
    f32 = jnp.float32

    def nrm(shape, scale):
        return jax.random.normal(next(ks), shape, f32) * scale

    def gain(shape):
        return 1.0 + 0.01 * jax.random.normal(next(ks), shape, f32)

    u = jax.random.uniform(next(ks), (DEPTH, D_B), f32, 0.9, 0.999)
    s = u ** (1.0 / RG_C)
    lam = jnp.log(s) - jnp.log1p(-s)
    return {
        "x_prompt": nrm((BATCH, SEQ, D_MODEL), 1.0),
        "x_sample": nrm((DEC_BATCH, DEC_SEQ, D_MODEL), 1.0),
        "state_conv_a": nrm((DEPTH, DEC_BATCH, CONV_A_W - 1, D_A), 0.5),
        "state_conv_b": nrm((DEPTH, DEC_BATCH, CONV_B_W - 1, D_B), 0.5),
        "state_h": nrm((DEPTH, DEC_BATCH, D_B), 0.5),
        "meta": nrm((N_META, D_MODEL), 1.0),
        "g_ffn1": gain((DEPTH, D_MODEL)),
        "w1_gate": nrm((DEPTH, D_MODEL, D_FF), D_MODEL ** -0.5),
        "w1_up": nrm((DEPTH, D_MODEL, D_FF), D_MODEL ** -0.5),
        "w1_down": nrm((DEPTH, D_FF, D_MODEL), D_FF ** -0.5),
        "g_mix": gain((DEPTH, D_MODEL)),
        "w_in": nrm((DEPTH, D_MODEL, 2 * D_A + 2 * D_B), D_MODEL ** -0.5),
        "conv_a_w": nrm((DEPTH, CONV_A_W, D_A), CONV_A_W ** -0.5),
        "conv_a_b": nrm((DEPTH, D_A), 0.01),
        "ln_a_g": gain((DEPTH, D_A)),
        "ln_a_b": nrm((DEPTH, D_A), 0.01),
        "conv_b_w": nrm((DEPTH, CONV_B_W, D_B), CONV_B_W ** -0.5),
        "conv_b_b": nrm((DEPTH, D_B), 0.01),
        "w_rgate": nrm((DEPTH, H_B, HD_B, HD_B), HD_B ** -0.5),
        "b_rgate": nrm((DEPTH, D_B), 0.01),
        "w_igate": nrm((DEPTH, H_B, HD_B, HD_B), HD_B ** -0.5),
        "b_igate": nrm((DEPTH, D_B), 0.01),
        "lam": lam,
        "w_out": nrm((DEPTH, D_MIX, D_MODEL), D_MIX ** -0.5),
        "g_ffn2": gain((DEPTH, D_MODEL)),
        "w2_gate": nrm((DEPTH, D_MODEL, D_FF), D_MODEL ** -0.5),
        "w2_up": nrm((DEPTH, D_MODEL, D_FF), D_MODEL ** -0.5),
        "w2_down": nrm((DEPTH, D_FF, D_MODEL), D_FF ** -0.5),
        "g_final": gain((D_MODEL,)),
    }


def reference(x_prompt, x_sample, state_conv_a, state_conv_b, state_h, meta,
              g_ffn1, w1_gate, w1_up, w1_down, g_mix, w_in, conv_a_w, conv_a_b, ln_a_g, ln_a_b,
              conv_b_w, conv_b_b, w_rgate, b_rgate, w_igate, b_igate, lam, w_out,
              g_ffn2, w2_gate, w2_up, w2_down, g_final):
    weights = (g_ffn1, w1_gate, w1_up, w1_down, g_mix, w_in, conv_a_w, conv_a_b, ln_a_g, ln_a_b,
               conv_b_w, conv_b_b, w_rgate, b_rgate, w_igate, b_igate, lam, w_out,
               g_ffn2, w2_gate, w2_up, w2_down, g_final)
    bsz = x_prompt.shape[0]
    dt = x_prompt.dtype
    xp = jnp.concatenate([jnp.broadcast_to(meta.astype(dt)[None], (bsz, N_META, D_MODEL)), x_prompt], axis=1)
    zeros_a = jnp.zeros((DEPTH, bsz, CONV_A_W - 1, D_A), dt)
    zeros_b = jnp.zeros((DEPTH, bsz, CONV_B_W - 1, D_B), dt)
    zeros_h = jnp.zeros((DEPTH, bsz, D_B), dt)
    yp, new_conv_a_p, new_conv_b_p, new_h_p = trunk(xp, zeros_a, zeros_b, zeros_h, *weights)
    y_prompt = yp[:, N_META:]
    y_sample, new_conv_a_s, new_conv_b_s, new_h_s = trunk(x_sample, state_conv_a, state_conv_b, state_h, *weights)
    return (y_prompt, y_sample, new_conv_a_p, new_conv_b_p, new_h_p, new_conv_a_s, new_conv_b_s, new_h_s)
```

```cpp
#include <hip/hip_runtime.h>
#include <hip/hip_cooperative_groups.h>
#include <cstdio>
#include <cstdint>
namespace cg = cooperative_groups;
__device__ __forceinline__ int hw_lane_id() { int l; asm volatile("v_mbcnt_lo_u32_b32 %0, -1, 0\n\tv_mbcnt_hi_u32_b32 %0, -1, %0" : "=v"(l)); return l; }
namespace pg8 {
#define PG8_LAS __attribute__((address_space(3)))
typedef unsigned short bf16_t;
typedef short bf16x8 __attribute__((ext_vector_type(8)));
typedef float f32x4 __attribute__((ext_vector_type(4)));
typedef unsigned u32x4 __attribute__((ext_vector_type(4)));
constexpr int BM = 256, BK = 64, HALF = 128, HTB = HALF * BK * 2  , STAGE_BYTES = 8 * HTB, NXCD = 8, WGM = 8;

__host__ __device__ __forceinline__ int lds_byte(int r, int c) { const int st = (r >> 4) * 2 + (c >> 5), rr = r & 15, cc = c & 31, ob = rr * 64 + cc * 2; return st * 1024 + (ob ^ (((ob >> 9) & 1) << 5)); }
__host__ __device__ __forceinline__ void stage_rc(int b, int& R, int& C) { const int st = b / 1024, sb = b % 1024, swz = sb ^ (((sb >> 9) & 1) << 5); R = (st >> 1) * 16 + swz / 64; C = (st & 1) * 32 + (swz % 64) / 2; }
__host__ __device__ __forceinline__ int perm32(int rho) { const int n = rho >> 4, i = rho & 15; return 8 * (i >> 2) + 4 * n + (i & 3); }

struct Unit { int pm, pn, k0, len, kind; };
struct Gemm { const bf16_t* A; const bf16_t* Bt; int M, N, K; };

struct StaticOrder {
    static constexpr bool STREAMK = false;
    int nM, nN, nwg, G, c, nt;
    __host__ __device__ void init(int M, int N, int K, int G_, int c_) { nM = M / BM; nN = N / BM; nwg = nM * nN; G = G_; c = c_; nt = K / BK; }
    __host__ __device__ bool next(int i, Unit& u) const {
        const long L = (long)i * G + c; if (L >= nwg) return false;
        int wgid = (int)L; { const int q = nwg / NXCD, r = nwg % NXCD, xcd = wgid % NXCD, off = wgid / NXCD; wgid = (xcd < r ? xcd * (q + 1) : r * (q + 1) + (xcd - r) * q) + off; }
        const int nig = WGM * nN, gid = wgid / nig, fm = gid * WGM, gsz = (nM - fm) < WGM ? (nM - fm) : WGM;
        u.pm = fm + ((wgid % nig) % gsz); u.pn = (wgid % nig) / gsz; u.k0 = 0; u.len = nt; u.kind = 0; return true;
    }
    __device__ __forceinline__ void a_ready(const Unit&) const {}
    __device__ __forceinline__ void done(const Unit&) const {}
    __device__ __forceinline__ void store_partial(const f32x4 (&)[2][2][4][2], int, int, int) const {}
    __device__ __forceinline__ void load_partial(f32x4 (&)[2][2][4][2], int, int, int) const {}
};
struct DpSplit {
    static constexpr bool STREAMK = true;
    int nM, nN, nwg, G, c, nt; float* slab;
    __device__ __forceinline__ void init(int M, int N, int K, int G_, int c_, float* slab_) { nM = M / BM; nN = N / BM; nwg = nM * nN; G = G_; c = c_; nt = K / BK; slab = slab_; }
    __device__ __forceinline__ void unit_of(int L, Unit& u) const {
        int wgid = L; { const int q = nwg / NXCD, r = nwg % NXCD, xcd = wgid % NXCD, off = wgid / NXCD; wgid = (xcd < r ? xcd * (q + 1) : r * (q + 1) + (xcd - r) * q) + off; }
        const int nig = WGM * nN, gid = wgid / nig, fm = gid * WGM, gsz = (nM - fm) < WGM ? (nM - fm) : WGM;
        u.pm = fm + ((wgid % nig) % gsz); u.pn = (wgid % nig) / gsz;
    }
    __device__ __forceinline__ bool next(int i, Unit& u) const {
        if (i == 0) { if (c >= nwg) return false; unit_of(c, u); u.k0 = 0; u.len = nt; u.kind = 0; return true; }
        if (i == 1 && c < 4 * (nwg - G)) {
            unit_of(G + (c >> 2), u);
            const int part = c & 3, lenp = (nt >> 2) & ~1, rem2 = (nt - 4 * lenp) >> 1;
            u.len = lenp + (part < rem2 ? 2 : 0); u.k0 = part * lenp + 2 * (part < rem2 ? part : rem2); u.kind = 1; return true;
        }
        return false;
    }
    __device__ __forceinline__ void a_ready(const Unit&) const {}
    __device__ __forceinline__ void done(const Unit&) const {}
    __device__ __forceinline__ void store_partial(const f32x4 (&acc)[2][2][4][2], int tid, int wid, int lane) const {
        typedef unsigned u32x4v __attribute__((ext_vector_type(4)));
        asm volatile("" : "+v"(tid));
        const __amdgpu_buffer_rsrc_t r = __builtin_amdgcn_make_buffer_rsrc((void*)(slab + (size_t)c * 65536), 0, 262144, 0x00020000);
        const int vo = tid * 16;
#pragma unroll
        for (int ai = 0; ai < 2; ++ai)
#pragma unroll
            for (int bj = 0; bj < 2; ++bj)
#pragma unroll
                for (int m = 0; m < 4; ++m)
#pragma unroll
                    for (int n = 0; n < 2; ++n) __builtin_amdgcn_raw_buffer_store_b128(__builtin_bit_cast(u32x4v, acc[ai][bj][m][n]), r, vo, (((ai * 2 + bj) * 4 + m) * 2 + n) * 8192, 16);
    }
    __device__ __forceinline__ void load_partial(f32x4 (&)[2][2][4][2], int, int, int) const {}
};

template <class Epi, class Sched, bool ALIGN_EPI = false, bool SP2 = false>
__device__ __forceinline__ void gemm_phase(PG8_LAS unsigned char* lds, const Gemm g, const Sched& S, const Epi& E, const int wave_s) {
    int tid_l = wave_s * 64 + hw_lane_id(); asm volatile("" : "+v"(tid_l));
    const int tid = tid_l, wid = __builtin_amdgcn_readfirstlane(tid >> 6), lane = tid & 63, wr = wid >> 2, wc = wid & 3, fr = lane & 15, fq = lane >> 4;
    const int K = g.K, nt = K / BK;
    unsigned voffA[2], voffB[2];
#pragma unroll
    for (int i = 0; i < 2; ++i) { int R, C; stage_rc(tid * 16 + i * 8192, R, C); const int Rb = Epi::PERM ? ((R & ~31) + perm32(R & 31)) : R;
        voffA[i] = (unsigned)(R * K + C) * 2u; voffB[i] = (unsigned)(Rb * K + C) * 2u; }
    const size_t kstep = (size_t)(BK * 2);
    const size_t hstep = (size_t)HALF * K * 2;
    const size_t tstep = 2 * hstep;
    const unsigned ldsw = (unsigned)wid * 1024u;
    const int aoff = lds_byte(wr * 64 + fr, fq * 8), boff = lds_byte(wc * 32 + fr, fq * 8);
#define PG8_SA(b, h) (((b) * 2 + (h)) * HTB)
#define PG8_SB(b, h) ((4 + (b) * 2 + (h)) * HTB)
#define PG8_STAGE(bufoff, gbase, voff) do { _Pragma("unroll") for (int _i = 0; _i < 2; ++_i) \
        __builtin_amdgcn_global_load_lds((const unsigned*)((const char*)(gbase) + (voff)[_i]), (PG8_LAS unsigned*)(lds + (bufoff) + ldsw + _i * 8192), 16, 0, 0); } while (0)
#define PG8_LDA(dst, b, h) do { _Pragma("unroll") for (int m = 0; m < 4; ++m) _Pragma("unroll") for (int k = 0; k < 2; ++k) dst[m][k] = *(const PG8_LAS bf16x8*)(lds + PG8_SA(b, h) + aoff + m * 2048 + k * 1024); } while (0)
#define PG8_LDB(dst, b, h) do { _Pragma("unroll") for (int n = 0; n < 2; ++n) _Pragma("unroll") for (int k = 0; k < 2; ++k) dst[n][k] = *(const PG8_LAS bf16x8*)(lds + PG8_SB(b, h) + boff + n * 2048 + k * 1024); } while (0)
#define PG8_MMA(ai, bj, At, Bt) do { __builtin_amdgcn_s_setprio(1); _Pragma("unroll") for (int m = 0; m < 4; ++m) _Pragma("unroll") for (int n = 0; n < 2; ++n) _Pragma("unroll") for (int k = 0; k < 2; ++k) \
        acc[ai][bj][m][n] = __builtin_amdgcn_mfma_f32_16x16x32_bf16(Bt[n][k], At[m][k], acc[ai][bj][m][n], 0, 0, 0); __builtin_amdgcn_s_setprio(0); } while (0)
#define PG8_WAIT_V(n) asm volatile("s_waitcnt vmcnt(" #n ")" ::: "memory")
#define PG8_WAIT_L(n) asm volatile("s_waitcnt lgkmcnt(" #n ")" ::: "memory")
#define PG8_BAR __builtin_amdgcn_s_barrier()
#define PG8_SCHED __builtin_amdgcn_sched_barrier(0)
    Unit cur, nxt; int ui = 0;
    if (!S.next(0, cur)) return;
    f32x4 acc[2][2][4][2];
#pragma unroll
    for (int a = 0; a < 2; ++a)
#pragma unroll
        for (int b = 0; b < 2; ++b)
#pragma unroll
            for (int m = 0; m < 4; ++m)
#pragma unroll
                for (int n = 0; n < 2; ++n) acc[a][b][m][n] = (f32x4){0.f, 0.f, 0.f, 0.f};
    if (Sched::STREAMK && cur.kind == 2) S.load_partial(acc, tid, wid, lane);
    if constexpr (Epi::INIT_ACC) { if (cur.kind == 0) E.init(acc, cur, wr, wc, fr, fq); }
    bf16x8 At[4][2], B0[2][2], B1[2][2];
    const char* cA = (const char*)g.A + (size_t)cur.pm * tstep + (size_t)cur.k0 * kstep; const char* cB = (const char*)g.Bt + (size_t)cur.pn * tstep + (size_t)cur.k0 * kstep;
    S.a_ready(cur);
    if constexpr (SP2) {
        PG8_STAGE(PG8_SB(0, 0), cB, voffB); PG8_STAGE(PG8_SB(0, 1), cB + hstep, voffB); PG8_STAGE(PG8_SA(0, 0), cA, voffA); PG8_STAGE(PG8_SA(0, 1), cA + hstep, voffA);
        if (wr == 1) PG8_BAR;
        PG8_WAIT_V(2); PG8_BAR;
        PG8_STAGE(PG8_SB(1, 0), cB + kstep, voffB); PG8_STAGE(PG8_SA(1, 0), cA + kstep, voffA); PG8_STAGE(PG8_SB(1, 1), cB + hstep + kstep, voffB);
        PG8_WAIT_V(6); PG8_BAR;
    } else {
        PG8_STAGE(PG8_SB(0, 0), cB, voffB); PG8_STAGE(PG8_SA(0, 0), cA, voffA); PG8_STAGE(PG8_SB(0, 1), cB + hstep, voffB); PG8_STAGE(PG8_SA(0, 1), cA + hstep, voffA);
        if (wr == 1) PG8_BAR;
        PG8_WAIT_V(4); PG8_BAR;
        PG8_STAGE(PG8_SB(1, 0), cB + kstep, voffB); PG8_STAGE(PG8_SA(1, 0), cA + kstep, voffA); PG8_STAGE(PG8_SB(1, 1), cB + hstep + kstep, voffB);
        PG8_WAIT_V(6); PG8_BAR;
    }
    for (;;) {
        const bool has_next = S.next(ui + 1, nxt);
        const char* nA = has_next ? (const char*)g.A + (size_t)nxt.pm * tstep + (size_t)nxt.k0 * kstep : cA; const char* nB = has_next ? (const char*)g.Bt + (size_t)nxt.pn * tstep + (size_t)nxt.k0 * kstep : cB;
        const int clen = cur.len;
        for (int t = 0; t < clen; t += 2) {
            const bool last = (t == clen - 2);
            const char* a1 = cA + (size_t)(t + 1) * kstep;
            const char* a2 = last ? nA : cA + (size_t)(t + 2) * kstep; const char* b2 = last ? nB : cB + (size_t)(t + 2) * kstep;
            const char* a3 = a2 + kstep; const char* b3 = b2 + kstep;
            if (last && has_next) S.a_ready(nxt);
            if constexpr (SP2) {
            PG8_LDB(B0, 0, 0); PG8_LDB(B1, 0, 1); PG8_SCHED; PG8_LDA(At, 0, 0); PG8_STAGE(PG8_SA(1, 1), a1 + hstep, voffA);
            PG8_WAIT_V(8); PG8_WAIT_L(0); PG8_BAR; PG8_MMA(0, 0, At, B0); PG8_MMA(0, 1, At, B1); PG8_BAR; PG8_SCHED;
            PG8_LDA(At, 0, 1); PG8_STAGE(PG8_SB(0, 0), b2, voffB); PG8_STAGE(PG8_SB(0, 1), b2 + hstep, voffB); PG8_STAGE(PG8_SA(0, 0), a2, voffA);
            PG8_WAIT_V(8); PG8_WAIT_L(0); PG8_BAR; PG8_MMA(1, 0, At, B0); PG8_MMA(1, 1, At, B1); PG8_BAR; PG8_SCHED;
            PG8_LDB(B0, 1, 0); PG8_LDB(B1, 1, 1); PG8_SCHED; PG8_LDA(At, 1, 0); PG8_STAGE(PG8_SA(0, 1), a2 + hstep, voffA);
            PG8_WAIT_V(8); PG8_WAIT_L(0); PG8_BAR; PG8_MMA(0, 0, At, B0); PG8_MMA(0, 1, At, B1); PG8_BAR; PG8_SCHED;
            PG8_LDA(At, 1, 1); PG8_STAGE(PG8_SB(1, 0), b3, voffB); PG8_STAGE(PG8_SB(1, 1), b3 + hstep, voffB); PG8_STAGE(PG8_SA(1, 0), a3, voffA);
            PG8_WAIT_V(8); PG8_WAIT_L(0); PG8_BAR; PG8_MMA(1, 0, At, B0); PG8_MMA(1, 1, At, B1); PG8_BAR; PG8_SCHED;
            } else {
            PG8_LDB(B0, 0, 0); PG8_SCHED; PG8_LDA(At, 0, 0); PG8_STAGE(PG8_SA(1, 1), a1 + hstep, voffA);
            PG8_WAIT_L(8); PG8_BAR; PG8_WAIT_L(0); PG8_MMA(0, 0, At, B0); PG8_BAR; PG8_SCHED;
            PG8_LDB(B1, 0, 1); PG8_STAGE(PG8_SB(0, 0), b2, voffB);
            PG8_BAR; PG8_WAIT_L(0); PG8_MMA(0, 1, At, B1); PG8_BAR;
            PG8_LDA(At, 0, 1); PG8_STAGE(PG8_SA(0, 0), a2, voffA);
            PG8_BAR; PG8_WAIT_L(0); PG8_MMA(1, 0, At, B0); PG8_BAR; PG8_SCHED;
            PG8_STAGE(PG8_SB(0, 1), b2 + hstep, voffB);
            PG8_WAIT_V(6); PG8_BAR; PG8_MMA(1, 1, At, B1); PG8_BAR;
            PG8_LDB(B0, 1, 0); PG8_SCHED; PG8_LDA(At, 1, 0); PG8_STAGE(PG8_SA(0, 1), a2 + hstep, voffA);
            PG8_WAIT_L(8); PG8_BAR; PG8_WAIT_L(0); PG8_MMA(0, 0, At, B0); PG8_BAR; PG8_SCHED;
            PG8_LDB(B1, 1, 1); PG8_STAGE(PG8_SB(1, 0), b3, voffB);
            PG8_BAR; PG8_WAIT_L(0); PG8_MMA(0, 1, At, B1); PG8_BAR;
            PG8_LDA(At, 1, 1); PG8_STAGE(PG8_SA(1, 0), a3, voffA);
            PG8_BAR; PG8_WAIT_L(0); PG8_MMA(1, 0, At, B0); PG8_BAR; PG8_SCHED;
            PG8_STAGE(PG8_SB(1, 1), b3 + hstep, voffB);
            PG8_WAIT_V(6); PG8_BAR; PG8_MMA(1, 1, At, B1); PG8_BAR;
            }
        }
        if constexpr (ALIGN_EPI) { if (wr == 0) PG8_BAR; }
        if constexpr (!Epi::AFTER_DRAIN) {
            int fr_l = fr, fq_l = fq; asm volatile("" : "+v"(fr_l), "+v"(fq_l));
            if constexpr (Sched::STREAMK) {
                if (cur.kind == 1) S.store_partial(acc, tid, wid, lane);
                else E(acc, cur, wr, wc, fr_l, fq_l);
            } else E(acc, cur, wr, wc, fr_l, fq_l);
            S.done(cur); }
        if (!has_next) break;
#define PG8_ZERO_ACC() do { _Pragma("unroll") for (int a = 0; a < 2; ++a) _Pragma("unroll") for (int b = 0; b < 2; ++b) _Pragma("unroll") for (int m = 0; m < 4; ++m) _Pragma("unroll") for (int n = 0; n < 2; ++n) acc[a][b][m][n] = (f32x4){0.f, 0.f, 0.f, 0.f}; } while (0)
        if constexpr (Epi::INIT_ACC) {
            if (Sched::STREAMK && nxt.kind == 2) S.load_partial(acc, tid, wid, lane);
            else if (nxt.kind == 0) { int fr_i = fr, fq_i = fq; asm volatile("" : "+v"(fr_i), "+v"(fq_i)); E.init(acc, nxt, wr, wc, fr_i, fq_i); }
            else PG8_ZERO_ACC();
        } else {
            if (Sched::STREAMK && nxt.kind == 2) S.load_partial(acc, tid, wid, lane);
            else PG8_ZERO_ACC();
        }
#undef PG8_ZERO_ACC
        cur = nxt; cA = nA; cB = nB; ++ui;
        if constexpr (ALIGN_EPI) { if (wr == 1) PG8_BAR; }
    }
    PG8_WAIT_V(0);
    if constexpr (!ALIGN_EPI) { if (wr == 0) PG8_BAR; }
    PG8_BAR;
    if constexpr (Epi::AFTER_DRAIN) { E.fused(acc, cur, wr, wc, fr, fq, lds, wid, lane); S.done(cur); }
#undef PG8_SA
#undef PG8_SB
#undef PG8_STAGE
#undef PG8_LDA
#undef PG8_LDB
#undef PG8_MMA
#undef PG8_WAIT_V
#undef PG8_WAIT_L
#undef PG8_BAR
#undef PG8_SCHED
}
}

#define LAS __attribute__((address_space(3)))
typedef unsigned short bf16_t;
typedef float f32x4 __attribute__((ext_vector_type(4)));
typedef float f32x2 __attribute__((ext_vector_type(2)));
typedef unsigned u32x4 __attribute__((ext_vector_type(4)));
typedef unsigned u32x2 __attribute__((ext_vector_type(2)));

constexpr int D = 1024, FF = 2816, DA = 512, DB = 512;
constexpr int NB_P = 8, TP = 2064, NB_S = 128, TS = 8, NMETA = 16, SEQ = 2048;
constexpr int MP = NB_P * TP;
constexpr int MR = MP + NB_S * TS;
constexpr int MPAD = 17664;
constexpr int NCH_P = 33;
constexpr int NQ_P = NB_P * NCH_P;
constexpr int NQ_S = (NB_S * TS) / 64;
constexpr int NQ = NQ_P + NQ_S;
constexpr float EPS = 1e-6f;
constexpr int NWAVES = 8;

enum { I_XP = 0, I_XS, I_SCA, I_SCB, I_SH, I_META, I_GF1, I_W1G, I_W1U, I_W1D, I_GMIX, I_WIN, I_CAW, I_CAB, I_LNG, I_LNB, I_CBW, I_CBB,
       I_WRG, I_BRG, I_WIG, I_BIG, I_LAM, I_WOUT, I_GF2, I_W2G, I_W2U, I_W2D, I_GFIN, N_IN };
constexpr size_t O_YP = 0, O_YS = O_YP + (size_t)NB_P * SEQ * D, O_CAP = O_YS + (size_t)NB_S * TS * D, O_CBP = O_CAP + (size_t)2 * NB_P * 30 * DA,
                 O_HP = O_CBP + (size_t)2 * NB_P * 3 * DB, O_CAS = O_HP + (size_t)2 * NB_P * DB, O_CBS = O_CAS + (size_t)2 * NB_S * 30 * DA,
                 O_HS = O_CBS + (size_t)2 * NB_S * 3 * DB, O_END = O_HS + (size_t)2 * NB_S * DB;

constexpr size_t WS_SS = 0;
constexpr size_t WS_SUMM = 0x80000;
constexpr size_t WS_LAST = 0x1A0000;
constexpr size_t WS_W = 0x400000;
constexpr size_t SZ_WGU = (size_t)2 * FF * D * 2, SZ_WD = (size_t)D * FF * 2, SZ_WIN = (size_t)2048 * D * 2, SZ_WOUT = (size_t)D * D * 2;
constexpr size_t WS_WGU1 = WS_W, WS_WD1 = WS_WGU1 + SZ_WGU, WS_WIN = WS_WD1 + SZ_WD, WS_WOUT = WS_WIN + SZ_WIN, WS_WGU2 = WS_WOUT + SZ_WOUT, WS_WD2 = WS_WGU2 + SZ_WGU;
constexpr size_t WS_X = WS_WD2 + SZ_WD;
constexpr size_t WS_XB = WS_X + (size_t)MPAD * D * 4;
constexpr size_t WS_ACT = WS_XB + (size_t)MPAD * D * 2;
constexpr size_t WS_U = WS_ACT, WS_BX = WS_U + (size_t)MPAD * 512 * 2, WS_GG = WS_BX + (size_t)MPAD * 512 * 2, WS_YAB = WS_GG + (size_t)MPAD * 512 * 2;
constexpr size_t WS_END = WS_ACT + (size_t)MPAD * FF * 2;
static_assert(WS_YAB + (size_t)MPAD * D * 2 <= WS_END, "mixer overlay fits");
static_assert(WS_END <= 268435456, "ws map fits 256 MiB");
static_assert(WS_SS + 7 * (size_t)MPAD * 4 <= WS_SUMM && WS_SUMM + (size_t)NQ * 512 * 8 <= WS_LAST && WS_LAST + (size_t)128 * 512 * 8 <= WS_W, "small buffers");

constexpr int LDS_BYTES = 147456;

__device__ __forceinline__ float bf2f(bf16_t b) { return __uint_as_float(((unsigned)b) << 16); }
__device__ __forceinline__ unsigned pk2(float lo, float hi) { unsigned r; asm("v_cvt_pk_bf16_f32 %0, %1, %2" : "=v"(r) : "v"(lo), "v"(hi)); return r; }
__device__ __forceinline__ unsigned f2bf(float f) { return pk2(f, f) & 0xffffu; }
__device__ __forceinline__ float fast_rcp(float x) { return __builtin_amdgcn_rcpf(x); }
__device__ __forceinline__ float sigmoid_f(float x) { return fast_rcp(1.0f + __expf(-x)); }
__device__ __forceinline__ float silu_f(float x) { return x * sigmoid_f(x); }
__device__ __forceinline__ float gelu_tanh_f(float x) {
    const float u = 0.7978845608028654f * (x + 0.044715f * x * x * x);
    return x * sigmoid_f(2.0f * u);
}
__device__ __forceinline__ float neg_expm1_f(float x) {
    const float p = -x * (1.0f + x * (0.5f + x * (0.16666667f + x * (0.041666668f + x * (0.0083333338f + x * (0.0013888889f + x * 0.0001984127f))))));
    const float q = 1.0f - __expf(x);
    return x > -0.35f ? p : q;
}
__device__ __forceinline__ float wave_sum(float v) {
#pragma unroll
    for (int o = 1; o < 64; o <<= 1) v += __shfl_xor(v, o);
    return v;
}

#define XB_TMO      128
#define XB_XCNT(j)  (256  + 64 * (j))
#define XB_XSUB(j)  (1280 + 64 * (j))
#define XB_XGEN(j)  (2304 + 64 * (j))
#define XB_TOP      3328
#define XB_TOPGEN   3392
#define XCD_BAR_WORDS 3456
#define XB_SPIN_CAP (1u << 18)

__device__ __forceinline__ unsigned xb_ld(unsigned* p)              { return __hip_atomic_load(p, __ATOMIC_RELAXED, __HIP_MEMORY_SCOPE_AGENT); }
__device__ __forceinline__ unsigned xb_add(unsigned* p, unsigned v) { return __hip_atomic_fetch_add(p, v, __ATOMIC_RELAXED, __HIP_MEMORY_SCOPE_AGENT); }
__device__ __forceinline__ unsigned xb_xcc_id() { return (unsigned)__builtin_amdgcn_s_getreg((3 << 11) | 20) & 0xFu; }
#define XB_SPIN(cond, bar) do { unsigned _sp = 0; while (cond) { __builtin_amdgcn_s_sleep(1); \
    if ((++_sp & 255u) == 0u) { if (xb_ld(&(bar)[XB_TMO])) break; if (_sp > XB_SPIN_CAP) { atomicAdd(&(bar)[XB_TMO], 1u); break; } } } } while (0)

struct XcdBarrier {
    unsigned* bar; unsigned x;
    volatile LAS unsigned* st;
};

__device__ __forceinline__ XcdBarrier xcd_barrier_post(unsigned* bar, volatile LAS unsigned* st) {
    XcdBarrier b; b.bar = bar; b.x = xb_xcc_id(); b.st = st;
    if (threadIdx.x == 0) (void)xb_add(&bar[XB_XCNT(b.x)], 1u);
    return b;
}
__device__ __forceinline__ void xcd_barrier_complete(unsigned* bar, unsigned x, unsigned& nloc, unsigned& nx) {
    const unsigned G = gridDim.x * gridDim.y * gridDim.z;
    unsigned sum, cnt, mine, sp = 0u;
    for (;;) {
        sum = 0u; cnt = 0u; mine = 0u;
#pragma unroll
        for (unsigned j = 0; j < 16; ++j) { const unsigned c = xb_ld(&bar[XB_XCNT(j)]); sum += c; cnt += (c > 0u) ? 1u : 0u; mine = (j == x) ? c : mine; }
        if (sum == G) break;
        __builtin_amdgcn_s_sleep(1);
        if ((++sp & 255u) == 0u) { if (xb_ld(&bar[XB_TMO])) break; if (sp > XB_SPIN_CAP) { atomicAdd(&bar[XB_TMO], 1u); break; } }
    }
    nloc = mine > 0u ? mine : 1u; nx = cnt > 0u ? cnt : 1u;
}

__device__ __forceinline__ void xcd_barrier(const XcdBarrier& b, const bool is_t0) {
    asm volatile("s_waitcnt vmcnt(0)" ::: "memory");
    __syncthreads();
    if (is_t0) {
        unsigned* bar = b.bar;
        __builtin_amdgcn_s_waitcnt(0);
        unsigned nloc = b.st[0], nx = b.st[1];
        if (nloc == 0u) { xcd_barrier_complete(bar, b.x, nloc, nx); b.st[0] = nloc; b.st[1] = nx; }
        const unsigned old = xb_add(&bar[XB_XSUB(b.x)], 1u);
        const unsigned gen = old / nloc;
        if (old + 1u == (gen + 1u) * nloc) {
            __builtin_amdgcn_fence(__ATOMIC_RELEASE, "agent");
            asm volatile("s_waitcnt vmcnt(0)" ::: "memory");
            const unsigned og = xb_add(&bar[XB_TOP], 1u);
            const unsigned tg = og / nx;
            if (og + 1u == (tg + 1u) * nx) xb_add(&bar[XB_TOPGEN], 1u);
            else XB_SPIN(xb_ld(&bar[XB_TOPGEN]) == tg, bar);
            __builtin_amdgcn_fence(__ATOMIC_ACQUIRE, "agent");
            xb_add(&bar[XB_XGEN(b.x)], 1u);
            asm volatile("s_waitcnt vmcnt(0)" ::: "memory");
        } else {
            XB_SPIN(xb_ld(&bar[XB_XGEN(b.x)]) == gen, bar);
            __builtin_amdgcn_fence(__ATOMIC_ACQUIRE, "agent");
            asm volatile("s_waitcnt vmcnt(0)" ::: "memory");
        }
    }
    __syncthreads();
}

constexpr size_t WS_BAR = 0x380000;
constexpr int LDS_BARST = 139264;
constexpr size_t WS_SKF = 0x390000;

struct EpiGU {
    static constexpr bool PERM = true, AFTER_DRAIN = false, INIT_ACC = false;
    bf16_t* ACT; const float* ss;
    __device__ __forceinline__ void operator()(const f32x4 (&acc)[2][2][4][2], const pg8::Unit& u, int wr, int wc, int fr, int fq) const {
        const int row0 = u.pm * 256 + wr * 64 + fr, col0 = u.pn * 128 + wc * 32 + 8 * fq;
        float rs[2][4];
#pragma unroll
        for (int ai = 0; ai < 2; ++ai)
#pragma unroll
            for (int m = 0; m < 4; ++m) rs[ai][m] = ss[row0 + ai * 128 + m * 16];
#pragma unroll
        for (int ai = 0; ai < 2; ++ai)
#pragma unroll
            for (int m = 0; m < 4; ++m) {
                const int r = row0 + ai * 128 + m * 16;
                const float rstd = __builtin_amdgcn_rsqf(rs[ai][m] * (1.0f / D) + EPS);
                float o[8];
#pragma unroll
                for (int n = 0; n < 2; ++n)
#pragma unroll
                    for (int e = 0; e < 4; ++e) { const float g = acc[ai][0][m][n][e] * rstd, up = acc[ai][1][m][n][e] * rstd; o[4 * n + e] = silu_f(g) * up; }
                u32x4 w; w.x = pk2(o[0], o[1]); w.y = pk2(o[2], o[3]); w.z = pk2(o[4], o[5]); w.w = pk2(o[6], o[7]);
                *(u32x4*)(ACT + (size_t)r * FF + col0) = w;
            }
    }
};
struct EpiRes {
    static constexpr bool PERM = true, AFTER_DRAIN = false, INIT_ACC = true;
    float* X; bf16_t* XB; float* ssn; float scale;
    __device__ __forceinline__ void init(f32x4 (&acc)[2][2][4][2], const pg8::Unit& u, int wr, int wc, int fr, int fq) const {
        const int row0 = u.pm * 256 + wr * 64 + fr, col0 = u.pn * 256 + wc * 32 + 8 * fq; const float inv = 1.0f / scale;
#pragma unroll
        for (int ai = 0; ai < 2; ++ai)
#pragma unroll
            for (int m = 0; m < 4; ++m)
#pragma unroll
                for (int bj = 0; bj < 2; ++bj) { const float* xp = X + (size_t)(row0 + ai * 128 + m * 16) * D + col0 + bj * 128; acc[ai][bj][m][0] = *(const f32x4*)xp * inv; acc[ai][bj][m][1] = *(const f32x4*)(xp + 4) * inv; }
    }
    __device__ __forceinline__ void operator()(const f32x4 (&acc)[2][2][4][2], const pg8::Unit& u, int wr, int wc, int fr, int fq) const {
        const int row0 = u.pm * 256 + wr * 64 + fr, col0 = u.pn * 256 + wc * 32 + 8 * fq;
#pragma unroll
        for (int ai = 0; ai < 2; ++ai)
#pragma unroll
            for (int m = 0; m < 4; ++m) {
                const int r = row0 + ai * 128 + m * 16; float q = 0.f;
#pragma unroll
                for (int bj = 0; bj < 2; ++bj) {
                    float* xp = X + (size_t)r * D + col0 + bj * 128;
                    const f32x4 v0 = acc[ai][bj][m][0] * scale, v1 = acc[ai][bj][m][1] * scale;
                    *(f32x4*)xp = v0; *(f32x4*)(xp + 4) = v1;
                    u32x4 w; w.x = pk2(v0[0], v0[1]); w.y = pk2(v0[2], v0[3]); w.z = pk2(v1[0], v1[1]); w.w = pk2(v1[2], v1[3]);
                    *(u32x4*)(XB + (size_t)r * D + col0 + bj * 128) = w;
                    q += (v0[0] * v0[0] + v0[1] * v0[1]) + (v0[2] * v0[2] + v0[3] * v0[3]) + (v1[0] * v1[0] + v1[1] * v1[1]) + (v1[2] * v1[2] + v1[3] * v1[3]);
                }
                q += __shfl_xor(q, 16); q += __shfl_xor(q, 32);
                if (fq == 0) atomicAdd(ssn + r, q);
            }
    }
};
struct EpiWin {
    static constexpr bool PERM = true, AFTER_DRAIN = false, INIT_ACC = false;
    bf16_t *U, *BX, *GG; const float* ss;
    __device__ __forceinline__ void operator()(const f32x4 (&acc)[2][2][4][2], const pg8::Unit& u, int wr, int wc, int fr, int fq) const {
        const int row0 = u.pm * 256 + wr * 64 + fr, col0 = (u.pn & 3) * 128 + wc * 32 + 8 * fq;
        const bool isA = u.pn < 4;
        float rs[2][4];
#pragma unroll
        for (int ai = 0; ai < 2; ++ai)
#pragma unroll
            for (int m = 0; m < 4; ++m) rs[ai][m] = ss[row0 + ai * 128 + m * 16];
#pragma unroll
        for (int ai = 0; ai < 2; ++ai)
#pragma unroll
            for (int m = 0; m < 4; ++m) {
                const int r = row0 + ai * 128 + m * 16;
                const float rstd = __builtin_amdgcn_rsqf(rs[ai][m] * (1.0f / D) + EPS);
                float a0[8], a1[8];
#pragma unroll
                for (int n = 0; n < 2; ++n)
#pragma unroll
                    for (int e = 0; e < 4; ++e) { a0[4 * n + e] = acc[ai][0][m][n][e] * rstd; a1[4 * n + e] = acc[ai][1][m][n][e] * rstd; }
                if (isA) {
                    float o[8];
#pragma unroll
                    for (int e = 0; e < 8; ++e) o[e] = a0[e] * sigmoid_f(a1[e]);
                    u32x4 w; w.x = pk2(o[0], o[1]); w.y = pk2(o[2], o[3]); w.z = pk2(o[4], o[5]); w.w = pk2(o[6], o[7]);
                    *(u32x4*)(U + (size_t)r * 512 + col0) = w;
                } else {
                    float o[8];
#pragma unroll
                    for (int e = 0; e < 8; ++e) o[e] = gelu_tanh_f(a1[e]);
                    u32x4 w; w.x = pk2(a0[0], a0[1]); w.y = pk2(a0[2], a0[3]); w.z = pk2(a0[4], a0[5]); w.w = pk2(a0[6], a0[7]);
                    *(u32x4*)(BX + (size_t)r * 512 + col0) = w;
                    u32x4 g; g.x = pk2(o[0], o[1]); g.y = pk2(o[2], o[3]); g.z = pk2(o[4], o[5]); g.w = pk2(o[6], o[7]);
                    *(u32x4*)(GG + (size_t)r * 512 + col0) = g;
                }
            }
    }
};

struct Args { const float* in[N_IN]; float* out; unsigned char* ws; int ph_lo, ph_hi; };
struct Frame {
    LAS unsigned char* lds;
    int tid, lane, wave, G;
    const float* const __attribute__((address_space(4)))* in; float* out; unsigned char* ws;
};
#define LDS_WAIT() asm volatile("s_waitcnt lgkmcnt(0)" ::: "memory")

template <class FrameT>
__device__ __forceinline__ void res_fixup(FrameT& F, const EpiRes& E, const pg8::DpSplit& S) {
    const int nleft = S.nwg - S.G, tid = F.tid, wid = tid >> 6, lane = tid & 63, wr = wid >> 2, wc = wid & 3, fr = lane & 15, fq = lane >> 4;
    for (int item = blockIdx.x; item < nleft * 8; item += F.G) {
        const int j = item >> 3, ai = (item >> 2) & 1, m = item & 3;
        pg8::Unit u; S.unit_of(S.G + j, u);
        const int r = u.pm * 256 + wr * 64 + fr + ai * 128 + m * 16, col0 = u.pn * 256 + wc * 32 + 8 * fq;
        float q = 0.f;
#pragma unroll
        for (int bj = 0; bj < 2; ++bj) {
            f32x4 a0 = {0.f, 0.f, 0.f, 0.f}, a1 = {0.f, 0.f, 0.f, 0.f};
#pragma unroll
            for (int p = 0; p < 4; ++p) {
                const float* sp = S.slab + (size_t)(4 * j + p) * 65536 + (size_t)((((ai * 2 + bj) * 4 + m) * 2) * 2048) + tid * 4;
                a0 += __builtin_nontemporal_load((const f32x4*)sp); a1 += __builtin_nontemporal_load((const f32x4*)(sp + 2048));
            }
            float* xp = E.X + (size_t)r * D + col0 + bj * 128;
            f32x4 v0 = *(f32x4*)xp, v1 = *(f32x4*)(xp + 4);
            v0 = v0 + a0 * E.scale; v1 = v1 + a1 * E.scale;
            *(f32x4*)xp = v0; *(f32x4*)(xp + 4) = v1;
            u32x4 w; w.x = pk2(v0[0], v0[1]); w.y = pk2(v0[2], v0[3]); w.z = pk2(v1[0], v1[1]); w.w = pk2(v1[2], v1[3]);
            *(u32x4*)(E.XB + (size_t)r * D + col0 + bj * 128) = w;
            q += (v0[0] * v0[0] + v0[1] * v0[1]) + (v0[2] * v0[2] + v0[3] * v0[3]) + (v1[0] * v1[0] + v1[1] * v1[1]) + (v1[2] * v1[2] + v1[3] * v1[3]);
        }
        q += __shfl_xor(q, 16); q += __shfl_xor(q, 32);
        if (fq == 0) atomicAdd(E.ssn + r, q);
    }
}


__device__ __forceinline__ void transpose_item(const float* W, int K, int N, bf16_t* WT, const float* g, int mode, LAS float* scr, int item, int lane) {
    const int nblk = N / 32, kb = item / nblk, nb = item % nblk, k0 = 64 * kb, n0 = 32 * nb;
    float tv[32];
#pragma unroll
    for (int i = 0; i < 32; ++i) { const int kk = 2 * i + (lane >> 5); tv[i] = W[(size_t)(k0 + kk) * N + n0 + (lane & 31)]; }
    if (g) {
#pragma unroll
        for (int i = 0; i < 32; ++i) tv[i] *= g[k0 + 2 * i + (lane >> 5)];
    }
#pragma unroll
    for (int i = 0; i < 32; ++i) scr[(2 * i + (lane >> 5)) * 33 + (lane & 31)] = tv[i];
    LDS_WAIT(); asm volatile("" ::: "memory");
    int d0;
    if (mode == 0) d0 = n0;
    else if (mode == 1) d0 = 256 * (n0 >> 7) + (n0 & 127);
    else if (mode == 2) d0 = 256 * (n0 >> 7) + 128 + (n0 & 127);
    else { const int seg = n0 >> 9, cc = n0 & 511; d0 = 256 * ((seg >> 1) * 4 + (cc >> 7)) + 128 * (seg & 1) + (cc & 127); }
    const int c = lane & 7;
#pragma unroll
    for (int j = 0; j < 4; ++j) { const int n = (lane >> 3) + 8 * j; const LAS float* s = scr + (8 * c) * 33 + n;
        u32x4 o; o.x = pk2(s[0 * 33], s[1 * 33]); o.y = pk2(s[2 * 33], s[3 * 33]); o.z = pk2(s[4 * 33], s[5 * 33]); o.w = pk2(s[6 * 33], s[7 * 33]);
        *(u32x4*)(WT + (size_t)(d0 + n) * K + k0 + 8 * c) = o; }
    LDS_WAIT(); asm volatile("" ::: "memory");
}
constexpr int IT_G = (D / 64) * (FF / 32), IT_D = (FF / 64) * (D / 32), IT_WIN = (D / 64) * (2048 / 32), IT_WOUT = (D / 64) * (D / 32);
__device__ __forceinline__ void convert_mats(Frame& F, int l, int id_lo, int id_hi, int gw, int NGW) {
    LAS float* scr = (LAS float*)(F.lds + F.wave * 16384);
    unsigned char* ws = F.ws;
    for (int id = id_lo; id < id_hi; ++id) {
        const int nit = (id == 0 || id == 4) ? 2 * IT_G : (id == 1 || id == 5) ? IT_D : (id == 2 ? IT_WIN : IT_WOUT);
        for (int it = gw; it < nit; it += NGW) {
            if (id == 0) { const bool up = it >= IT_G; transpose_item(F.in[up ? I_W1U : I_W1G] + (size_t)l * D * FF, D, FF, (bf16_t*)(ws + WS_WGU1), F.in[I_GF1] + l * D, up ? 2 : 1, scr, up ? it - IT_G : it, F.lane); }
            else if (id == 4) { const bool up = it >= IT_G; transpose_item(F.in[up ? I_W2U : I_W2G] + (size_t)l * D * FF, D, FF, (bf16_t*)(ws + WS_WGU2), F.in[I_GF2] + l * D, up ? 2 : 1, scr, up ? it - IT_G : it, F.lane); }
            else if (id == 1) transpose_item(F.in[I_W1D] + (size_t)l * D * FF, FF, D, (bf16_t*)(ws + WS_WD1), nullptr, 0, scr, it, F.lane);
            else if (id == 5) transpose_item(F.in[I_W2D] + (size_t)l * D * FF, FF, D, (bf16_t*)(ws + WS_WD2), nullptr, 0, scr, it, F.lane);
            else if (id == 2) transpose_item(F.in[I_WIN] + (size_t)l * D * 2048, D, 2048, (bf16_t*)(ws + WS_WIN), F.in[I_GMIX] + l * D, 3, scr, it, F.lane);
            else transpose_item(F.in[I_WOUT] + (size_t)l * D * D, D, D, (bf16_t*)(ws + WS_WOUT), nullptr, 0, scr, it, F.lane);
        }
    }
}

__device__ __forceinline__ void p0_prologue(Frame& F) {
    convert_mats(F, 0, 0, 6, blockIdx.x * NWAVES + F.wave, F.G * NWAVES);
    const int gw = blockIdx.x * NWAVES + F.wave, NGW = F.G * NWAVES;
    float* X = (float*)(F.ws + WS_X); bf16_t* XB = (bf16_t*)(F.ws + WS_XB); float* ss = (float*)(F.ws + WS_SS);
    for (int r = gw; r < MPAD; r += NGW) {
        const float* src = nullptr;
        if (r < MP) { const int b = r / TP, tt = r - b * TP; src = tt < NMETA ? F.in[I_META] + (size_t)tt * D : F.in[I_XP] + ((size_t)b * SEQ + (tt - NMETA)) * D; }
        else if (r < MR) src = F.in[I_XS] + (size_t)(r - MP) * D;
        f32x4 v[4]; float s = 0.f;
#pragma unroll
        for (int j = 0; j < 4; ++j) { v[j] = src ? ((const f32x4*)src)[F.lane + 64 * j] : (f32x4){0.f, 0.f, 0.f, 0.f}; s += (v[j][0] * v[j][0] + v[j][1] * v[j][1]) + (v[j][2] * v[j][2] + v[j][3] * v[j][3]); }
        s = wave_sum(s);
#pragma unroll
        for (int j = 0; j < 4; ++j) { ((f32x4*)(X + (size_t)r * D))[F.lane + 64 * j] = v[j];
            u32x2 w; w.x = pk2(v[j][0], v[j][1]); w.y = pk2(v[j][2], v[j][3]); ((u32x2*)(XB + (size_t)r * D))[F.lane + 64 * j] = w; }
        if (F.lane == 0) ss[r] = s;
    }
    { const int i = blockIdx.x * 512 + F.tid; if (i < 6 * MPAD) ss[MPAD + i] = 0.f; }
}

__device__ __forceinline__ void final_phase(Frame& F) {
    const int gw = blockIdx.x * NWAVES + F.wave, NGW = F.G * NWAVES;
    const float* X = (const float*)(F.ws + WS_X); const float* ss = (const float*)(F.ws + WS_SS) + 6 * MPAD; const float* g = F.in[I_GFIN];
    f32x4 gv[4];
#pragma unroll
    for (int j = 0; j < 4; ++j) gv[j] = ((const f32x4*)g)[F.lane + 64 * j];
    for (int r = gw; r < MR; r += NGW) {
        float* dst;
        if (r < MP) { const int b = r / TP, tt = r - b * TP; if (tt < NMETA) continue; dst = F.out + O_YP + ((size_t)b * SEQ + (tt - NMETA)) * D; }
        else dst = F.out + O_YS + (size_t)(r - MP) * D;
        const float rstd = __builtin_amdgcn_rsqf(ss[r] * (1.0f / D) + EPS);
#pragma unroll
        for (int j = 0; j < 4; ++j) { const f32x4 v = ((const f32x4*)(X + (size_t)r * D))[F.lane + 64 * j]; ((f32x4*)dst)[F.lane + 64 * j] = v * rstd * gv[j]; }
    }
}

constexpr int LDS_WR = 0, LDS_WI = 16384, LDS_CBT = 32768, LDS_GRP = LDS_CBT + 4 * 64 * 68 * 4, LDS_RED = 0;

__device__ __forceinline__ float reduce_scatter32(float (&v)[32], int lane) {
#define RS_STEP(H, M) { const bool up = (lane & (M)) != 0; _Pragma("unroll") for (int i = 0; i < (H); ++i) { const float snd = up ? v[i] : v[i + (H)], kp = up ? v[i + (H)] : v[i]; v[i] = kp + __shfl_xor(snd, (M)); } }
    RS_STEP(16, 32) RS_STEP(8, 16) RS_STEP(4, 8) RS_STEP(2, 4) RS_STEP(1, 2)
#undef RS_STEP
    return v[0] + __shfl_xor(v[0], 1);
}

__device__ __forceinline__ void mix_job_a(Frame& F, int l, int sp, int gi) {
    const int tid = F.tid, c = 128 * gi + (tid & 127), sub = tid >> 7;
    const bf16_t* U = (const bf16_t*)(F.ws + WS_U); bf16_t* YAB = (bf16_t*)(F.ws + WS_YAB);
    const float* cw = F.in[I_CAW] + (size_t)l * 31 * DA;
    float w[31];
#pragma unroll
    for (int k = 0; k < 31; ++k) w[k] = cw[k * DA + c];
    const float cbias = F.in[I_CAB][l * DA + c], lg = F.in[I_LNG][l * DA + c], lb = F.in[I_LNB][l * DA + c];
    float acc[32];
#pragma unroll
    for (int t = 0; t < 32; ++t) acc[t] = cbias;
    int rowbase, nval;
    if (sp < 136) {
        const int b = sp / 17, k2 = sp - b * 17, nvalid = (k2 == 16) ? 16 : 128, seqrow0 = b * TP, tb = 128 * k2 + 32 * sub;
        nval = nvalid - 32 * sub; rowbase = seqrow0 + tb;
        if (nval > 0) {
#pragma unroll
            for (int tt = 0; tt < 62; ++tt) {
                const int ti = tb - 30 + tt;
                const float v = ti >= 0 ? bf2f(U[(size_t)(seqrow0 + ti) * 512 + c]) : 0.f;
#pragma unroll
                for (int t = 0; t < 32; ++t) { const int kk = tt - t; if (kk >= 0 && kk <= 30) acc[t] += w[kk] * v; }
            }
        }
    } else {
        nval = 32; const int s0 = 16 * (sp - 136) + 4 * sub; rowbase = MP + 8 * s0;
        const float* st = F.in[I_SCA] + (size_t)l * NB_S * 30 * DA;
#pragma unroll
        for (int hs = 0; hs < 4; ++hs) {
            const int s = s0 + hs, rowS = MP + 8 * s;
#pragma unroll
            for (int tt = 0; tt < 38; ++tt) {
                const float v = tt < 30 ? st[((size_t)s * 30 + tt) * DA + c] : bf2f(U[(size_t)(rowS + tt - 30) * 512 + c]);
#pragma unroll
                for (int t = 0; t < 8; ++t) { const int kk = tt - t; if (kk >= 0 && kk <= 30) acc[8 * hs + t] += w[kk] * v; }
            }
        }
    }
    LAS f32x2* red = (LAS f32x2*)(F.lds + LDS_RED);
    float s1[32], s2[32];
#pragma unroll
    for (int t = 0; t < 32; ++t) { s1[t] = acc[t]; s2[t] = acc[t] * acc[t]; }
    const float r1 = reduce_scatter32(s1, F.lane), r2 = reduce_scatter32(s2, F.lane);
    __syncthreads();
    if ((F.lane & 1) == 0) red[F.wave * 32 + (F.lane >> 1)] = (f32x2){r1, r2};
    __syncthreads();
    if (nval > 0) {
#pragma unroll
        for (int t = 0; t < 32; ++t) {
            const f32x2 a = red[F.wave * 32 + t], o = red[(F.wave ^ 1) * 32 + t];
            const float mean = (a.x + o.x) * (1.0f / 128.0f), var = (a.y + o.y) * (1.0f / 128.0f) - mean * mean;
            const float rstd = __builtin_amdgcn_rsqf(fmaxf(var, 0.f) + EPS);
            const float y = (acc[t] - mean) * rstd * lg + lb;
            if (t < nval) YAB[(size_t)(rowbase + t) * D + c] = (bf16_t)f2bf(silu_f(y));
        }
    }
}

constexpr int WJ_TILE = 9728;
constexpr int LDS_WT = 8 * WJ_TILE;
typedef short bf16x8_t __attribute__((ext_vector_type(8)));

__device__ __forceinline__ void mix_b_wave_jobs(Frame& F, int l) {
    const int lane = F.lane, wave = F.wave, fr = lane & 15, fq = lane >> 4, h = blockIdx.x & 7;
    const bf16_t* BX = (const bf16_t*)(F.ws + WS_BX);
    bf16_t* YAB = (bf16_t*)(F.ws + WS_YAB); bf16_t* PCG = (bf16_t*)(F.ws + WS_XB);
    LAS bf16_t* WT = (LAS bf16_t*)(F.lds + LDS_WT);
    LAS bf16_t* tile = (LAS bf16_t*)(F.lds + wave * WJ_TILE);
    __syncthreads();
    {
        const f32x4* gr = (const f32x4*)(F.in[I_WRG] + (size_t)(l * 8 + h) * 4096); const f32x4* gx = (const f32x4*)(F.in[I_WIG] + (size_t)(l * 8 + h) * 4096);
#pragma unroll
        for (int e = 0; e < 2; ++e) {
            const int idx = F.tid + e * 512, i = idx >> 4, j4 = (idx & 15) * 4;
            const f32x4 a = gr[idx], b = gx[idx];
#pragma unroll
            for (int d = 0; d < 4; ++d) { WT[(j4 + d) * 72 + i] = (bf16_t)f2bf(a[d]); WT[(64 + j4 + d) * 72 + i] = (bf16_t)f2bf(b[d]); }
        }
    }
    float bra[4], bix[4], sp[4];
#pragma unroll
    for (int nt = 0; nt < 4; ++nt) {
        const int c = 64 * h + 16 * nt + fr;
        bra[nt] = F.in[I_BRG][l * DB + c]; bix[nt] = F.in[I_BIG][l * DB + c];
        sp[nt] = log1pf(expf(-F.in[I_LAM][l * DB + c]));
    }
    __syncthreads();
    for (int q = (int)(blockIdx.x >> 3) * 8 + wave; q < NQ; q += 256) {
        const bool prompt = q < NQ_P;
        int row0, t0, nvalid;
        if (prompt) { const int b_ = q / NCH_P, k = q - b_ * NCH_P; row0 = b_ * TP + 64 * k; t0 = 64 * k; nvalid = (k == NCH_P - 1) ? 16 : 64; }
        else { row0 = MP + 64 * (q - NQ_P); t0 = 0; nvalid = 64; }
        int ln = lane; asm volatile("" : "+v"(ln));
#pragma unroll
        for (int i = 0; i < 9; ++i) {
            const int p = ln + 64 * i;
            if (p < 536) {
                const int rr = p >> 3, pc = p & 7, row = rr - 3;
                const bool okr = prompt ? (t0 + row >= 0) : (row >= 0);
                u32x4 v = *(const u32x4*)(BX + (size_t)(row0 + (okr ? row : 0)) * 512 + 64 * h + 8 * pc);
                if (!okr) v = (u32x4){0u, 0u, 0u, 0u};
                *(LAS u32x4*)(tile + rr * 72 + 8 * pc) = v;
            }
        }
        float wb[4][4], bb[4];
        { int fr_l = fr; asm volatile("" : "+v"(fr_l));
#pragma unroll
        for (int nt = 0; nt < 4; ++nt) {
            const int c = 64 * h + 16 * nt + fr_l;
#pragma unroll
            for (int k = 0; k < 4; ++k) wb[k][nt] = F.in[I_CBW][((size_t)l * 4 + k) * DB + c];
            bb[nt] = F.in[I_CBB][l * DB + c];
        } }
        float cbv[4][4][4];
#pragma unroll
        for (int mt = 0; mt < 4; ++mt)
#pragma unroll
            for (int nt = 0; nt < 4; ++nt) {
                const int tb = 16 * mt + 4 * fq; float x[7];
#pragma unroll
                for (int i = 0; i < 7; ++i) x[i] = bf2f(tile[(tb + i) * 72 + 16 * nt + fr]);
                if (!prompt && !(fq & 1)) {
                    const int s = 8 * (q - NQ_P) + 2 * mt + (fq >> 1);
                    const float* st = F.in[I_SCB] + ((size_t)l * NB_S + s) * 3 * DB + 64 * h + 16 * nt + fr;
                    x[0] = st[0]; x[1] = st[DB]; x[2] = st[2 * DB];
                }
#pragma unroll
                for (int e = 0; e < 4; ++e) cbv[mt][nt][e] = bb[nt] + wb[0][nt] * x[e] + wb[1][nt] * x[e + 1] + wb[2][nt] * x[e + 2] + wb[3][nt] * x[e + 3];
            }
        asm volatile("s_waitcnt lgkmcnt(0)" ::: "memory");
#pragma unroll
        for (int mt = 0; mt < 4; ++mt)
#pragma unroll
            for (int nt = 0; nt < 4; ++nt)
#pragma unroll
                for (int e = 0; e < 4; ++e) tile[(16 * mt + 4 * fq + e) * 72 + 16 * nt + fr] = (bf16_t)f2bf(cbv[mt][nt][e]);
        asm volatile("s_waitcnt lgkmcnt(0)" ::: "memory");
        float Pc[4] = {1.f, 1.f, 1.f, 1.f}, Hc[4] = {0.f, 0.f, 0.f, 0.f};
#pragma unroll
        for (int mt = 0; mt < 4; ++mt) {
            const bf16x8_t a0 = *(const LAS bf16x8_t*)(tile + (16 * mt + fr) * 72 + 8 * fq), a1 = *(const LAS bf16x8_t*)(tile + (16 * mt + fr) * 72 + 32 + 8 * fq);
#pragma unroll
            for (int nt = 0; nt < 4; ++nt) {
                const int c = 64 * h + 16 * nt + fr;
                const bf16x8_t br0 = *(const LAS bf16x8_t*)(WT + (16 * nt + fr) * 72 + 8 * fq), br1 = *(const LAS bf16x8_t*)(WT + (16 * nt + fr) * 72 + 32 + 8 * fq);
                const bf16x8_t bi0 = *(const LAS bf16x8_t*)(WT + (64 + 16 * nt + fr) * 72 + 8 * fq), bi1 = *(const LAS bf16x8_t*)(WT + (64 + 16 * nt + fr) * 72 + 32 + 8 * fq);
                f32x4 accR = {0.f, 0.f, 0.f, 0.f}, accI = {0.f, 0.f, 0.f, 0.f};
                accR = __builtin_amdgcn_mfma_f32_16x16x32_bf16(a0, br0, accR, 0, 0, 0); accR = __builtin_amdgcn_mfma_f32_16x16x32_bf16(a1, br1, accR, 0, 0, 0);
                accI = __builtin_amdgcn_mfma_f32_16x16x32_bf16(a0, bi0, accI, 0, 0, 0); accI = __builtin_amdgcn_mfma_f32_16x16x32_bf16(a1, bi1, accI, 0, 0, 0);
                float P4[4], H4[4]; float hp = 0.f, pp = 1.f;
#pragma unroll
                for (int e = 0; e < 4; ++e) {
                    const float r = sigmoid_f(accR[e] + bra[nt]), ig = sigmoid_f(accI[e] + bix[nt]);
                    const float la = -8.0f * r * sp[nt], a = __expf(la), bt = __builtin_amdgcn_sqrtf(fmaxf(__builtin_fmaf(-a, a, 1.0f), 0.f)) * (ig * bf2f(tile[(16 * mt + 4 * fq + e) * 72 + 16 * nt + fr]));
                    hp = a * hp + bt; pp = pp * a; H4[e] = hp; P4[e] = pp;
                }
                float pex = 1.f, hex = 0.f;
#pragma unroll
                for (int d = 3; d >= 1; --d) {
                    const float ps = __shfl(pp, lane - 16 * d), hs = __shfl(hp, lane - 16 * d);
                    const bool use = prompt ? (fq >= d) : (d == 1 && (fq & 1));
                    if (use) { hex = ps * hex + hs; pex = pex * ps; }
                }
                const float pin = prompt ? Pc[nt] * pex : pex, hin = prompt ? pex * Hc[nt] + hex : hex;
                float Pf[4], Hf[4];
#pragma unroll
                for (int e = 0; e < 4; ++e) { Hf[e] = H4[e] + P4[e] * hin; Pf[e] = P4[e] * pin; }
                Pc[nt] = __shfl(Pf[3], fr + 48); Hc[nt] = __shfl(Hf[3], fr + 48);
#pragma unroll
                for (int e = 0; e < 4; ++e) {
                    const int tl = 16 * mt + 4 * fq + e;
                    if (tl < nvalid) { const size_t row = (size_t)(row0 + tl); YAB[row * D + 512 + c] = (bf16_t)f2bf(Hf[e]); PCG[row * 512 + c] = (bf16_t)f2bf(Pf[e]); }
                }
                if (prompt) { if (16 * (mt + 1) == nvalid && fq == 3) ((f32x2*)(F.ws + WS_SUMM))[(size_t)q * 512 + c] = (f32x2){Pf[3], Hf[3]}; }
                else if (fq & 1) { const int s = 8 * (q - NQ_P) + 2 * mt + (fq >> 1); ((f32x2*)(F.ws + WS_LAST))[(size_t)s * 512 + c] = (f32x2){Pf[3], Hf[3]}; }
            }
        }
    }
}

constexpr int LDS_ARED = 98304;
__device__ __forceinline__ float reduce_scatter16(float (&v)[16], int lane) {
#define RS_STEP(H, M) { const bool up = (lane & (M)) != 0; _Pragma("unroll") for (int i = 0; i < (H); ++i) { const float snd = up ? v[i] : v[i + (H)], kp = up ? v[i + (H)] : v[i]; v[i] = kp + __shfl_xor(snd, (M)); } }
    RS_STEP(8, 32) RS_STEP(4, 16) RS_STEP(2, 8) RS_STEP(1, 4)
#undef RS_STEP
    float r = v[0]; r += __shfl_xor(r, 2); r += __shfl_xor(r, 1); return r;
}
__device__ __forceinline__ void mix_a_wave_jobs(Frame& F, int l) {
    const int lane = F.lane, wave = F.wave, gi = wave & 3, c0 = 128 * gi + 2 * lane;
    const bf16_t* U = (const bf16_t*)(F.ws + WS_U); bf16_t* YAB = (bf16_t*)(F.ws + WS_YAB);
    const float* cw = F.in[I_CAW] + (size_t)l * 31 * DA;
    f32x2 w[31];
#pragma unroll
    for (int k = 0; k < 31; ++k) w[k] = *(const f32x2*)(cw + k * DA + c0);
    const f32x2 cbv = *(const f32x2*)(F.in[I_CAB] + l * DA + c0), lgv = *(const f32x2*)(F.in[I_LNG] + l * DA + c0), lbv = *(const f32x2*)(F.in[I_LNB] + l * DA + c0);
    LAS f32x2* red = (LAS f32x2*)(F.lds + LDS_ARED + wave * 128);
    for (int tb = 511 - ((int)blockIdx.x * 2 + (wave >> 2)); tb < 1096; tb += 512) {
        f32x2 a[16];
#pragma unroll
        for (int t = 0; t < 16; ++t) a[t] = cbv;
        int rowbase;
        if (tb < 1032) {
            const int b = tb / 129, kb = tb - b * 129, t0 = 16 * kb, seqrow0 = b * TP; rowbase = seqrow0 + t0;
            unsigned raw[46];
#pragma unroll
            for (int tt = 0; tt < 46; ++tt) { const int ti = t0 - 30 + tt; raw[tt] = *(const unsigned*)(U + (size_t)(seqrow0 + (ti < 0 ? 0 : ti)) * 512 + c0); }
#pragma unroll
            for (int tt = 0; tt < 46; ++tt) {
                const unsigned rw = ((t0 - 30 + tt) >= 0) ? raw[tt] : 0u;
                const f32x2 v = {__uint_as_float(rw << 16), __uint_as_float(rw & 0xffff0000u)};
#pragma unroll
                for (int t = 0; t < 16; ++t) { const int kk = tt - t; if (kk >= 0 && kk <= 30) a[t] += w[kk] * v; }
            }
        } else {
            const int s0 = 2 * (tb - 1032); rowbase = MP + 8 * s0;
            const float* st = F.in[I_SCA] + (size_t)l * NB_S * 30 * DA;
#pragma unroll
            for (int hs = 0; hs < 2; ++hs) {
                const int s = s0 + hs, rowS = MP + 8 * s;
#pragma unroll
                for (int tt = 0; tt < 38; ++tt) {
                    f32x2 v;
                    if (tt < 30) v = *(const f32x2*)(st + ((size_t)s * 30 + tt) * DA + c0);
                    else { const unsigned rw = *(const unsigned*)(U + (size_t)(rowS + tt - 30) * 512 + c0); v = (f32x2){__uint_as_float(rw << 16), __uint_as_float(rw & 0xffff0000u)}; }
#pragma unroll
                    for (int t = 0; t < 8; ++t) { const int kk = tt - t; if (kk >= 0 && kk <= 30) a[8 * hs + t] += w[kk] * v; }
                }
            }
        }
        float s1[16], s2[16];
#pragma unroll
        for (int t = 0; t < 16; ++t) { s1[t] = a[t].x + a[t].y; s2[t] = a[t].x * a[t].x + a[t].y * a[t].y; }
        const float r1 = reduce_scatter16(s1, lane), r2 = reduce_scatter16(s2, lane);
        if ((lane & 3) == 0) red[lane >> 2] = (f32x2){r1, r2};
        asm volatile("s_waitcnt lgkmcnt(0)" ::: "memory");
#pragma unroll
        for (int t = 0; t < 16; ++t) {
            const f32x2 st_ = red[t];
            const float mean = st_.x * (1.0f / 128.0f), var = st_.y * (1.0f / 128.0f) - mean * mean;
            const float rstd = __builtin_amdgcn_rsqf(fmaxf(var, 0.f) + EPS);
            const f32x2 y = (a[t] - mean) * rstd * lgv + lbv;
            *(unsigned*)(YAB + (size_t)(rowbase + t) * D + c0) = pk2(silu_f(y.x), silu_f(y.y));
        }
        asm volatile("s_waitcnt lgkmcnt(0)" ::: "memory");
    }
}

__device__ __forceinline__ void mix_job_state(Frame& F, int l, int s) {
    const int c = F.tid;
    const bf16_t* U = (const bf16_t*)(F.ws + WS_U); const bf16_t* BX = (const bf16_t*)(F.ws + WS_BX);
    if (s < NB_P) {
        const int b = s; float* oa = F.out + O_CAP + ((size_t)l * NB_P + b) * 30 * DA; float* ob = F.out + O_CBP + ((size_t)l * NB_P + b) * 3 * DB;
#pragma unroll 10
        for (int i = 0; i < 30; ++i) oa[i * DA + c] = bf2f(U[(size_t)(b * TP + TP - 30 + i) * 512 + c]);
#pragma unroll
        for (int i = 0; i < 3; ++i) ob[i * DB + c] = bf2f(BX[(size_t)(b * TP + TP - 3 + i) * 512 + c]);
    } else {
        const int b = s - NB_P, rowS = MP + 8 * b; float* oa = F.out + O_CAS + ((size_t)l * NB_S + b) * 30 * DA; float* ob = F.out + O_CBS + ((size_t)l * NB_S + b) * 3 * DB;
        const float* st = F.in[I_SCA] + ((size_t)l * NB_S + b) * 30 * DA;
#pragma unroll 11
        for (int i = 0; i < 22; ++i) oa[i * DA + c] = st[(8 + i) * DA + c];
#pragma unroll
        for (int i = 22; i < 30; ++i) oa[i * DA + c] = bf2f(U[(size_t)(rowS + i - 22) * 512 + c]);
#pragma unroll
        for (int i = 0; i < 3; ++i) ob[i * DB + c] = bf2f(BX[(size_t)(rowS + 5 + i) * 512 + c]);
    }
}

__device__ __forceinline__ void mix_a_phase(Frame& F, int l, int sel) {
    if (sel & 1) mix_b_wave_jobs(F, l);
    if (!(sel & 2)) return;
    { int t_ = F.tid; asm volatile("" : "+v"(t_)); F.tid = t_; F.lane = t_ & 63; }
    mix_a_wave_jobs(F, l);
    { int t_ = F.tid; asm volatile("" : "+v"(t_)); F.tid = t_; F.lane = t_ & 63; }
    const int b = blockIdx.x;
    if (b >= 64 && b - 64 < NB_P + NB_S) mix_job_state(F, l, b - 64);
}

__device__ __forceinline__ void mix_c_phase(Frame& F, int l, int rep) {
    const int c = F.tid;
    bf16_t* YAB = (bf16_t*)(F.ws + WS_YAB); const bf16_t* PCG = (const bf16_t*)(F.ws + WS_XB); const bf16_t* GGp = (const bf16_t*)(F.ws + WS_GG);
    const f32x2* SUMM = (const f32x2*)(F.ws + WS_SUMM); const f32x2* LAST = (const f32x2*)(F.ws + WS_LAST);
    for (int job = blockIdx.x; job < NQ * 2; job += F.G) {
        const int q = job >> 1, hh = job & 1;
        if (q < NQ_P) {
            const int b = q / NCH_P, k = q - b * NCH_P, nvalid = (k == NCH_P - 1) ? 16 : 64, row0 = b * TP + 64 * k;
            if (32 * hh >= nvalid) continue;
            float carry = 0.f;
            {
                f32x2 ph[32];
#pragma unroll
                for (int e = 0; e < 32; ++e) { const int kk = e < k ? e : 0; ph[e] = SUMM[(size_t)(b * NCH_P + kk) * 512 + c]; }
#pragma unroll
                for (int e = 0; e < 32; ++e) { const float px = e < k ? ph[e].x : 1.f, py = e < k ? ph[e].y : 0.f; carry = px * carry + py; }
            }
            const int r1 = (32 * hh + 32 < nvalid) ? 32 * hh + 32 : nvalid;
            for (int r = 32 * hh; r < r1; ++r) {
                const size_t row = row0 + r;
                const float y = (bf2f(YAB[row * D + 512 + c]) + bf2f(PCG[row * 512 + c]) * carry) * bf2f(GGp[row * 512 + c]);
                if (rep) ((bf16_t*)(F.ws + WS_U))[row * 512 + c] = (bf16_t)f2bf(y); else
                YAB[row * D + 512 + c] = (bf16_t)f2bf(y);
            }
            if (k == NCH_P - 1 && hh == 0) { const f32x2 ph = SUMM[(size_t)q * 512 + c]; F.out[O_HP + ((size_t)l * NB_P + b) * DB + c] = ph.y + ph.x * carry; }
        } else {
            const int row0 = MP + 64 * (q - NQ_P);
            for (int r = 32 * hh; r < 32 * hh + 32; ++r) {
                const int s = 8 * (q - NQ_P) + (r >> 3); const size_t row = row0 + r;
                const float carry = F.in[I_SH][((size_t)l * NB_S + s) * DB + c];
                const float y = (bf2f(YAB[row * D + 512 + c]) + bf2f(PCG[row * 512 + c]) * carry) * bf2f(GGp[row * 512 + c]);
                if (rep) ((bf16_t*)(F.ws + WS_U))[row * 512 + c] = (bf16_t)f2bf(y); else
                YAB[row * D + 512 + c] = (bf16_t)f2bf(y);
                if ((r & 7) == 7) { const f32x2 ph = LAST[(size_t)s * 512 + c]; F.out[O_HS + ((size_t)l * NB_S + s) * DB + c] = ph.y + ph.x * carry; }
            }
        }
    }
}

constexpr int NPH = 18;
#ifndef PHMASK
#define PHMASK 127
#endif
#define DUPMASK 0
#define MIXSEL 1
__global__ void __launch_bounds__(NWAVES * 64, 2) mega_fwd(Args args) {
    extern __shared__ __attribute__((aligned(16))) unsigned char lds[];
    Frame F;
    F.lds = (LAS unsigned char*)lds; F.G = gridDim.x;
    if (threadIdx.x < 2) ((volatile LAS unsigned*)(F.lds + LDS_BARST))[threadIdx.x] = 0u;
    __syncthreads();
    if (args.ph_hi - args.ph_lo > 1) (void)xcd_barrier_post((unsigned*)(args.ws + WS_BAR), (volatile LAS unsigned*)(F.lds + LDS_BARST));
    const int ph_lo = args.ph_lo, ph_hi = args.ph_hi;
    const int wave_s = __builtin_amdgcn_readfirstlane(threadIdx.x >> 6);
    for (int st = 2 * ph_lo; st < 2 * ph_hi; ++st) {
        const int ph = st >> 1, rep = st & 1;
        bool run = true;
        if (rep == 1) { const int ty = (ph == 0) ? 1 : (ph == NPH - 1) ? 2 : (int)((0x0804084020100804ull >> (8 * ((ph - 1) & 7))) & 255ull);
            run = (DUPMASK & ty) != 0; }
        if (run) {
        const __attribute__((address_space(4))) unsigned char* kp = (const __attribute__((address_space(4))) unsigned char*)__builtin_amdgcn_kernarg_segment_ptr();
        asm volatile("" : "+s"(kp));
        const __attribute__((address_space(4))) Args* ap = (const __attribute__((address_space(4))) Args*)kp;
        F.in = ap->in; F.out = ap->out; F.ws = ap->ws;
        { int t_ = wave_s * 64 + hw_lane_id(); asm volatile("" : "+v"(t_)); F.tid = t_; F.lane = t_ & 63; F.wave = wave_s; }
        unsigned char* ws = F.ws;
        float* SS = (float*)(ws + WS_SS);
        if ((PHMASK & 1) && ph == 0) p0_prologue(F);
        else if ((PHMASK & 2) && ph == NPH - 1) final_phase(F);
        else {
            const int l = (ph - 1) >> 3, s = (ph - 1) & 7;
            if ((PHMASK & 4) && (s == 0 || s == 6)) {
                pg8::Gemm g{(const bf16_t*)(ws + WS_XB), (const bf16_t*)(ws + (s == 0 ? WS_WGU1 : WS_WGU2)), MPAD, 2 * FF, D};
                pg8::StaticOrder S; S.init(MPAD, 2 * FF, D, F.G, (int)blockIdx.x);
                EpiGU E{(bf16_t*)(ws + WS_ACT), SS + (size_t)(s == 0 ? 3 * l : 3 * l + 2) * MPAD};
                pg8::gemm_phase<EpiGU, pg8::StaticOrder, true, true>(F.lds, g, S, E, wave_s);
            } else if ((PHMASK & 8) && (s == 1 || s == 7 || s == 5)) {
                const bool down = (s != 5);
                pg8::Gemm g{(const bf16_t*)(ws + (down ? WS_ACT : WS_YAB)), (const bf16_t*)(ws + (s == 1 ? WS_WD1 : (s == 7 ? WS_WD2 : WS_WOUT))), MPAD, D, down ? FF : D};
                pg8::DpSplit S; S.init(MPAD, D, down ? FF : D, F.G, (int)blockIdx.x, F.out);
                EpiRes E{(float*)(ws + WS_X), (bf16_t*)(ws + WS_XB), (rep ? (float*)(ws + 0x300000) : SS + (size_t)(s == 1 ? 3 * l + 1 : (s == 5 ? 3 * l + 2 : 3 * l + 3)) * MPAD), rep ? 0.0f : (down ? 0.5f : 1.0f)};
                pg8::gemm_phase<EpiRes, pg8::DpSplit, true, true>(F.lds, g, S, E, wave_s);
                if (blockIdx.x >= 80 && rep == 0) {
                    const int gw = ((int)blockIdx.x - 80) * NWAVES + F.wave, NGW = (F.G - 80) * NWAVES;
                    if (l == 0 && s == 1) convert_mats(F, 1, 0, 1, gw, NGW);
                    else if (l == 0 && s == 7) convert_mats(F, 1, 1, 3, gw, NGW);
                    else if (l == 1 && s == 1) convert_mats(F, 1, 3, 5, gw, NGW);
                    else if (l == 1 && s == 5) convert_mats(F, 1, 5, 6, gw, NGW);
                }
                { XcdBarrier xb; xb.bar = (unsigned*)(ws + WS_BAR); xb.x = xb_xcc_id(); xb.st = (volatile LAS unsigned*)(F.lds + LDS_BARST); xcd_barrier(xb, wave_s == 0 && hw_lane_id() == 0); }
                res_fixup(F, E, S);
            } else if ((PHMASK & 16) && s == 2) {
                pg8::Gemm g{(const bf16_t*)(ws + WS_XB), (const bf16_t*)(ws + WS_WIN), MPAD, 2048, D};
                pg8::StaticOrder S; S.init(MPAD, 2048, D, F.G, (int)blockIdx.x);
                EpiWin E{(bf16_t*)(ws + WS_U), (bf16_t*)(ws + WS_BX), (bf16_t*)(ws + WS_GG), SS + (size_t)(3 * l + 1) * MPAD};
                pg8::gemm_phase<EpiWin, pg8::StaticOrder, true, true>(F.lds, g, S, E, wave_s);
            } else if ((PHMASK & 32) && s == 3) mix_a_phase(F, l, rep ? MIXSEL : 3);
            else if ((PHMASK & 64) && s == 4) mix_c_phase(F, l, rep);
        }
        }
        if (rep == 1 && ph + 1 < ph_hi) {
            const __attribute__((address_space(4))) Args* ap2 = (const __attribute__((address_space(4))) Args*)__builtin_amdgcn_kernarg_segment_ptr();
            unsigned* barw = (unsigned*)(ap2->ws + WS_BAR);
            if (ph_hi > 1000) cg::this_grid().sync();
            XcdBarrier xb; xb.bar = barw; xb.x = xb_xcc_id(); xb.st = (volatile LAS unsigned*)(F.lds + LDS_BARST);
            xcd_barrier(xb, wave_s == 0 && hw_lane_id() == 0);
        }
    }
}

#ifndef MK_FUSED
#define MK_FUSED 1
#endif
extern "C" void kernel_launch(void* const* d_in, const int* in_sizes, int n_in, void* d_out, int out_size, void* d_ws, size_t ws_size, hipStream_t stream) {
    static int grid = 0;
    if (grid == 0) {
        if (n_in != N_IN || (size_t)out_size != O_END || ws_size < WS_END) { fprintf(stderr, "kernel_launch: unexpected shapes: n_in %d out %d ws %zu (need %zu)\n", n_in, out_size, ws_size, (size_t)WS_END); grid = -1; return; }
        int dev = 0, cus = 0, per_cu = 0;
        hipGetDevice(&dev); hipDeviceGetAttribute(&cus, hipDeviceAttributeMultiprocessorCount, dev);
        if (hipFuncSetAttribute((const void*)mega_fwd, hipFuncAttributeMaxDynamicSharedMemorySize, LDS_BYTES) != hipSuccess) { fprintf(stderr, "kernel_launch: hipFuncSetAttribute failed\n"); grid = -1; return; }
        if (hipOccupancyMaxActiveBlocksPerMultiprocessor(&per_cu, (const void*)mega_fwd, NWAVES * 64, LDS_BYTES) != hipSuccess || per_cu < 1) { fprintf(stderr, "kernel_launch: occupancy query failed (%d)\n", per_cu); (void)hipGetLastError(); per_cu = 1; }
        grid = cus * 1;
        fprintf(stderr, "kernel_launch: cus %d per_cu %d grid %d ws %zu\n", cus, per_cu, grid, ws_size);
    }
    if (grid < 0) return;
    Args a{};
    for (int i = 0; i < N_IN; ++i) a.in[i] = (const float*)d_in[i];
    a.out = (float*)d_out; a.ws = (unsigned char*)d_ws;
#if MK_FUSED
    a.ph_lo = 0; a.ph_hi = NPH;
    if (hipMemsetAsync((unsigned char*)d_ws + WS_BAR, 0, 0x10000, stream) != hipSuccess) { fprintf(stderr, "kernel_launch: memset of the barrier words failed\n"); return; }
    void* kargs[] = {&a};
    hipError_t e = hipLaunchCooperativeKernel((const void*)mega_fwd, dim3(grid), dim3(NWAVES * 64), kargs, LDS_BYTES, stream);
    if (e != hipSuccess) fprintf(stderr, "cooperative launch failed: %s (grid %d)\n", hipGetErrorString(e), grid);
#else
    for (int ph = 0; ph < NPH; ++ph) { a.ph_lo = ph; a.ph_hi = ph + 1; hipLaunchKernelGGL(mega_fwd, dim3(grid), dim3(NWAVES * 64), LDS_BYTES, stream, a); }
#endif
}
```

```cpp
#include <hip/hip_runtime.h>
#include <hip/hip_cooperative_groups.h>
#include <cstdio>
#include <cstdint>
namespace cg = cooperative_groups;
__device__ __forceinline__ int hw_lane_id() { int l; asm volatile("v_mbcnt_lo_u32_b32 %0, -1, 0\n\tv_mbcnt_hi_u32_b32 %0, -1, %0" : "=v"(l)); return l; }
namespace pg8 {
#define PG8_LAS __attribute__((address_space(3)))
typedef unsigned short bf16_t;
typedef short bf16x8 __attribute__((ext_vector_type(8)));
typedef float f32x4 __attribute__((ext_vector_type(4)));
typedef unsigned u32x4 __attribute__((ext_vector_type(4)));
constexpr int BM = 256, BK = 64, HALF = 128, HTB = HALF * BK * 2  , STAGE_BYTES = 8 * HTB, NXCD = 8, WGM = 8;

__host__ __device__ __forceinline__ int lds_byte(int r, int c) { const int st = (r >> 4) * 2 + (c >> 5), rr = r & 15, cc = c & 31, ob = rr * 64 + cc * 2; return st * 1024 + (ob ^ (((ob >> 9) & 1) << 5)); }
__host__ __device__ __forceinline__ void stage_rc(int b, int& R, int& C) { const int st = b / 1024, sb = b % 1024, swz = sb ^ (((sb >> 9) & 1) << 5); R = (st >> 1) * 16 + swz / 64; C = (st & 1) * 32 + (swz % 64) / 2; }
__host__ __device__ __forceinline__ int perm32(int rho) { const int n = rho >> 4, i = rho & 15; return 8 * (i >> 2) + 4 * n + (i & 3); }

struct Unit { int pm, pn, k0, len, kind; };
struct Gemm { const bf16_t* A; const bf16_t* Bt; int M, N, K; };

struct StaticOrder {
    static constexpr bool STREAMK = false;
    int nM, nN, nwg, G, c, nt;
    __host__ __device__ void init(int M, int N, int K, int G_, int c_) { nM = M / BM; nN = N / BM; nwg = nM * nN; G = G_; c = c_; nt = K / BK; }
    __host__ __device__ bool next(int i, Unit& u) const {
        const long L = (long)i * G + c; if (L >= nwg) return false;
        int wgid = (int)L; { const int q = nwg / NXCD, r = nwg % NXCD, xcd = wgid % NXCD, off = wgid / NXCD; wgid = (xcd < r ? xcd * (q + 1) : r * (q + 1) + (xcd - r) * q) + off; }
        const int nig = WGM * nN, gid = wgid / nig, fm = gid * WGM, gsz = (nM - fm) < WGM ? (nM - fm) : WGM;
        u.pm = fm + ((wgid % nig) % gsz); u.pn = (wgid % nig) / gsz; u.k0 = 0; u.len = nt; u.kind = 0; return true;
    }
    __device__ __forceinline__ void a_ready(const Unit&) const {}
    __device__ __forceinline__ void done(const Unit&) const {}
    __device__ __forceinline__ void store_partial(const f32x4 (&)[2][2][4][2], int, int, int) const {}
    __device__ __forceinline__ void load_partial(f32x4 (&)[2][2][4][2], int, int, int) const {}
};
struct DpSplit {
    static constexpr bool STREAMK = true;
    int nM, nN, nwg, G, c, nt; float* slab;
    __device__ __forceinline__ void init(int M, int N, int K, int G_, int c_, float* slab_) { nM = M / BM; nN = N / BM; nwg = nM * nN; G = G_; c = c_; nt = K / BK; slab = slab_; }
    __device__ __forceinline__ void unit_of(int L, Unit& u) const {
        int wgid = L; { const int q = nwg / NXCD, r = nwg % NXCD, xcd = wgid % NXCD, off = wgid / NXCD; wgid = (xcd < r ? xcd * (q + 1) : r * (q + 1) + (xcd - r) * q) + off; }
        const int nig = WGM * nN, gid = wgid / nig, fm = gid * WGM, gsz = (nM - fm) < WGM ? (nM - fm) : WGM;
        u.pm = fm + ((wgid % nig) % gsz); u.pn = (wgid % nig) / gsz;
    }
    __device__ __forceinline__ bool next(int i, Unit& u) const {
        if (i == 0) { if (c >= nwg) return false; unit_of(c, u); u.k0 = 0; u.len = nt; u.kind = 0; return true; }
        if (i == 1 && c < 4 * (nwg - G)) {
            unit_of(G + (c >> 2), u);
            const int part = c & 3, lenp = (nt >> 2) & ~1, rem2 = (nt - 4 * lenp) >> 1;
            u.len = lenp + (part < rem2 ? 2 : 0); u.k0 = part * lenp + 2 * (part < rem2 ? part : rem2); u.kind = 1; return true;
        }
        return false;
    }
    __device__ __forceinline__ void a_ready(const Unit&) const {}
    __device__ __forceinline__ void done(const Unit&) const {}
    __device__ __forceinline__ void store_partial(const f32x4 (&acc)[2][2][4][2], int tid, int wid, int lane) const {
        typedef unsigned u32x4v __attribute__((ext_vector_type(4)));
        asm volatile("" : "+v"(tid));
        const __amdgpu_buffer_rsrc_t r = __builtin_amdgcn_make_buffer_rsrc((void*)(slab + (size_t)c * 65536), 0, 262144, 0x00020000);
        const int vo = tid * 16;
#pragma unroll
        for (int ai = 0; ai < 2; ++ai)
#pragma unroll
            for (int bj = 0; bj < 2; ++bj)
#pragma unroll
                for (int m = 0; m < 4; ++m)
#pragma unroll
                    for (int n = 0; n < 2; ++n) __builtin_amdgcn_raw_buffer_store_b128(__builtin_bit_cast(u32x4v, acc[ai][bj][m][n]), r, vo, (((ai * 2 + bj) * 4 + m) * 2 + n) * 8192, 16);
    }
    __device__ __forceinline__ void load_partial(f32x4 (&)[2][2][4][2], int, int, int) const {}
};

template <class Epi, class Sched, bool ALIGN_EPI = false, bool SP2 = false>
__device__ __forceinline__ void gemm_phase(PG8_LAS unsigned char* lds, const Gemm g, const Sched& S, const Epi& E, const int wave_s) {
    int tid_l = wave_s * 64 + hw_lane_id(); asm volatile("" : "+v"(tid_l));
    const int tid = tid_l, wid = __builtin_amdgcn_readfirstlane(tid >> 6), lane = tid & 63, wr = wid >> 2, wc = wid & 3, fr = lane & 15, fq = lane >> 4;
    const int K = g.K, nt = K / BK;
    unsigned voffA[2], voffB[2];
#pragma unroll
    for (int i = 0; i < 2; ++i) { int R, C; stage_rc(tid * 16 + i * 8192, R, C); const int Rb = Epi::PERM ? ((R & ~31) + perm32(R & 31)) : R;
        voffA[i] = (unsigned)(R * K + C) * 2u; voffB[i] = (unsigned)(Rb * K + C) * 2u; }
    const size_t kstep = (size_t)(BK * 2);
    const size_t hstep = (size_t)HALF * K * 2;
    const size_t tstep = 2 * hstep;
    const unsigned ldsw = (unsigned)wid * 1024u;
    const int aoff = lds_byte(wr * 64 + fr, fq * 8), boff = lds_byte(wc * 32 + fr, fq * 8);
#define PG8_SA(b, h) (((b) * 2 + (h)) * HTB)
#define PG8_SB(b, h) ((4 + (b) * 2 + (h)) * HTB)
#define PG8_STAGE(bufoff, gbase, voff) do { _Pragma("unroll") for (int _i = 0; _i < 2; ++_i) \
        __builtin_amdgcn_global_load_lds((const unsigned*)((const char*)(gbase) + (voff)[_i]), (PG8_LAS unsigned*)(lds + (bufoff) + ldsw + _i * 8192), 16, 0, 0); } while (0)
#define PG8_LDA(dst, b, h) do { _Pragma("unroll") for (int m = 0; m < 4; ++m) _Pragma("unroll") for (int k = 0; k < 2; ++k) dst[m][k] = *(const PG8_LAS bf16x8*)(lds + PG8_SA(b, h) + aoff + m * 2048 + k * 1024); } while (0)
#define PG8_LDB(dst, b, h) do { _Pragma("unroll") for (int n = 0; n < 2; ++n) _Pragma("unroll") for (int k = 0; k < 2; ++k) dst[n][k] = *(const PG8_LAS bf16x8*)(lds + PG8_SB(b, h) + boff + n * 2048 + k * 1024); } while (0)
#define PG8_MMA(ai, bj, At, Bt) do { __builtin_amdgcn_s_setprio(1); _Pragma("unroll") for (int m = 0; m < 4; ++m) _Pragma("unroll") for (int n = 0; n < 2; ++n) _Pragma("unroll") for (int k = 0; k < 2; ++k) \
        acc[ai][bj][m][n] = __builtin_amdgcn_mfma_f32_16x16x32_bf16(Bt[n][k], At[m][k], acc[ai][bj][m][n], 0, 0, 0); __builtin_amdgcn_s_setprio(0); } while (0)
#define PG8_WAIT_V(n) asm volatile("s_waitcnt vmcnt(" #n ")" ::: "memory")
#define PG8_WAIT_L(n) asm volatile("s_waitcnt lgkmcnt(" #n ")" ::: "memory")
#define PG8_BAR __builtin_amdgcn_s_barrier()
#define PG8_SCHED __builtin_amdgcn_sched_barrier(0)
    Unit cur, nxt; int ui = 0;
    if (!S.next(0, cur)) return;
    f32x4 acc[2][2][4][2];
#pragma unroll
    for (int a = 0; a < 2; ++a)
#pragma unroll
        for (int b = 0; b < 2; ++b)
#pragma unroll
            for (int m = 0; m < 4; ++m)
#pragma unroll
                for (int n = 0; n < 2; ++n) acc[a][b][m][n] = (f32x4){0.f, 0.f, 0.f, 0.f};
    if (Sched::STREAMK && cur.kind == 2) S.load_partial(acc, tid, wid, lane);
    if constexpr (Epi::INIT_ACC) { if (cur.kind == 0) E.init(acc, cur, wr, wc, fr, fq); }
    bf16x8 At[4][2], B0[2][2], B1[2][2];
    const char* cA = (const char*)g.A + (size_t)cur.pm * tstep + (size_t)cur.k0 * kstep; const char* cB = (const char*)g.Bt + (size_t)cur.pn * tstep + (size_t)cur.k0 * kstep;
    S.a_ready(cur);
    if constexpr (SP2) {
        PG8_STAGE(PG8_SB(0, 0), cB, voffB); PG8_STAGE(PG8_SB(0, 1), cB + hstep, voffB); PG8_STAGE(PG8_SA(0, 0), cA, voffA); PG8_STAGE(PG8_SA(0, 1), cA + hstep, voffA);
        if (wr == 1) PG8_BAR;
        PG8_WAIT_V(2); PG8_BAR;
        PG8_STAGE(PG8_SB(1, 0), cB + kstep, voffB); PG8_STAGE(PG8_SA(1, 0), cA + kstep, voffA); PG8_STAGE(PG8_SB(1, 1), cB + hstep + kstep, voffB);
        PG8_WAIT_V(6); PG8_BAR;
    } else {
        PG8_STAGE(PG8_SB(0, 0), cB, voffB); PG8_STAGE(PG8_SA(0, 0), cA, voffA); PG8_STAGE(PG8_SB(0, 1), cB + hstep, voffB); PG8_STAGE(PG8_SA(0, 1), cA + hstep, voffA);
        if (wr == 1) PG8_BAR;
        PG8_WAIT_V(4); PG8_BAR;
        PG8_STAGE(PG8_SB(1, 0), cB + kstep, voffB); PG8_STAGE(PG8_SA(1, 0), cA + kstep, voffA); PG8_STAGE(PG8_SB(1, 1), cB + hstep + kstep, voffB);
        PG8_WAIT_V(6); PG8_BAR;
    }
    for (;;) {
        const bool has_next = S.next(ui + 1, nxt);
        const char* nA = has_next ? (const char*)g.A + (size_t)nxt.pm * tstep + (size_t)nxt.k0 * kstep : cA; const char* nB = has_next ? (const char*)g.Bt + (size_t)nxt.pn * tstep + (size_t)nxt.k0 * kstep : cB;
        const int clen = cur.len;
        for (int t = 0; t < clen; t += 2) {
            const bool last = (t == clen - 2);
            const char* a1 = cA + (size_t)(t + 1) * kstep;
            const char* a2 = last ? nA : cA + (size_t)(t + 2) * kstep; const char* b2 = last ? nB : cB + (size_t)(t + 2) * kstep;
            const char* a3 = a2 + kstep; const char* b3 = b2 + kstep;
            if (last && has_next) S.a_ready(nxt);
            if constexpr (SP2) {
            PG8_LDB(B0, 0, 0); PG8_LDB(B1, 0, 1); PG8_SCHED; PG8_LDA(At, 0, 0); PG8_STAGE(PG8_SA(1, 1), a1 + hstep, voffA);
            PG8_WAIT_V(8); PG8_WAIT_L(0); PG8_BAR; PG8_MMA(0, 0, At, B0); PG8_MMA(0, 1, At, B1); PG8_BAR; PG8_SCHED;
            PG8_LDA(At, 0, 1); PG8_STAGE(PG8_SB(0, 0), b2, voffB); PG8_STAGE(PG8_SB(0, 1), b2 + hstep, voffB); PG8_STAGE(PG8_SA(0, 0), a2, voffA);
            PG8_WAIT_V(8); PG8_WAIT_L(0); PG8_BAR; PG8_MMA(1, 0, At, B0); PG8_MMA(1, 1, At, B1); PG8_BAR; PG8_SCHED;
            PG8_LDB(B0, 1, 0); PG8_LDB(B1, 1, 1); PG8_SCHED; PG8_LDA(At, 1, 0); PG8_STAGE(PG8_SA(0, 1), a2 + hstep, voffA);
            PG8_WAIT_V(8); PG8_WAIT_L(0); PG8_BAR; PG8_MMA(0, 0, At, B0); PG8_MMA(0, 1, At, B1); PG8_BAR; PG8_SCHED;
            PG8_LDA(At, 1, 1); PG8_STAGE(PG8_SB(1, 0), b3, voffB); PG8_STAGE(PG8_SB(1, 1), b3 + hstep, voffB); PG8_STAGE(PG8_SA(1, 0), a3, voffA);
            PG8_WAIT_V(8); PG8_WAIT_L(0); PG8_BAR; PG8_MMA(1, 0, At, B0); PG8_MMA(1, 1, At, B1); PG8_BAR; PG8_SCHED;
            } else {
            PG8_LDB(B0, 0, 0); PG8_SCHED; PG8_LDA(At, 0, 0); PG8_STAGE(PG8_SA(1, 1), a1 + hstep, voffA);
            PG8_WAIT_L(8); PG8_BAR; PG8_WAIT_L(0); PG8_MMA(0, 0, At, B0); PG8_BAR; PG8_SCHED;
            PG8_LDB(B1, 0, 1); PG8_STAGE(PG8_SB(0, 0), b2, voffB);
            PG8_BAR; PG8_WAIT_L(0); PG8_MMA(0, 1, At, B1); PG8_BAR;
            PG8_LDA(At, 0, 1); PG8_STAGE(PG8_SA(0, 0), a2, voffA);
            PG8_BAR; PG8_WAIT_L(0); PG8_MMA(1, 0, At, B0); PG8_BAR; PG8_SCHED;
            PG8_STAGE(PG8_SB(0, 1), b2 + hstep, voffB);
            PG8_WAIT_V(6); PG8_BAR; PG8_MMA(1, 1, At, B1); PG8_BAR;
            PG8_LDB(B0, 1, 0); PG8_SCHED; PG8_LDA(At, 1, 0); PG8_STAGE(PG8_SA(0, 1), a2 + hstep, voffA);
            PG8_WAIT_L(8); PG8_BAR; PG8_WAIT_L(0); PG8_MMA(0, 0, At, B0); PG8_BAR; PG8_SCHED;
            PG8_LDB(B1, 1, 1); PG8_STAGE(PG8_SB(1, 0), b3, voffB);
            PG8_BAR; PG8_WAIT_L(0); PG8_MMA(0, 1, At, B1); PG8_BAR;
            PG8_LDA(At, 1, 1); PG8_STAGE(PG8_SA(1, 0), a3, voffA);
            PG8_BAR; PG8_WAIT_L(0); PG8_MMA(1, 0, At, B0); PG8_BAR; PG8_SCHED;
            PG8_STAGE(PG8_SB(1, 1), b3 + hstep, voffB);
            PG8_WAIT_V(6); PG8_BAR; PG8_MMA(1, 1, At, B1); PG8_BAR;
            }
        }
        if constexpr (ALIGN_EPI) { if (wr == 0) PG8_BAR; }
        if constexpr (!Epi::AFTER_DRAIN) {
            int fr_l = fr, fq_l = fq; asm volatile("" : "+v"(fr_l), "+v"(fq_l));
            if constexpr (Sched::STREAMK) {
                if (cur.kind == 1) S.store_partial(acc, tid, wid, lane);
                else E(acc, cur, wr, wc, fr_l, fq_l);
            } else E(acc, cur, wr, wc, fr_l, fq_l);
            S.done(cur); }
        if (!has_next) break;
#define PG8_ZERO_ACC() do { _Pragma("unroll") for (int a = 0; a < 2; ++a) _Pragma("unroll") for (int b = 0; b < 2; ++b) _Pragma("unroll") for (int m = 0; m < 4; ++m) _Pragma("unroll") for (int n = 0; n < 2; ++n) acc[a][b][m][n] = (f32x4){0.f, 0.f, 0.f, 0.f}; } while (0)
        if constexpr (Epi::INIT_ACC) {
            if (Sched::STREAMK && nxt.kind == 2) S.load_partial(acc, tid, wid, lane);
            else if (nxt.kind == 0) { int fr_i = fr, fq_i = fq; asm volatile("" : "+v"(fr_i), "+v"(fq_i)); E.init(acc, nxt, wr, wc, fr_i, fq_i); }
            else PG8_ZERO_ACC();
        } else {
            if (Sched::STREAMK && nxt.kind == 2) S.load_partial(acc, tid, wid, lane);
            else PG8_ZERO_ACC();
        }
#undef PG8_ZERO_ACC
        cur = nxt; cA = nA; cB = nB; ++ui;
        if constexpr (ALIGN_EPI) { if (wr == 1) PG8_BAR; }
    }
    PG8_WAIT_V(0);
    if constexpr (!ALIGN_EPI) { if (wr == 0) PG8_BAR; }
    PG8_BAR;
    if constexpr (Epi::AFTER_DRAIN) { E.fused(acc, cur, wr, wc, fr, fq, lds, wid, lane); S.done(cur); }
#undef PG8_SA
#undef PG8_SB
#undef PG8_STAGE
#undef PG8_LDA
#undef PG8_LDB
#undef PG8_MMA
#undef PG8_WAIT_V
#undef PG8_WAIT_L
#undef PG8_BAR
#undef PG8_SCHED
}
}

#define LAS __attribute__((address_space(3)))
typedef unsigned short bf16_t;
typedef float f32x4 __attribute__((ext_vector_type(4)));
typedef float f32x2 __attribute__((ext_vector_type(2)));
typedef unsigned u32x4 __attribute__((ext_vector_type(4)));
typedef unsigned u32x2 __attribute__((ext_vector_type(2)));

constexpr int D = 1024, FF = 2816, DA = 512, DB = 512;
constexpr int NB_P = 8, TP = 2064, NB_S = 128, TS = 8, NMETA = 16, SEQ = 2048;
constexpr int MP = NB_P * TP;
constexpr int MR = MP + NB_S * TS;
constexpr int MPAD = 17664;
constexpr int NCH_P = 33;
constexpr int NQ_P = NB_P * NCH_P;
constexpr int NQ_S = (NB_S * TS) / 64;
constexpr int NQ = NQ_P + NQ_S;
constexpr float EPS = 1e-6f;
constexpr int NWAVES = 8;

enum { I_XP = 0, I_XS, I_SCA, I_SCB, I_SH, I_META, I_GF1, I_W1G, I_W1U, I_W1D, I_GMIX, I_WIN, I_CAW, I_CAB, I_LNG, I_LNB, I_CBW, I_CBB,
       I_WRG, I_BRG, I_WIG, I_BIG, I_LAM, I_WOUT, I_GF2, I_W2G, I_W2U, I_W2D, I_GFIN, N_IN };
constexpr size_t O_YP = 0, O_YS = O_YP + (size_t)NB_P * SEQ * D, O_CAP = O_YS + (size_t)NB_S * TS * D, O_CBP = O_CAP + (size_t)2 * NB_P * 30 * DA,
                 O_HP = O_CBP + (size_t)2 * NB_P * 3 * DB, O_CAS = O_HP + (size_t)2 * NB_P * DB, O_CBS = O_CAS + (size_t)2 * NB_S * 30 * DA,
                 O_HS = O_CBS + (size_t)2 * NB_S * 3 * DB, O_END = O_HS + (size_t)2 * NB_S * DB;

constexpr size_t WS_SS = 0;
constexpr size_t WS_SUMM = 0x80000;
constexpr size_t WS_LAST = 0x1A0000;
constexpr size_t WS_W = 0x400000;
constexpr size_t SZ_WGU = (size_t)2 * FF * D * 2, SZ_WD = (size_t)D * FF * 2, SZ_WIN = (size_t)2048 * D * 2, SZ_WOUT = (size_t)D * D * 2;
constexpr size_t WS_WGU1 = WS_W, WS_WD1 = WS_WGU1 + SZ_WGU, WS_WIN = WS_WD1 + SZ_WD, WS_WOUT = WS_WIN + SZ_WIN, WS_WGU2 = WS_WOUT + SZ_WOUT, WS_WD2 = WS_WGU2 + SZ_WGU;
constexpr size_t WS_X = WS_WD2 + SZ_WD;
constexpr size_t WS_XB = WS_X + (size_t)MPAD * D * 4;
constexpr size_t WS_ACT = WS_XB + (size_t)MPAD * D * 2;
constexpr size_t WS_U = WS_ACT, WS_BX = WS_U + (size_t)MPAD * 512 * 2, WS_GG = WS_BX + (size_t)MPAD * 512 * 2, WS_YAB = WS_GG + (size_t)MPAD * 512 * 2;
constexpr size_t WS_END = WS_ACT + (size_t)MPAD * FF * 2;
static_assert(WS_YAB + (size_t)MPAD * D * 2 <= WS_END, "mixer overlay fits");
static_assert(WS_END <= 268435456, "ws map fits 256 MiB");
static_assert(WS_SS + 7 * (size_t)MPAD * 4 <= WS_SUMM && WS_SUMM + (size_t)NQ * 512 * 8 <= WS_LAST && WS_LAST + (size_t)128 * 512 * 8 <= WS_W, "small buffers");

constexpr int LDS_BYTES = 147456;

__device__ __forceinline__ float bf2f(bf16_t b) { return __uint_as_float(((unsigned)b) << 16); }
__device__ __forceinline__ unsigned pk2(float lo, float hi) { unsigned r; asm("v_cvt_pk_bf16_f32 %0, %1, %2" : "=v"(r) : "v"(lo), "v"(hi)); return r; }
__device__ __forceinline__ unsigned f2bf(float f) { return pk2(f, f) & 0xffffu; }
__device__ __forceinline__ float fast_rcp(float x) { return __builtin_amdgcn_rcpf(x); }
__device__ __forceinline__ float sigmoid_f(float x) { return fast_rcp(1.0f + __expf(-x)); }
__device__ __forceinline__ float silu_f(float x) { return x * sigmoid_f(x); }
__device__ __forceinline__ float gelu_tanh_f(float x) {
    const float u = 0.7978845608028654f * (x + 0.044715f * x * x * x);
    return x * sigmoid_f(2.0f * u);
}
__device__ __forceinline__ float neg_expm1_f(float x) {
    const float p = -x * (1.0f + x * (0.5f + x * (0.16666667f + x * (0.041666668f + x * (0.0083333338f + x * (0.0013888889f + x * 0.0001984127f))))));
    const float q = 1.0f - __expf(x);
    return x > -0.35f ? p : q;
}
__device__ __forceinline__ float wave_sum(float v) {
#pragma unroll
    for (int o = 1; o < 64; o <<= 1) v += __shfl_xor(v, o);
    return v;
}

#define XB_TMO      128
#define XB_XCNT(j)  (256  + 64 * (j))
#define XB_XSUB(j)  (1280 + 64 * (j))
#define XB_XGEN(j)  (2304 + 64 * (j))
#define XB_TOP      3328
#define XB_TOPGEN   3392
#define XCD_BAR_WORDS 3456
#define XB_SPIN_CAP (1u << 18)

__device__ __forceinline__ unsigned xb_ld(unsigned* p)              { return __hip_atomic_load(p, __ATOMIC_RELAXED, __HIP_MEMORY_SCOPE_AGENT); }
__device__ __forceinline__ unsigned xb_add(unsigned* p, unsigned v) { return __hip_atomic_fetch_add(p, v, __ATOMIC_RELAXED, __HIP_MEMORY_SCOPE_AGENT); }
__device__ __forceinline__ unsigned xb_xcc_id() { return (unsigned)__builtin_amdgcn_s_getreg((3 << 11) | 20) & 0xFu; }
#define XB_SPIN(cond, bar) do { unsigned _sp = 0; while (cond) { __builtin_amdgcn_s_sleep(1); \
    if ((++_sp & 255u) == 0u) { if (xb_ld(&(bar)[XB_TMO])) break; if (_sp > XB_SPIN_CAP) { atomicAdd(&(bar)[XB_TMO], 1u); break; } } } } while (0)

struct XcdBarrier {
    unsigned* bar; unsigned x;
    volatile LAS unsigned* st;
};

__device__ __forceinline__ XcdBarrier xcd_barrier_post(unsigned* bar, volatile LAS unsigned* st) {
    XcdBarrier b; b.bar = bar; b.x = xb_xcc_id(); b.st = st;
    if (threadIdx.x == 0) (void)xb_add(&bar[XB_XCNT(b.x)], 1u);
    return b;
}
__device__ __forceinline__ void xcd_barrier_complete(unsigned* bar, unsigned x, unsigned& nloc, unsigned& nx) {
    const unsigned G = gridDim.x * gridDim.y * gridDim.z;
    unsigned sum, cnt, mine, sp = 0u;
    for (;;) {
        sum = 0u; cnt = 0u; mine = 0u;
#pragma unroll
        for (unsigned j = 0; j < 16; ++j) { const unsigned c = xb_ld(&bar[XB_XCNT(j)]); sum += c; cnt += (c > 0u) ? 1u : 0u; mine = (j == x) ? c : mine; }
        if (sum == G) break;
        __builtin_amdgcn_s_sleep(1);
        if ((++sp & 255u) == 0u) { if (xb_ld(&bar[XB_TMO])) break; if (sp > XB_SPIN_CAP) { atomicAdd(&bar[XB_TMO], 1u); break; } }
    }
    nloc = mine > 0u ? mine : 1u; nx = cnt > 0u ? cnt : 1u;
}

__device__ __forceinline__ void xcd_barrier(const XcdBarrier& b, const bool is_t0) {
    asm volatile("s_waitcnt vmcnt(0)" ::: "memory");
    __syncthreads();
    if (is_t0) {
        unsigned* bar = b.bar;
        __builtin_amdgcn_s_waitcnt(0);
        unsigned nloc = b.st[0], nx = b.st[1];
        if (nloc == 0u) { xcd_barrier_complete(bar, b.x, nloc, nx); b.st[0] = nloc; b.st[1] = nx; }
        const unsigned old = xb_add(&bar[XB_XSUB(b.x)], 1u);
        const unsigned gen = old / nloc;
        if (old + 1u == (gen + 1u) * nloc) {
            __builtin_amdgcn_fence(__ATOMIC_RELEASE, "agent");
            asm volatile("s_waitcnt vmcnt(0)" ::: "memory");
            const unsigned og = xb_add(&bar[XB_TOP], 1u);
            const unsigned tg = og / nx;
            if (og + 1u == (tg + 1u) * nx) xb_add(&bar[XB_TOPGEN], 1u);
            else XB_SPIN(xb_ld(&bar[XB_TOPGEN]) == tg, bar);
            __builtin_amdgcn_fence(__ATOMIC_ACQUIRE, "agent");
            xb_add(&bar[XB_XGEN(b.x)], 1u);
            asm volatile("s_waitcnt vmcnt(0)" ::: "memory");
        } else {
            XB_SPIN(xb_ld(&bar[XB_XGEN(b.x)]) == gen, bar);
            __builtin_amdgcn_fence(__ATOMIC_ACQUIRE, "agent");
            asm volatile("s_waitcnt vmcnt(0)" ::: "memory");
        }
    }
    __syncthreads();
}

constexpr size_t WS_BAR = 0x380000;
constexpr int LDS_BARST = 139264;
constexpr size_t WS_SKF = 0x390000;

struct EpiGU {
    static constexpr bool PERM = true, AFTER_DRAIN = false, INIT_ACC = false;
    bf16_t* ACT; const float* ss;
    __device__ __forceinline__ void operator()(const f32x4 (&acc)[2][2][4][2], const pg8::Unit& u, int wr, int wc, int fr, int fq) const {
        const int row0 = u.pm * 256 + wr * 64 + fr, col0 = u.pn * 128 + wc * 32 + 8 * fq;
        float rs[2][4];
#pragma unroll
        for (int ai = 0; ai < 2; ++ai)
#pragma unroll
            for (int m = 0; m < 4; ++m) rs[ai][m] = ss[row0 + ai * 128 + m * 16];
#pragma unroll
        for (int ai = 0; ai < 2; ++ai)
#pragma unroll
            for (int m = 0; m < 4; ++m) {
                const int r = row0 + ai * 128 + m * 16;
                const float rstd = __builtin_amdgcn_rsqf(rs[ai][m] * (1.0f / D) + EPS);
                float o[8];
#pragma unroll
                for (int n = 0; n < 2; ++n)
#pragma unroll
                    for (int e = 0; e < 4; ++e) { const float g = acc[ai][0][m][n][e] * rstd, up = acc[ai][1][m][n][e] * rstd; o[4 * n + e] = silu_f(g) * up; }
                u32x4 w; w.x = pk2(o[0], o[1]); w.y = pk2(o[2], o[3]); w.z = pk2(o[4], o[5]); w.w = pk2(o[6], o[7]);
                *(u32x4*)(ACT + (size_t)r * FF + col0) = w;
            }
    }
};
struct EpiRes {
    static constexpr bool PERM = true, AFTER_DRAIN = false, INIT_ACC = true;
    float* X; bf16_t* XB; float* ssn; float scale;
    __device__ __forceinline__ void init(f32x4 (&acc)[2][2][4][2], const pg8::Unit& u, int wr, int wc, int fr, int fq) const {
        const int row0 = u.pm * 256 + wr * 64 + fr, col0 = u.pn * 256 + wc * 32 + 8 * fq; const float inv = 1.0f / scale;
#pragma unroll
        for (int ai = 0; ai < 2; ++ai)
#pragma unroll
            for (int m = 0; m < 4; ++m)
#pragma unroll
                for (int bj = 0; bj < 2; ++bj) { const float* xp = X + (size_t)(row0 + ai * 128 + m * 16) * D + col0 + bj * 128; acc[ai][bj][m][0] = *(const f32x4*)xp * inv; acc[ai][bj][m][1] = *(const f32x4*)(xp + 4) * inv; }
    }
    __device__ __forceinline__ void operator()(const f32x4 (&acc)[2][2][4][2], const pg8::Unit& u, int wr, int wc, int fr, int fq) const {
        const int row0 = u.pm * 256 + wr * 64 + fr, col0 = u.pn * 256 + wc * 32 + 8 * fq;
#pragma unroll
        for (int ai = 0; ai < 2; ++ai)
#pragma unroll
            for (int m = 0; m < 4; ++m) {
                const int r = row0 + ai * 128 + m * 16; float q = 0.f;
#pragma unroll
                for (int bj = 0; bj < 2; ++bj) {
                    float* xp = X + (size_t)r * D + col0 + bj * 128;
                    const f32x4 v0 = acc[ai][bj][m][0] * scale, v1 = acc[ai][bj][m][1] * scale;
                    *(f32x4*)xp = v0; *(f32x4*)(xp + 4) = v1;
                    u32x4 w; w.x = pk2(v0[0], v0[1]); w.y = pk2(v0[2], v0[3]); w.z = pk2(v1[0], v1[1]); w.w = pk2(v1[2], v1[3]);
                    *(u32x4*)(XB + (size_t)r * D + col0 + bj * 128) = w;
                    q += (v0[0] * v0[0] + v0[1] * v0[1]) + (v0[2] * v0[2] + v0[3] * v0[3]) + (v1[0] * v1[0] + v1[1] * v1[1]) + (v1[2] * v1[2] + v1[3] * v1[3]);
                }
                q += __shfl_xor(q, 16); q += __shfl_xor(q, 32);
                if (fq == 0) atomicAdd(ssn + r, q);
            }
    }
};
struct EpiWin {
    static constexpr bool PERM = true, AFTER_DRAIN = false, INIT_ACC = false;
    bf16_t *U, *BX, *GG; const float* ss;
    __device__ __forceinline__ void operator()(const f32x4 (&acc)[2][2][4][2], const pg8::Unit& u, int wr, int wc, int fr, int fq) const {
        const int row0 = u.pm * 256 + wr * 64 + fr, col0 = (u.pn & 3) * 128 + wc * 32 + 8 * fq;
        const bool isA = u.pn < 4;
        float rs[2][4];
#pragma unroll
        for (int ai = 0; ai < 2; ++ai)
#pragma unroll
            for (int m = 0; m < 4; ++m) rs[ai][m] = ss[row0 + ai * 128 + m * 16];
#pragma unroll
        for (int ai = 0; ai < 2; ++ai)
#pragma unroll
            for (int m = 0; m < 4; ++m) {
                const int r = row0 + ai * 128 + m * 16;
                const float rstd = __builtin_amdgcn_rsqf(rs[ai][m] * (1.0f / D) + EPS);
                float a0[8], a1[8];
#pragma unroll
                for (int n = 0; n < 2; ++n)
#pragma unroll
                    for (int e = 0; e < 4; ++e) { a0[4 * n + e] = acc[ai][0][m][n][e] * rstd; a1[4 * n + e] = acc[ai][1][m][n][e] * rstd; }
                if (isA) {
                    float o[8];
#pragma unroll
                    for (int e = 0; e < 8; ++e) o[e] = a0[e] * sigmoid_f(a1[e]);
                    u32x4 w; w.x = pk2(o[0], o[1]); w.y = pk2(o[2], o[3]); w.z = pk2(o[4], o[5]); w.w = pk2(o[6], o[7]);
                    *(u32x4*)(U + (size_t)r * 512 + col0) = w;
                } else {
                    float o[8];
#pragma unroll
                    for (int e = 0; e < 8; ++e) o[e] = gelu_tanh_f(a1[e]);
                    u32x4 w; w.x = pk2(a0[0], a0[1]); w.y = pk2(a0[2], a0[3]); w.z = pk2(a0[4], a0[5]); w.w = pk2(a0[6], a0[7]);
                    *(u32x4*)(BX + (size_t)r * 512 + col0) = w;
                    u32x4 g; g.x = pk2(o[0], o[1]); g.y = pk2(o[2], o[3]); g.z = pk2(o[4], o[5]); g.w = pk2(o[6], o[7]);
                    *(u32x4*)(GG + (size_t)r * 512 + col0) = g;
                }
            }
    }
};

struct Args { const float* in[N_IN]; float* out; unsigned char* ws; int ph_lo, ph_hi; };
struct Frame {
    LAS unsigned char* lds;
    int tid, lane, wave, G;
    const float* const __attribute__((address_space(4)))* in; float* out; unsigned char* ws;
};
#define LDS_WAIT() asm volatile("s_waitcnt lgkmcnt(0)" ::: "memory")

template <class FrameT>
__device__ __forceinline__ void res_fixup(FrameT& F, const EpiRes& E, const pg8::DpSplit& S) {
    const int nleft = S.nwg - S.G, tid = F.tid, wid = tid >> 6, lane = tid & 63, wr = wid >> 2, wc = wid & 3, fr = lane & 15, fq = lane >> 4;
    for (int item = blockIdx.x; item < nleft * 8; item += F.G) {
        const int j = item >> 3, ai = (item >> 2) & 1, m = item & 3;
        pg8::Unit u; S.unit_of(S.G + j, u);
        const int r = u.pm * 256 + wr * 64 + fr + ai * 128 + m * 16, col0 = u.pn * 256 + wc * 32 + 8 * fq;
        float q = 0.f;
#pragma unroll
        for (int bj = 0; bj < 2; ++bj) {
            f32x4 a0 = {0.f, 0.f, 0.f, 0.f}, a1 = {0.f, 0.f, 0.f, 0.f};
#pragma unroll
            for (int p = 0; p < 4; ++p) {
                const float* sp = S.slab + (size_t)(4 * j + p) * 65536 + (size_t)((((ai * 2 + bj) * 4 + m) * 2) * 2048) + tid * 4;
                a0 += __builtin_nontemporal_load((const f32x4*)sp); a1 += __builtin_nontemporal_load((const f32x4*)(sp + 2048));
            }
            float* xp = E.X + (size_t)r * D + col0 + bj * 128;
            f32x4 v0 = *(f32x4*)xp, v1 = *(f32x4*)(xp + 4);
            v0 = v0 + a0 * E.scale; v1 = v1 + a1 * E.scale;
            *(f32x4*)xp = v0; *(f32x4*)(xp + 4) = v1;
            u32x4 w; w.x = pk2(v0[0], v0[1]); w.y = pk2(v0[2], v0[3]); w.z = pk2(v1[0], v1[1]); w.w = pk2(v1[2], v1[3]);
            *(u32x4*)(E.XB + (size_t)r * D + col0 + bj * 128) = w;
            q += (v0[0] * v0[0] + v0[1] * v0[1]) + (v0[2] * v0[2] + v0[3] * v0[3]) + (v1[0] * v1[0] + v1[1] * v1[1]) + (v1[2] * v1[2] + v1[3] * v1[3]);
        }
        q += __shfl_xor(q, 16); q += __shfl_xor(q, 32);
        if (fq == 0) atomicAdd(E.ssn + r, q);
    }
}


__device__ __forceinline__ void transpose_item(const float* W, int K, int N, bf16_t* WT, const float* g, int mode, LAS float* scr, int item, int lane) {
    const int nblk = N / 32, kb = item / nblk, nb = item % nblk, k0 = 64 * kb, n0 = 32 * nb;
    float tv[32];
#pragma unroll
    for (int i = 0; i < 32; ++i) { const int kk = 2 * i + (lane >> 5); tv[i] = __builtin_nontemporal_load(W + (size_t)(k0 + kk) * N + n0 + (lane & 31)); }
    if (g) {
#pragma unroll
        for (int i = 0; i < 32; ++i) tv[i] *= g[k0 + 2 * i + (lane >> 5)];
    }
#pragma unroll
    for (int i = 0; i < 32; ++i) scr[(2 * i + (lane >> 5)) * 33 + (lane & 31)] = tv[i];
    LDS_WAIT(); asm volatile("" ::: "memory");
    int d0;
    if (mode == 0) d0 = n0;
    else if (mode == 1) d0 = 256 * (n0 >> 7) + (n0 & 127);
    else if (mode == 2) d0 = 256 * (n0 >> 7) + 128 + (n0 & 127);
    else { const int seg = n0 >> 9, cc = n0 & 511; d0 = 256 * ((seg >> 1) * 4 + (cc >> 7)) + 128 * (seg & 1) + (cc & 127); }
    const int c = lane & 7;
#pragma unroll
    for (int j = 0; j < 4; ++j) { const int n = (lane >> 3) + 8 * j; const LAS float* s = scr + (8 * c) * 33 + n;
        u32x4 o; o.x = pk2(s[0 * 33], s[1 * 33]); o.y = pk2(s[2 * 33], s[3 * 33]); o.z = pk2(s[4 * 33], s[5 * 33]); o.w = pk2(s[6 * 33], s[7 * 33]);
        *(u32x4*)(WT + (size_t)(d0 + n) * K + k0 + 8 * c) = o; }
    LDS_WAIT(); asm volatile("" ::: "memory");
}
constexpr int IT_G = (D / 64) * (FF / 32), IT_D = (FF / 64) * (D / 32), IT_WIN = (D / 64) * (2048 / 32), IT_WOUT = (D / 64) * (D / 32);
__device__ __forceinline__ void convert_mats(Frame& F, int l, int id_lo, int id_hi, int gw, int NGW) {
    LAS float* scr = (LAS float*)(F.lds + F.wave * 16384);
    unsigned char* ws = F.ws;
    for (int id = id_lo; id < id_hi; ++id) {
        const int nit = (id == 0 || id == 4) ? 2 * IT_G : (id == 1 || id == 5) ? IT_D : (id == 2 ? IT_WIN : IT_WOUT);
        for (int it = gw; it < nit; it += NGW) {
            if (id == 0) { const bool up = it >= IT_G; transpose_item(F.in[up ? I_W1U : I_W1G] + (size_t)l * D * FF, D, FF, (bf16_t*)(ws + WS_WGU1), F.in[I_GF1] + l * D, up ? 2 : 1, scr, up ? it - IT_G : it, F.lane); }
            else if (id == 4) { const bool up = it >= IT_G; transpose_item(F.in[up ? I_W2U : I_W2G] + (size_t)l * D * FF, D, FF, (bf16_t*)(ws + WS_WGU2), F.in[I_GF2] + l * D, up ? 2 : 1, scr, up ? it - IT_G : it, F.lane); }
            else if (id == 1) transpose_item(F.in[I_W1D] + (size_t)l * D * FF, FF, D, (bf16_t*)(ws + WS_WD1), nullptr, 0, scr, it, F.lane);
            else if (id == 5) transpose_item(F.in[I_W2D] + (size_t)l * D * FF, FF, D, (bf16_t*)(ws + WS_WD2), nullptr, 0, scr, it, F.lane);
            else if (id == 2) transpose_item(F.in[I_WIN] + (size_t)l * D * 2048, D, 2048, (bf16_t*)(ws + WS_WIN), F.in[I_GMIX] + l * D, 3, scr, it, F.lane);
            else transpose_item(F.in[I_WOUT] + (size_t)l * D * D, D, D, (bf16_t*)(ws + WS_WOUT), nullptr, 0, scr, it, F.lane);
        }
    }
}

__device__ __forceinline__ void p0_prologue(Frame& F) {
    convert_mats(F, 0, 0, 6, blockIdx.x * NWAVES + F.wave, F.G * NWAVES);
    const int gw = blockIdx.x * NWAVES + F.wave, NGW = F.G * NWAVES;
    float* X = (float*)(F.ws + WS_X); bf16_t* XB = (bf16_t*)(F.ws + WS_XB); float* ss = (float*)(F.ws + WS_SS);
    for (int r = gw; r < MPAD; r += NGW) {
        const float* src = nullptr;
        if (r < MP) { const int b = r / TP, tt = r - b * TP; src = tt < NMETA ? F.in[I_META] + (size_t)tt * D : F.in[I_XP] + ((size_t)b * SEQ + (tt - NMETA)) * D; }
        else if (r < MR) src = F.in[I_XS] + (size_t)(r - MP) * D;
        f32x4 v[4]; float s = 0.f;
#pragma unroll
        for (int j = 0; j < 4; ++j) { v[j] = src ? ((const f32x4*)src)[F.lane + 64 * j] : (f32x4){0.f, 0.f, 0.f, 0.f}; s += (v[j][0] * v[j][0] + v[j][1] * v[j][1]) + (v[j][2] * v[j][2] + v[j][3] * v[j][3]); }
        s = wave_sum(s);
#pragma unroll
        for (int j = 0; j < 4; ++j) { ((f32x4*)(X + (size_t)r * D))[F.lane + 64 * j] = v[j];
            u32x2 w; w.x = pk2(v[j][0], v[j][1]); w.y = pk2(v[j][2], v[j][3]); ((u32x2*)(XB + (size_t)r * D))[F.lane + 64 * j] = w; }
        if (F.lane == 0) ss[r] = s;
    }
    { const int i = blockIdx.x * 512 + F.tid; if (i < 6 * MPAD) ss[MPAD + i] = 0.f; }
}

__device__ __forceinline__ void final_phase(Frame& F) {
    const int gw = blockIdx.x * NWAVES + F.wave, NGW = F.G * NWAVES;
    const float* X = (const float*)(F.ws + WS_X); const float* ss = (const float*)(F.ws + WS_SS) + 6 * MPAD; const float* g = F.in[I_GFIN];
    f32x4 gv[4];
#pragma unroll
    for (int j = 0; j < 4; ++j) gv[j] = ((const f32x4*)g)[F.lane + 64 * j];
    for (int r = gw; r < MR; r += NGW) {
        float* dst;
        if (r < MP) { const int b = r / TP, tt = r - b * TP; if (tt < NMETA) continue; dst = F.out + O_YP + ((size_t)b * SEQ + (tt - NMETA)) * D; }
        else dst = F.out + O_YS + (size_t)(r - MP) * D;
        const float rstd = __builtin_amdgcn_rsqf(ss[r] * (1.0f / D) + EPS);
#pragma unroll
        for (int j = 0; j < 4; ++j) { const f32x4 v = ((const f32x4*)(X + (size_t)r * D))[F.lane + 64 * j]; ((f32x4*)dst)[F.lane + 64 * j] = v * rstd * gv[j]; }
    }
}

constexpr int LDS_WR = 0, LDS_WI = 16384, LDS_CBT = 32768, LDS_GRP = LDS_CBT + 4 * 64 * 68 * 4, LDS_RED = 0;

__device__ __forceinline__ float reduce_scatter32(float (&v)[32], int lane) {
#define RS_STEP(H, M) { const bool up = (lane & (M)) != 0; _Pragma("unroll") for (int i = 0; i < (H); ++i) { const float snd = up ? v[i] : v[i + (H)], kp = up ? v[i + (H)] : v[i]; v[i] = kp + __shfl_xor(snd, (M)); } }
    RS_STEP(16, 32) RS_STEP(8, 16) RS_STEP(4, 8) RS_STEP(2, 4) RS_STEP(1, 2)
#undef RS_STEP
    return v[0] + __shfl_xor(v[0], 1);
}

__device__ __forceinline__ void mix_job_a(Frame& F, int l, int sp, int gi) {
    const int tid = F.tid, c = 128 * gi + (tid & 127), sub = tid >> 7;
    const bf16_t* U = (const bf16_t*)(F.ws + WS_U); bf16_t* YAB = (bf16_t*)(F.ws + WS_YAB);
    const float* cw = F.in[I_CAW] + (size_t)l * 31 * DA;
    float w[31];
#pragma unroll
    for (int k = 0; k < 31; ++k) w[k] = cw[k * DA + c];
    const float cbias = F.in[I_CAB][l * DA + c], lg = F.in[I_LNG][l * DA + c], lb = F.in[I_LNB][l * DA + c];
    float acc[32];
#pragma unroll
    for (int t = 0; t < 32; ++t) acc[t] = cbias;
    int rowbase, nval;
    if (sp < 136) {
        const int b = sp / 17, k2 = sp - b * 17, nvalid = (k2 == 16) ? 16 : 128, seqrow0 = b * TP, tb = 128 * k2 + 32 * sub;
        nval = nvalid - 32 * sub; rowbase = seqrow0 + tb;
        if (nval > 0) {
#pragma unroll
            for (int tt = 0; tt < 62; ++tt) {
                const int ti = tb - 30 + tt;
                const float v = ti >= 0 ? bf2f(U[(size_t)(seqrow0 + ti) * 512 + c]) : 0.f;
#pragma unroll
                for (int t = 0; t < 32; ++t) { const int kk = tt - t; if (kk >= 0 && kk <= 30) acc[t] += w[kk] * v; }
            }
        }
    } else {
        nval = 32; const int s0 = 16 * (sp - 136) + 4 * sub; rowbase = MP + 8 * s0;
        const float* st = F.in[I_SCA] + (size_t)l * NB_S * 30 * DA;
#pragma unroll
        for (int hs = 0; hs < 4; ++hs) {
            const int s = s0 + hs, rowS = MP + 8 * s;
#pragma unroll
            for (int tt = 0; tt < 38; ++tt) {
                const float v = tt < 30 ? st[((size_t)s * 30 + tt) * DA + c] : bf2f(U[(size_t)(rowS + tt - 30) * 512 + c]);
#pragma unroll
                for (int t = 0; t < 8; ++t) { const int kk = tt - t; if (kk >= 0 && kk <= 30) acc[8 * hs + t] += w[kk] * v; }
            }
        }
    }
    LAS f32x2* red = (LAS f32x2*)(F.lds + LDS_RED);
    float s1[32], s2[32];
#pragma unroll
    for (int t = 0; t < 32; ++t) { s1[t] = acc[t]; s2[t] = acc[t] * acc[t]; }
    const float r1 = reduce_scatter32(s1, F.lane), r2 = reduce_scatter32(s2, F.lane);
    __syncthreads();
    if ((F.lane & 1) == 0) red[F.wave * 32 + (F.lane >> 1)] = (f32x2){r1, r2};
    __syncthreads();
    if (nval > 0) {
#pragma unroll
        for (int t = 0; t < 32; ++t) {
            const f32x2 a = red[F.wave * 32 + t], o = red[(F.wave ^ 1) * 32 + t];
            const float mean = (a.x + o.x) * (1.0f / 128.0f), var = (a.y + o.y) * (1.0f / 128.0f) - mean * mean;
            const float rstd = __builtin_amdgcn_rsqf(fmaxf(var, 0.f) + EPS);
            const float y = (acc[t] - mean) * rstd * lg + lb;
            if (t < nval) YAB[(size_t)(rowbase + t) * D + c] = (bf16_t)f2bf(silu_f(y));
        }
    }
}

constexpr int WJ_TILE = 9728;
constexpr int LDS_WT = 8 * WJ_TILE;
typedef short bf16x8_t __attribute__((ext_vector_type(8)));

__device__ __forceinline__ void mix_b_wave_jobs(Frame& F, int l) {
    const int lane = F.lane, wave = F.wave, fr = lane & 15, fq = lane >> 4, h = blockIdx.x & 7;
    const bf16_t* BX = (const bf16_t*)(F.ws + WS_BX);
    bf16_t* YAB = (bf16_t*)(F.ws + WS_YAB); bf16_t* PCG = (bf16_t*)(F.ws + WS_XB);
    LAS bf16_t* WT = (LAS bf16_t*)(F.lds + LDS_WT);
    LAS bf16_t* tile = (LAS bf16_t*)(F.lds + wave * WJ_TILE);
    __syncthreads();
    {
        const f32x4* gr = (const f32x4*)(F.in[I_WRG] + (size_t)(l * 8 + h) * 4096); const f32x4* gx = (const f32x4*)(F.in[I_WIG] + (size_t)(l * 8 + h) * 4096);
#pragma unroll
        for (int e = 0; e < 2; ++e) {
            const int idx = F.tid + e * 512, i = idx >> 4, j4 = (idx & 15) * 4;
            const f32x4 a = gr[idx], b = gx[idx];
#pragma unroll
            for (int d = 0; d < 4; ++d) { WT[(j4 + d) * 72 + i] = (bf16_t)f2bf(a[d]); WT[(64 + j4 + d) * 72 + i] = (bf16_t)f2bf(b[d]); }
        }
    }
    float bra[4], bix[4], sp[4];
#pragma unroll
    for (int nt = 0; nt < 4; ++nt) {
        const int c = 64 * h + 16 * nt + fr;
        bra[nt] = F.in[I_BRG][l * DB + c]; bix[nt] = F.in[I_BIG][l * DB + c];
        sp[nt] = log1pf(expf(-F.in[I_LAM][l * DB + c]));
    }
    __syncthreads();
    for (int q = (int)(blockIdx.x >> 3) * 8 + wave; q < NQ; q += 256) {
        const bool prompt = q < NQ_P;
        int row0, t0, nvalid;
        if (prompt) { const int b_ = q / NCH_P, k = q - b_ * NCH_P; row0 = b_ * TP + 64 * k; t0 = 64 * k; nvalid = (k == NCH_P - 1) ? 16 : 64; }
        else { row0 = MP + 64 * (q - NQ_P); t0 = 0; nvalid = 64; }
        int ln = lane; asm volatile("" : "+v"(ln));
#pragma unroll
        for (int i = 0; i < 9; ++i) {
            const int p = ln + 64 * i;
            if (p < 536) {
                const int rr = p >> 3, pc = p & 7, row = rr - 3;
                const bool okr = prompt ? (t0 + row >= 0) : (row >= 0);
                u32x4 v = *(const u32x4*)(BX + (size_t)(row0 + (okr ? row : 0)) * 512 + 64 * h + 8 * pc);
                if (!okr) v = (u32x4){0u, 0u, 0u, 0u};
                *(LAS u32x4*)(tile + rr * 72 + 8 * pc) = v;
            }
        }
        float wb[4][4], bb[4];
        { int fr_l = fr; asm volatile("" : "+v"(fr_l));
#pragma unroll
        for (int nt = 0; nt < 4; ++nt) {
            const int c = 64 * h + 16 * nt + fr_l;
#pragma unroll
            for (int k = 0; k < 4; ++k) wb[k][nt] = F.in[I_CBW][((size_t)l * 4 + k) * DB + c];
            bb[nt] = F.in[I_CBB][l * DB + c];
        } }
        float cbv[4][4][4];
#pragma unroll
        for (int mt = 0; mt < 4; ++mt)
#pragma unroll
            for (int nt = 0; nt < 4; ++nt) {
                const int tb = 16 * mt + 4 * fq; float x[7];
#pragma unroll
                for (int i = 0; i < 7; ++i) x[i] = bf2f(tile[(tb + i) * 72 + 16 * nt + fr]);
                if (!prompt && !(fq & 1)) {
                    const int s = 8 * (q - NQ_P) + 2 * mt + (fq >> 1);
                    const float* st = F.in[I_SCB] + ((size_t)l * NB_S + s) * 3 * DB + 64 * h + 16 * nt + fr;
                    x[0] = st[0]; x[1] = st[DB]; x[2] = st[2 * DB];
                }
#pragma unroll
                for (int e = 0; e < 4; ++e) cbv[mt][nt][e] = bb[nt] + wb[0][nt] * x[e] + wb[1][nt] * x[e + 1] + wb[2][nt] * x[e + 2] + wb[3][nt] * x[e + 3];
            }
        asm volatile("s_waitcnt lgkmcnt(0)" ::: "memory");
#pragma unroll
        for (int mt = 0; mt < 4; ++mt)
#pragma unroll
            for (int nt = 0; nt < 4; ++nt)
#pragma unroll
                for (int e = 0; e < 4; ++e) tile[(16 * mt + 4 * fq + e) * 72 + 16 * nt + fr] = (bf16_t)f2bf(cbv[mt][nt][e]);
        asm volatile("s_waitcnt lgkmcnt(0)" ::: "memory");
        float Pc[4] = {1.f, 1.f, 1.f, 1.f}, Hc[4] = {0.f, 0.f, 0.f, 0.f};
#pragma unroll
        for (int mt = 0; mt < 4; ++mt) {
            const bf16x8_t a0 = *(const LAS bf16x8_t*)(tile + (16 * mt + fr) * 72 + 8 * fq), a1 = *(const LAS bf16x8_t*)(tile + (16 * mt + fr) * 72 + 32 + 8 * fq);
#pragma unroll
            for (int nt = 0; nt < 4; ++nt) {
                const int c = 64 * h + 16 * nt + fr;
                const bf16x8_t br0 = *(const LAS bf16x8_t*)(WT + (16 * nt + fr) * 72 + 8 * fq), br1 = *(const LAS bf16x8_t*)(WT + (16 * nt + fr) * 72 + 32 + 8 * fq);
                const bf16x8_t bi0 = *(const LAS bf16x8_t*)(WT + (64 + 16 * nt + fr) * 72 + 8 * fq), bi1 = *(const LAS bf16x8_t*)(WT + (64 + 16 * nt + fr) * 72 + 32 + 8 * fq);
                f32x4 accR = {0.f, 0.f, 0.f, 0.f}, accI = {0.f, 0.f, 0.f, 0.f};
                accR = __builtin_amdgcn_mfma_f32_16x16x32_bf16(a0, br0, accR, 0, 0, 0); accR = __builtin_amdgcn_mfma_f32_16x16x32_bf16(a1, br1, accR, 0, 0, 0);
                accI = __builtin_amdgcn_mfma_f32_16x16x32_bf16(a0, bi0, accI, 0, 0, 0); accI = __builtin_amdgcn_mfma_f32_16x16x32_bf16(a1, bi1, accI, 0, 0, 0);
                float P4[4], H4[4]; float hp = 0.f, pp = 1.f;
#pragma unroll
                for (int e = 0; e < 4; ++e) {
                    const float r = sigmoid_f(accR[e] + bra[nt]), ig = sigmoid_f(accI[e] + bix[nt]);
                    const float la = -8.0f * r * sp[nt], a = __expf(la), bt = __builtin_amdgcn_sqrtf(neg_expm1_f(2.0f * la)) * (ig * bf2f(tile[(16 * mt + 4 * fq + e) * 72 + 16 * nt + fr]));
                    hp = a * hp + bt; pp = pp * a; H4[e] = hp; P4[e] = pp;
                }
                float pex = 1.f, hex = 0.f;
#pragma unroll
                for (int d = 3; d >= 1; --d) {
                    const float ps = __shfl(pp, lane - 16 * d), hs = __shfl(hp, lane - 16 * d);
                    const bool use = prompt ? (fq >= d) : (d == 1 && (fq & 1));
                    if (use) { hex = ps * hex + hs; pex = pex * ps; }
                }
                const float pin = prompt ? Pc[nt] * pex : pex, hin = prompt ? pex * Hc[nt] + hex : hex;
                float Pf[4], Hf[4];
#pragma unroll
                for (int e = 0; e < 4; ++e) { Hf[e] = H4[e] + P4[e] * hin; Pf[e] = P4[e] * pin; }
                Pc[nt] = __shfl(Pf[3], fr + 48); Hc[nt] = __shfl(Hf[3], fr + 48);
#pragma unroll
                for (int e = 0; e < 4; ++e) {
                    const int tl = 16 * mt + 4 * fq + e;
                    if (tl < nvalid) { const size_t row = (size_t)(row0 + tl); YAB[row * D + 512 + c] = (bf16_t)f2bf(Hf[e]); PCG[row * 512 + c] = (bf16_t)f2bf(Pf[e]); }
                }
                if (prompt) { if (16 * (mt + 1) == nvalid && fq == 3) ((f32x2*)(F.ws + WS_SUMM))[(size_t)q * 512 + c] = (f32x2){Pf[3], Hf[3]}; }
                else if (fq & 1) { const int s = 8 * (q - NQ_P) + 2 * mt + (fq >> 1); ((f32x2*)(F.ws + WS_LAST))[(size_t)s * 512 + c] = (f32x2){Pf[3], Hf[3]}; }
            }
        }
    }
}

constexpr int LDS_ARED = 98304;
__device__ __forceinline__ float reduce_scatter16(float (&v)[16], int lane) {
#define RS_STEP(H, M) { const bool up = (lane & (M)) != 0; _Pragma("unroll") for (int i = 0; i < (H); ++i) { const float snd = up ? v[i] : v[i + (H)], kp = up ? v[i + (H)] : v[i]; v[i] = kp + __shfl_xor(snd, (M)); } }
    RS_STEP(8, 32) RS_STEP(4, 16) RS_STEP(2, 8) RS_STEP(1, 4)
#undef RS_STEP
    float r = v[0]; r += __shfl_xor(r, 2); r += __shfl_xor(r, 1); return r;
}
__device__ __forceinline__ void mix_a_wave_jobs(Frame& F, int l) {
    const int lane = F.lane, wave = F.wave, gi = wave & 3, c0 = 128 * gi + 2 * lane;
    const bf16_t* U = (const bf16_t*)(F.ws + WS_U); bf16_t* YAB = (bf16_t*)(F.ws + WS_YAB);
    const float* cw = F.in[I_CAW] + (size_t)l * 31 * DA;
    f32x2 w[31];
#pragma unroll
    for (int k = 0; k < 31; ++k) w[k] = *(const f32x2*)(cw + k * DA + c0);
    const f32x2 cbv = *(const f32x2*)(F.in[I_CAB] + l * DA + c0), lgv = *(const f32x2*)(F.in[I_LNG] + l * DA + c0), lbv = *(const f32x2*)(F.in[I_LNB] + l * DA + c0);
    LAS f32x2* red = (LAS f32x2*)(F.lds + LDS_ARED + wave * 128);
    for (int tb = 511 - ((int)blockIdx.x * 2 + (wave >> 2)); tb < 1096; tb += 512) {
        f32x2 a[16];
#pragma unroll
        for (int t = 0; t < 16; ++t) a[t] = cbv;
        int rowbase;
        if (tb < 1032) {
            const int b = tb / 129, kb = tb - b * 129, t0 = 16 * kb, seqrow0 = b * TP; rowbase = seqrow0 + t0;
            unsigned raw[46];
#pragma unroll
            for (int tt = 0; tt < 46; ++tt) { const int ti = t0 - 30 + tt; raw[tt] = *(const unsigned*)(U + (size_t)(seqrow0 + (ti < 0 ? 0 : ti)) * 512 + c0); }
#pragma unroll
            for (int tt = 0; tt < 46; ++tt) {
                const unsigned rw = ((t0 - 30 + tt) >= 0) ? raw[tt] : 0u;
                const f32x2 v = {__uint_as_float(rw << 16), __uint_as_float(rw & 0xffff0000u)};
#pragma unroll
                for (int t = 0; t < 16; ++t) { const int kk = tt - t; if (kk >= 0 && kk <= 30) a[t] += w[kk] * v; }
            }
        } else {
            const int s0 = 2 * (tb - 1032); rowbase = MP + 8 * s0;
            const float* st = F.in[I_SCA] + (size_t)l * NB_S * 30 * DA;
#pragma unroll
            for (int hs = 0; hs < 2; ++hs) {
                const int s = s0 + hs, rowS = MP + 8 * s;
#pragma unroll
                for (int tt = 0; tt < 38; ++tt) {
                    f32x2 v;
                    if (tt < 30) v = *(const f32x2*)(st + ((size_t)s * 30 + tt) * DA + c0);
                    else { const unsigned rw = *(const unsigned*)(U + (size_t)(rowS + tt - 30) * 512 + c0); v = (f32x2){__uint_as_float(rw << 16), __uint_as_float(rw & 0xffff0000u)}; }
#pragma unroll
                    for (int t = 0; t < 8; ++t) { const int kk = tt - t; if (kk >= 0 && kk <= 30) a[8 * hs + t] += w[kk] * v; }
                }
            }
        }
        float s1[16], s2[16];
#pragma unroll
        for (int t = 0; t < 16; ++t) { s1[t] = a[t].x + a[t].y; s2[t] = a[t].x * a[t].x + a[t].y * a[t].y; }
        const float r1 = reduce_scatter16(s1, lane), r2 = reduce_scatter16(s2, lane);
        if ((lane & 3) == 0) red[lane >> 2] = (f32x2){r1, r2};
        asm volatile("s_waitcnt lgkmcnt(0)" ::: "memory");
#pragma unroll
        for (int t = 0; t < 16; ++t) {
            const f32x2 st_ = red[t];
            const float mean = st_.x * (1.0f / 128.0f), var = st_.y * (1.0f / 128.0f) - mean * mean;
            const float rstd = __builtin_amdgcn_rsqf(fmaxf(var, 0.f) + EPS);
            const f32x2 y = (a[t] - mean) * rstd * lgv + lbv;
            *(unsigned*)(YAB + (size_t)(rowbase + t) * D + c0) = pk2(silu_f(y.x), silu_f(y.y));
        }
        asm volatile("s_waitcnt lgkmcnt(0)" ::: "memory");
    }
}

__device__ __forceinline__ void mix_job_state(Frame& F, int l, int s) {
    const int c = F.tid;
    const bf16_t* U = (const bf16_t*)(F.ws + WS_U); const bf16_t* BX = (const bf16_t*)(F.ws + WS_BX);
    if (s < NB_P) {
        const int b = s; float* oa = F.out + O_CAP + ((size_t)l * NB_P + b) * 30 * DA; float* ob = F.out + O_CBP + ((size_t)l * NB_P + b) * 3 * DB;
#pragma unroll 10
        for (int i = 0; i < 30; ++i) oa[i * DA + c] = bf2f(U[(size_t)(b * TP + TP - 30 + i) * 512 + c]);
#pragma unroll
        for (int i = 0; i < 3; ++i) ob[i * DB + c] = bf2f(BX[(size_t)(b * TP + TP - 3 + i) * 512 + c]);
    } else {
        const int b = s - NB_P, rowS = MP + 8 * b; float* oa = F.out + O_CAS + ((size_t)l * NB_S + b) * 30 * DA; float* ob = F.out + O_CBS + ((size_t)l * NB_S + b) * 3 * DB;
        const float* st = F.in[I_SCA] + ((size_t)l * NB_S + b) * 30 * DA;
#pragma unroll 11
        for (int i = 0; i < 22; ++i) oa[i * DA + c] = st[(8 + i) * DA + c];
#pragma unroll
        for (int i = 22; i < 30; ++i) oa[i * DA + c] = bf2f(U[(size_t)(rowS + i - 22) * 512 + c]);
#pragma unroll
        for (int i = 0; i < 3; ++i) ob[i * DB + c] = bf2f(BX[(size_t)(rowS + 5 + i) * 512 + c]);
    }
}

__device__ __forceinline__ void mix_a_phase(Frame& F, int l, int sel) {
    if (sel & 1) mix_b_wave_jobs(F, l);
    if (!(sel & 2)) return;
    { int t_ = F.tid; asm volatile("" : "+v"(t_)); F.tid = t_; F.lane = t_ & 63; }
    mix_a_wave_jobs(F, l);
    { int t_ = F.tid; asm volatile("" : "+v"(t_)); F.tid = t_; F.lane = t_ & 63; }
    const int b = blockIdx.x;
    if (b >= 64 && b - 64 < NB_P + NB_S) mix_job_state(F, l, b - 64);
}

__device__ __forceinline__ void mix_c_phase(Frame& F, int l, int rep) {
    const int c = F.tid;
    bf16_t* YAB = (bf16_t*)(F.ws + WS_YAB); const bf16_t* PCG = (const bf16_t*)(F.ws + WS_XB); const bf16_t* GGp = (const bf16_t*)(F.ws + WS_GG);
    const f32x2* SUMM = (const f32x2*)(F.ws + WS_SUMM); const f32x2* LAST = (const f32x2*)(F.ws + WS_LAST);
    for (int job = blockIdx.x; job < NQ * 2; job += F.G) {
        const int q = job >> 1, hh = job & 1;
        if (q < NQ_P) {
            const int b = q / NCH_P, k = q - b * NCH_P, nvalid = (k == NCH_P - 1) ? 16 : 64, row0 = b * TP + 64 * k;
            if (32 * hh >= nvalid) continue;
            float carry = 0.f;
            {
                f32x2 ph[32];
#pragma unroll
                for (int e = 0; e < 32; ++e) { const int kk = e < k ? e : 0; ph[e] = SUMM[(size_t)(b * NCH_P + kk) * 512 + c]; }
#pragma unroll
                for (int e = 0; e < 32; ++e) { const float px = e < k ? ph[e].x : 1.f, py = e < k ? ph[e].y : 0.f; carry = px * carry + py; }
            }
            const int r1 = (32 * hh + 32 < nvalid) ? 32 * hh + 32 : nvalid;
            for (int r = 32 * hh; r < r1; ++r) {
                const size_t row = row0 + r;
                const float y = (bf2f(YAB[row * D + 512 + c]) + bf2f(PCG[row * 512 + c]) * carry) * bf2f(GGp[row * 512 + c]);
                if (rep) ((bf16_t*)(F.ws + WS_U))[row * 512 + c] = (bf16_t)f2bf(y); else
                YAB[row * D + 512 + c] = (bf16_t)f2bf(y);
            }
            if (k == NCH_P - 1 && hh == 0) { const f32x2 ph = SUMM[(size_t)q * 512 + c]; F.out[O_HP + ((size_t)l * NB_P + b) * DB + c] = ph.y + ph.x * carry; }
        } else {
            const int row0 = MP + 64 * (q - NQ_P);
            for (int r = 32 * hh; r < 32 * hh + 32; ++r) {
                const int s = 8 * (q - NQ_P) + (r >> 3); const size_t row = row0 + r;
                const float carry = F.in[I_SH][((size_t)l * NB_S + s) * DB + c];
                const float y = (bf2f(YAB[row * D + 512 + c]) + bf2f(PCG[row * 512 + c]) * carry) * bf2f(GGp[row * 512 + c]);
                if (rep) ((bf16_t*)(F.ws + WS_U))[row * 512 + c] = (bf16_t)f2bf(y); else
                YAB[row * D + 512 + c] = (bf16_t)f2bf(y);
                if ((r & 7) == 7) { const f32x2 ph = LAST[(size_t)s * 512 + c]; F.out[O_HS + ((size_t)l * NB_S + s) * DB + c] = ph.y + ph.x * carry; }
            }
        }
    }
}

constexpr int NPH = 18;
#ifndef PHMASK
#define PHMASK 127
#endif
#define DUPMASK 0
#define MIXSEL 1
__global__ void __launch_bounds__(NWAVES * 64, 2) mega_fwd(Args args) {
    extern __shared__ __attribute__((aligned(16))) unsigned char lds[];
    Frame F;
    F.lds = (LAS unsigned char*)lds; F.G = gridDim.x;
    if (threadIdx.x < 2) ((volatile LAS unsigned*)(F.lds + LDS_BARST))[threadIdx.x] = 0u;
    __syncthreads();
    if (args.ph_hi - args.ph_lo > 1) (void)xcd_barrier_post((unsigned*)(args.ws + WS_BAR), (volatile LAS unsigned*)(F.lds + LDS_BARST));
    const int ph_lo = args.ph_lo, ph_hi = args.ph_hi;
    const int wave_s = __builtin_amdgcn_readfirstlane(threadIdx.x >> 6);
    for (int st = 2 * ph_lo; st < 2 * ph_hi; ++st) {
        const int ph = st >> 1, rep = st & 1;
        bool run = true;
        if (rep == 1) { const int ty = (ph == 0) ? 1 : (ph == NPH - 1) ? 2 : (int)((0x0804084020100804ull >> (8 * ((ph - 1) & 7))) & 255ull);
            run = (DUPMASK & ty) != 0; }
        if (run) {
        const __attribute__((address_space(4))) unsigned char* kp = (const __attribute__((address_space(4))) unsigned char*)__builtin_amdgcn_kernarg_segment_ptr();
        asm volatile("" : "+s"(kp));
        const __attribute__((address_space(4))) Args* ap = (const __attribute__((address_space(4))) Args*)kp;
        F.in = ap->in; F.out = ap->out; F.ws = ap->ws;
        { int t_ = wave_s * 64 + hw_lane_id(); asm volatile("" : "+v"(t_)); F.tid = t_; F.lane = t_ & 63; F.wave = wave_s; }
        unsigned char* ws = F.ws;
        float* SS = (float*)(ws + WS_SS);
        if ((PHMASK & 1) && ph == 0) p0_prologue(F);
        else if ((PHMASK & 2) && ph == NPH - 1) final_phase(F);
        else {
            const int l = (ph - 1) >> 3, s = (ph - 1) & 7;
            if ((PHMASK & 4) && (s == 0 || s == 6)) {
                pg8::Gemm g{(const bf16_t*)(ws + WS_XB), (const bf16_t*)(ws + (s == 0 ? WS_WGU1 : WS_WGU2)), MPAD, 2 * FF, D};
                pg8::StaticOrder S; S.init(MPAD, 2 * FF, D, F.G, (int)blockIdx.x);
                EpiGU E{(bf16_t*)(ws + WS_ACT), SS + (size_t)(s == 0 ? 3 * l : 3 * l + 2) * MPAD};
                pg8::gemm_phase<EpiGU, pg8::StaticOrder, true, true>(F.lds, g, S, E, wave_s);
            } else if ((PHMASK & 8) && (s == 1 || s == 7 || s == 5)) {
                const bool down = (s != 5);
                pg8::Gemm g{(const bf16_t*)(ws + (down ? WS_ACT : WS_YAB)), (const bf16_t*)(ws + (s == 1 ? WS_WD1 : (s == 7 ? WS_WD2 : WS_WOUT))), MPAD, D, down ? FF : D};
                pg8::DpSplit S; S.init(MPAD, D, down ? FF : D, F.G, (int)blockIdx.x, F.out);
                EpiRes E{(float*)(ws + WS_X), (bf16_t*)(ws + WS_XB), (rep ? (float*)(ws + 0x300000) : SS + (size_t)(s == 1 ? 3 * l + 1 : (s == 5 ? 3 * l + 2 : 3 * l + 3)) * MPAD), rep ? 0.0f : (down ? 0.5f : 1.0f)};
                pg8::gemm_phase<EpiRes, pg8::DpSplit, true, true>(F.lds, g, S, E, wave_s);
                if (blockIdx.x >= 80 && rep == 0) {
                    const int gw = ((int)blockIdx.x - 80) * NWAVES + F.wave, NGW = (F.G - 80) * NWAVES;
                    if (l == 0 && s == 1) convert_mats(F, 1, 0, 1, gw, NGW);
                    else if (l == 0 && s == 7) convert_mats(F, 1, 1, 3, gw, NGW);
                    else if (l == 1 && s == 1) convert_mats(F, 1, 3, 5, gw, NGW);
                    else if (l == 1 && s == 5) convert_mats(F, 1, 5, 6, gw, NGW);
                }
                { XcdBarrier xb; xb.bar = (unsigned*)(ws + WS_BAR); xb.x = xb_xcc_id(); xb.st = (volatile LAS unsigned*)(F.lds + LDS_BARST); xcd_barrier(xb, wave_s == 0 && hw_lane_id() == 0); }
                res_fixup(F, E, S);
            } else if ((PHMASK & 16) && s == 2) {
                pg8::Gemm g{(const bf16_t*)(ws + WS_XB), (const bf16_t*)(ws + WS_WIN), MPAD, 2048, D};
                pg8::StaticOrder S; S.init(MPAD, 2048, D, F.G, (int)blockIdx.x);
                EpiWin E{(bf16_t*)(ws + WS_U), (bf16_t*)(ws + WS_BX), (bf16_t*)(ws + WS_GG), SS + (size_t)(3 * l + 1) * MPAD};
                pg8::gemm_phase<EpiWin, pg8::StaticOrder, true, true>(F.lds, g, S, E, wave_s);
            } else if ((PHMASK & 32) && s == 3) mix_a_phase(F, l, rep ? MIXSEL : 3);
            else if ((PHMASK & 64) && s == 4) mix_c_phase(F, l, rep);
        }
        }
        if (rep == 1 && ph + 1 < ph_hi) {
            const __attribute__((address_space(4))) Args* ap2 = (const __attribute__((address_space(4))) Args*)__builtin_amdgcn_kernarg_segment_ptr();
            unsigned* barw = (unsigned*)(ap2->ws + WS_BAR);
            if (ph_hi > 1000) cg::this_grid().sync();
            XcdBarrier xb; xb.bar = barw; xb.x = xb_xcc_id(); xb.st = (volatile LAS unsigned*)(F.lds + LDS_BARST);
            xcd_barrier(xb, wave_s == 0 && hw_lane_id() == 0);
        }
    }
}

#ifndef MK_FUSED
#define MK_FUSED 1
#endif
extern "C" void kernel_launch(void* const* d_in, const int* in_sizes, int n_in, void* d_out, int out_size, void* d_ws, size_t ws_size, hipStream_t stream) {
    static int grid = 0;
    if (grid == 0) {
        if (n_in != N_IN || (size_t)out_size != O_END || ws_size < WS_END) { fprintf(stderr, "kernel_launch: unexpected shapes: n_in %d out %d ws %zu (need %zu)\n", n_in, out_size, ws_size, (size_t)WS_END); grid = -1; return; }
        int dev = 0, cus = 0, per_cu = 0;
        hipGetDevice(&dev); hipDeviceGetAttribute(&cus, hipDeviceAttributeMultiprocessorCount, dev);
        if (hipFuncSetAttribute((const void*)mega_fwd, hipFuncAttributeMaxDynamicSharedMemorySize, LDS_BYTES) != hipSuccess) { fprintf(stderr, "kernel_launch: hipFuncSetAttribute failed\n"); grid = -1; return; }
        if (hipOccupancyMaxActiveBlocksPerMultiprocessor(&per_cu, (const void*)mega_fwd, NWAVES * 64, LDS_BYTES) != hipSuccess || per_cu < 1) { fprintf(stderr, "kernel_launch: occupancy query failed (%d)\n", per_cu); (void)hipGetLastError(); per_cu = 1; }
        grid = cus * 1;
        fprintf(stderr, "kernel_launch: cus %d per_cu %d grid %d ws %zu\n", cus, per_cu, grid, ws_size);
    }
    if (grid < 0) return;
    Args a{};
    for (int i = 0; i < N_IN; ++i) a.in[i] = (const float*)d_in[i];
    a.out = (float*)d_out; a.ws = (unsigned char*)d_ws;
#if MK_FUSED
    a.ph_lo = 0; a.ph_hi = NPH;
    if (hipMemsetAsync((unsigned char*)d_ws + WS_BAR, 0, 0x10000, stream) != hipSuccess) { fprintf(stderr, "kernel_launch: memset of the barrier words failed\n"); return; }
    void* kargs[] = {&a};
    hipError_t e = hipLaunchCooperativeKernel((const void*)mega_fwd, dim3(grid), dim3(NWAVES * 64), kargs, LDS_BYTES, stream);
    if (e != hipSuccess) fprintf(stderr, "cooperative launch failed: %s (grid %d)\n", hipGetErrorString(e), grid);
#else
    for (int ph = 0; ph < NPH; ++ph) { a.ph_lo = ph; a.ph_hi = ph + 1; hipLaunchKernelGGL(mega_fwd, dim3(grid), dim3(NWAVES * 64), LDS_BYTES, stream, a); }
#endif
}
```

```cpp
#include <hip/hip_runtime.h>
#include <hip/hip_cooperative_groups.h>
#include <cstdio>
#include <cstdint>
namespace cg = cooperative_groups;
__device__ __forceinline__ int hw_lane_id() { int l; asm volatile("v_mbcnt_lo_u32_b32 %0, -1, 0\n\tv_mbcnt_hi_u32_b32 %0, -1, %0" : "=v"(l)); return l; }
namespace pg8 {
#define PG8_LAS __attribute__((address_space(3)))
typedef unsigned short bf16_t;
typedef short bf16x8 __attribute__((ext_vector_type(8)));
typedef float f32x4 __attribute__((ext_vector_type(4)));
typedef unsigned u32x4 __attribute__((ext_vector_type(4)));
constexpr int BM = 256, BK = 64, HALF = 128, HTB = HALF * BK * 2  , STAGE_BYTES = 8 * HTB, NXCD = 8, WGM = 8;

__host__ __device__ __forceinline__ int lds_byte(int r, int c) { const int st = (r >> 4) * 2 + (c >> 5), rr = r & 15, cc = c & 31, ob = rr * 64 + cc * 2; return st * 1024 + (ob ^ (((ob >> 9) & 1) << 5)); }
__host__ __device__ __forceinline__ void stage_rc(int b, int& R, int& C) { const int st = b / 1024, sb = b % 1024, swz = sb ^ (((sb >> 9) & 1) << 5); R = (st >> 1) * 16 + swz / 64; C = (st & 1) * 32 + (swz % 64) / 2; }
__host__ __device__ __forceinline__ int perm32(int rho) { const int n = rho >> 4, i = rho & 15; return 8 * (i >> 2) + 4 * n + (i & 3); }

struct Unit { int pm, pn, k0, len, kind; };
struct Gemm { const bf16_t* A; const bf16_t* Bt; int M, N, K; };

struct StaticOrder {
    static constexpr bool STREAMK = false;
    int nM, nN, nwg, G, c, nt;
    __host__ __device__ void init(int M, int N, int K, int G_, int c_) { nM = M / BM; nN = N / BM; nwg = nM * nN; G = G_; c = c_; nt = K / BK; }
    __host__ __device__ bool next(int i, Unit& u) const {
        const long L = (long)i * G + c; if (L >= nwg) return false;
        int wgid = (int)L; { const int q = nwg / NXCD, r = nwg % NXCD, xcd = wgid % NXCD, off = wgid / NXCD; wgid = (xcd < r ? xcd * (q + 1) : r * (q + 1) + (xcd - r) * q) + off; }
        const int nig = WGM * nN, gid = wgid / nig, fm = gid * WGM, gsz = (nM - fm) < WGM ? (nM - fm) : WGM;
        u.pm = fm + ((wgid % nig) % gsz); u.pn = (wgid % nig) / gsz; u.k0 = 0; u.len = nt; u.kind = 0; return true;
    }
    __device__ __forceinline__ void a_ready(const Unit&) const {}
    __device__ __forceinline__ void done(const Unit&) const {}
    __device__ __forceinline__ void store_partial(const f32x4 (&)[2][2][4][2], int, int, int) const {}
    __device__ __forceinline__ void load_partial(f32x4 (&)[2][2][4][2], int, int, int) const {}
};
struct DpSplit {
    static constexpr bool STREAMK = true;
    int nM, nN, nwg, G, c, nt; float* slab;
    __device__ __forceinline__ void init(int M, int N, int K, int G_, int c_, float* slab_) { nM = M / BM; nN = N / BM; nwg = nM * nN; G = G_; c = c_; nt = K / BK; slab = slab_; }
    __device__ __forceinline__ void unit_of(int L, Unit& u) const {
        int wgid = L; { const int q = nwg / NXCD, r = nwg % NXCD, xcd = wgid % NXCD, off = wgid / NXCD; wgid = (xcd < r ? xcd * (q + 1) : r * (q + 1) + (xcd - r) * q) + off; }
        const int nig = WGM * nN, gid = wgid / nig, fm = gid * WGM, gsz = (nM - fm) < WGM ? (nM - fm) : WGM;
        u.pm = fm + ((wgid % nig) % gsz); u.pn = (wgid % nig) / gsz;
    }
    __device__ __forceinline__ bool next(int i, Unit& u) const {
        if (i == 0) { if (c >= nwg) return false; unit_of(c, u); u.k0 = 0; u.len = nt; u.kind = 0; return true; }
        if (i == 1 && c < 4 * (nwg - G)) {
            unit_of(G + (c >> 2), u);
            const int part = c & 3, lenp = (nt >> 2) & ~1, rem2 = (nt - 4 * lenp) >> 1;
            u.len = lenp + (part < rem2 ? 2 : 0); u.k0 = part * lenp + 2 * (part < rem2 ? part : rem2); u.kind = 1; return true;
        }
        return false;
    }
    __device__ __forceinline__ void a_ready(const Unit&) const {}
    __device__ __forceinline__ void done(const Unit&) const {}
    __device__ __forceinline__ void store_partial(const f32x4 (&acc)[2][2][4][2], int tid, int wid, int lane) const {
        typedef unsigned u32x4v __attribute__((ext_vector_type(4)));
        asm volatile("" : "+v"(tid));
        const __amdgpu_buffer_rsrc_t r = __builtin_amdgcn_make_buffer_rsrc((void*)(slab + (size_t)c * 65536), 0, 262144, 0x00020000);
        const int vo = tid * 16;
#pragma unroll
        for (int ai = 0; ai < 2; ++ai)
#pragma unroll
            for (int bj = 0; bj < 2; ++bj)
#pragma unroll
                for (int m = 0; m < 4; ++m)
#pragma unroll
                    for (int n = 0; n < 2; ++n) __builtin_amdgcn_raw_buffer_store_b128(__builtin_bit_cast(u32x4v, acc[ai][bj][m][n]), r, vo, (((ai * 2 + bj) * 4 + m) * 2 + n) * 8192, 16);
    }
    __device__ __forceinline__ void load_partial(f32x4 (&)[2][2][4][2], int, int, int) const {}
};

template <class Epi, class Sched, bool ALIGN_EPI = false, bool SP2 = false>
__device__ __forceinline__ void gemm_phase(PG8_LAS unsigned char* lds, const Gemm g, const Sched& S, const Epi& E, const int wave_s) {
    int tid_l = wave_s * 64 + hw_lane_id(); asm volatile("" : "+v"(tid_l));
    const int tid = tid_l, wid = __builtin_amdgcn_readfirstlane(tid >> 6), lane = tid & 63, wr = wid >> 2, wc = wid & 3, fr = lane & 15, fq = lane >> 4;
    const int K = g.K, nt = K / BK;
    unsigned voffA[2], voffB[2];
#pragma unroll
    for (int i = 0; i < 2; ++i) { int R, C; stage_rc(tid * 16 + i * 8192, R, C); const int Rb = Epi::PERM ? ((R & ~31) + perm32(R & 31)) : R;
        voffA[i] = (unsigned)(R * K + C) * 2u; voffB[i] = (unsigned)(Rb * K + C) * 2u; }
    const size_t kstep = (size_t)(BK * 2);
    const size_t hstep = (size_t)HALF * K * 2;
    const size_t tstep = 2 * hstep;
    const unsigned ldsw = (unsigned)wid * 1024u;
    const int aoff = lds_byte(wr * 64 + fr, fq * 8), boff = lds_byte(wc * 32 + fr, fq * 8);
#define PG8_SA(b, h) (((b) * 2 + (h)) * HTB)
#define PG8_SB(b, h) ((4 + (b) * 2 + (h)) * HTB)
#define PG8_STAGE(bufoff, gbase, voff) do { _Pragma("unroll") for (int _i = 0; _i < 2; ++_i) \
        __builtin_amdgcn_global_load_lds((const unsigned*)((const char*)(gbase) + (voff)[_i]), (PG8_LAS unsigned*)(lds + (bufoff) + ldsw + _i * 8192), 16, 0, 0); } while (0)
#define PG8_LDA(dst, b, h) do { _Pragma("unroll") for (int m = 0; m < 4; ++m) _Pragma("unroll") for (int k = 0; k < 2; ++k) dst[m][k] = *(const PG8_LAS bf16x8*)(lds + PG8_SA(b, h) + aoff + m * 2048 + k * 1024); } while (0)
#define PG8_LDB(dst, b, h) do { _Pragma("unroll") for (int n = 0; n < 2; ++n) _Pragma("unroll") for (int k = 0; k < 2; ++k) dst[n][k] = *(const PG8_LAS bf16x8*)(lds + PG8_SB(b, h) + boff + n * 2048 + k * 1024); } while (0)
#define PG8_MMA(ai, bj, At, Bt) do { __builtin_amdgcn_s_setprio(1); _Pragma("unroll") for (int m = 0; m < 4; ++m) _Pragma("unroll") for (int n = 0; n < 2; ++n) _Pragma("unroll") for (int k = 0; k < 2; ++k) \
        acc[ai][bj][m][n] = __builtin_amdgcn_mfma_f32_16x16x32_bf16(Bt[n][k], At[m][k], acc[ai][bj][m][n], 0, 0, 0); __builtin_amdgcn_s_setprio(0); } while (0)
#define PG8_WAIT_V(n) asm volatile("s_waitcnt vmcnt(" #n ")" ::: "memory")
#define PG8_WAIT_L(n) asm volatile("s_waitcnt lgkmcnt(" #n ")" ::: "memory")
#define PG8_BAR __builtin_amdgcn_s_barrier()
#define PG8_SCHED __builtin_amdgcn_sched_barrier(0)
    Unit cur, nxt; int ui = 0;
    if (!S.next(0, cur)) return;
    f32x4 acc[2][2][4][2];
#pragma unroll
    for (int a = 0; a < 2; ++a)
#pragma unroll
        for (int b = 0; b < 2; ++b)
#pragma unroll
            for (int m = 0; m < 4; ++m)
#pragma unroll
                for (int n = 0; n < 2; ++n) acc[a][b][m][n] = (f32x4){0.f, 0.f, 0.f, 0.f};
    if (Sched::STREAMK && cur.kind == 2) S.load_partial(acc, tid, wid, lane);
    if constexpr (Epi::INIT_ACC) { if (cur.kind == 0) E.init(acc, cur, wr, wc, fr, fq); }
    bf16x8 At[4][2], B0[2][2], B1[2][2];
    const char* cA = (const char*)g.A + (size_t)cur.pm * tstep + (size_t)cur.k0 * kstep; const char* cB = (const char*)g.Bt + (size_t)cur.pn * tstep + (size_t)cur.k0 * kstep;
    S.a_ready(cur);
    if constexpr (SP2) {
        PG8_STAGE(PG8_SB(0, 0), cB, voffB); PG8_STAGE(PG8_SB(0, 1), cB + hstep, voffB); PG8_STAGE(PG8_SA(0, 0), cA, voffA); PG8_STAGE(PG8_SA(0, 1), cA + hstep, voffA);
        if (wr == 1) PG8_BAR;
        PG8_WAIT_V(2); PG8_BAR;
        PG8_STAGE(PG8_SB(1, 0), cB + kstep, voffB); PG8_STAGE(PG8_SA(1, 0), cA + kstep, voffA); PG8_STAGE(PG8_SB(1, 1), cB + hstep + kstep, voffB);
        PG8_WAIT_V(6); PG8_BAR;
    } else {
        PG8_STAGE(PG8_SB(0, 0), cB, voffB); PG8_STAGE(PG8_SA(0, 0), cA, voffA); PG8_STAGE(PG8_SB(0, 1), cB + hstep, voffB); PG8_STAGE(PG8_SA(0, 1), cA + hstep, voffA);
        if (wr == 1) PG8_BAR;
        PG8_WAIT_V(4); PG8_BAR;
        PG8_STAGE(PG8_SB(1, 0), cB + kstep, voffB); PG8_STAGE(PG8_SA(1, 0), cA + kstep, voffA); PG8_STAGE(PG8_SB(1, 1), cB + hstep + kstep, voffB);
        PG8_WAIT_V(6); PG8_BAR;
    }
    for (;;) {
        const bool has_next = S.next(ui + 1, nxt);
        const char* nA = has_next ? (const char*)g.A + (size_t)nxt.pm * tstep + (size_t)nxt.k0 * kstep : cA; const char* nB = has_next ? (const char*)g.Bt + (size_t)nxt.pn * tstep + (size_t)nxt.k0 * kstep : cB;
        const int clen = cur.len;
        for (int t = 0; t < clen; t += 2) {
            const bool last = (t == clen - 2);
            const char* a1 = cA + (size_t)(t + 1) * kstep;
            const char* a2 = last ? nA : cA + (size_t)(t + 2) * kstep; const char* b2 = last ? nB : cB + (size_t)(t + 2) * kstep;
            const char* a3 = a2 + kstep; const char* b3 = b2 + kstep;
            if (last && has_next) S.a_ready(nxt);
            if constexpr (SP2) {
            PG8_LDB(B0, 0, 0); PG8_LDB(B1, 0, 1); PG8_SCHED; PG8_LDA(At, 0, 0); PG8_STAGE(PG8_SA(1, 1), a1 + hstep, voffA);
            PG8_WAIT_V(8); PG8_WAIT_L(0); PG8_BAR; PG8_MMA(0, 0, At, B0); PG8_MMA(0, 1, At, B1); PG8_BAR; PG8_SCHED;
            PG8_LDA(At, 0, 1); PG8_STAGE(PG8_SB(0, 0), b2, voffB); PG8_STAGE(PG8_SB(0, 1), b2 + hstep, voffB); PG8_STAGE(PG8_SA(0, 0), a2, voffA);
            PG8_WAIT_V(8); PG8_WAIT_L(0); PG8_BAR; PG8_MMA(1, 0, At, B0); PG8_MMA(1, 1, At, B1); PG8_BAR; PG8_SCHED;
            PG8_LDB(B0, 1, 0); PG8_LDB(B1, 1, 1); PG8_SCHED; PG8_LDA(At, 1, 0); PG8_STAGE(PG8_SA(0, 1), a2 + hstep, voffA);
            PG8_WAIT_V(8); PG8_WAIT_L(0); PG8_BAR; PG8_MMA(0, 0, At, B0); PG8_MMA(0, 1, At, B1); PG8_BAR; PG8_SCHED;
            PG8_LDA(At, 1, 1); PG8_STAGE(PG8_SB(1, 0), b3, voffB); PG8_STAGE(PG8_SB(1, 1), b3 + hstep, voffB); PG8_STAGE(PG8_SA(1, 0), a3, voffA);
            PG8_WAIT_V(8); PG8_WAIT_L(0); PG8_BAR; PG8_MMA(1, 0, At, B0); PG8_MMA(1, 1, At, B1); PG8_BAR; PG8_SCHED;
            } else {
            PG8_LDB(B0, 0, 0); PG8_SCHED; PG8_LDA(At, 0, 0); PG8_STAGE(PG8_SA(1, 1), a1 + hstep, voffA);
            PG8_WAIT_L(8); PG8_BAR; PG8_WAIT_L(0); PG8_MMA(0, 0, At, B0); PG8_BAR; PG8_SCHED;
            PG8_LDB(B1, 0, 1); PG8_STAGE(PG8_SB(0, 0), b2, voffB);
            PG8_BAR; PG8_WAIT_L(0); PG8_MMA(0, 1, At, B1); PG8_BAR;
            PG8_LDA(At, 0, 1); PG8_STAGE(PG8_SA(0, 0), a2, voffA);
            PG8_BAR; PG8_WAIT_L(0); PG8_MMA(1, 0, At, B0); PG8_BAR; PG8_SCHED;
            PG8_STAGE(PG8_SB(0, 1), b2 + hstep, voffB);
            PG8_WAIT_V(6); PG8_BAR; PG8_MMA(1, 1, At, B1); PG8_BAR;
            PG8_LDB(B0, 1, 0); PG8_SCHED; PG8_LDA(At, 1, 0); PG8_STAGE(PG8_SA(0, 1), a2 + hstep, voffA);
            PG8_WAIT_L(8); PG8_BAR; PG8_WAIT_L(0); PG8_MMA(0, 0, At, B0); PG8_BAR; PG8_SCHED;
            PG8_LDB(B1, 1, 1); PG8_STAGE(PG8_SB(1, 0), b3, voffB);
            PG8_BAR; PG8_WAIT_L(0); PG8_MMA(0, 1, At, B1); PG8_BAR;
            PG8_LDA(At, 1, 1); PG8_STAGE(PG8_SA(1, 0), a3, voffA);
            PG8_BAR; PG8_WAIT_L(0); PG8_MMA(1, 0, At, B0); PG8_BAR; PG8_SCHED;
            PG8_STAGE(PG8_SB(1, 1), b3 + hstep, voffB);
            PG8_WAIT_V(6); PG8_BAR; PG8_MMA(1, 1, At, B1); PG8_BAR;
            }
        }
        if constexpr (ALIGN_EPI) { if (wr == 0) PG8_BAR; }
        if constexpr (!Epi::AFTER_DRAIN) {
            int fr_l = fr, fq_l = fq; asm volatile("" : "+v"(fr_l), "+v"(fq_l));
            if constexpr (Sched::STREAMK) {
                if (cur.kind == 1) S.store_partial(acc, tid, wid, lane);
                else E(acc, cur, wr, wc, fr_l, fq_l);
            } else E(acc, cur, wr, wc, fr_l, fq_l);
            S.done(cur); }
        if (!has_next) break;
#define PG8_ZERO_ACC() do { _Pragma("unroll") for (int a = 0; a < 2; ++a) _Pragma("unroll") for (int b = 0; b < 2; ++b) _Pragma("unroll") for (int m = 0; m < 4; ++m) _Pragma("unroll") for (int n = 0; n < 2; ++n) acc[a][b][m][n] = (f32x4){0.f, 0.f, 0.f, 0.f}; } while (0)
        if constexpr (Epi::INIT_ACC) {
            if (Sched::STREAMK && nxt.kind == 2) S.load_partial(acc, tid, wid, lane);
            else if (nxt.kind == 0) { int fr_i = fr, fq_i = fq; asm volatile("" : "+v"(fr_i), "+v"(fq_i)); E.init(acc, nxt, wr, wc, fr_i, fq_i); }
            else PG8_ZERO_ACC();
        } else {
            if (Sched::STREAMK && nxt.kind == 2) S.load_partial(acc, tid, wid, lane);
            else PG8_ZERO_ACC();
        }
#undef PG8_ZERO_ACC
        cur = nxt; cA = nA; cB = nB; ++ui;
        if constexpr (ALIGN_EPI) { if (wr == 1) PG8_BAR; }
    }
    PG8_WAIT_V(0);
    if constexpr (!ALIGN_EPI) { if (wr == 0) PG8_BAR; }
    PG8_BAR;
    if constexpr (Epi::AFTER_DRAIN) { E.fused(acc, cur, wr, wc, fr, fq, lds, wid, lane); S.done(cur); }
#undef PG8_SA
#undef PG8_SB
#undef PG8_STAGE
#undef PG8_LDA
#undef PG8_LDB
#undef PG8_MMA
#undef PG8_WAIT_V
#undef PG8_WAIT_L
#undef PG8_BAR
#undef PG8_SCHED
}
}

#define LAS __attribute__((address_space(3)))
typedef unsigned short bf16_t;
typedef float f32x4 __attribute__((ext_vector_type(4)));
typedef float f32x2 __attribute__((ext_vector_type(2)));
typedef unsigned u32x4 __attribute__((ext_vector_type(4)));
typedef unsigned u32x2 __attribute__((ext_vector_type(2)));

constexpr int D = 1024, FF = 2816, DA = 512, DB = 512;
constexpr int NB_P = 8, TP = 2064, NB_S = 128, TS = 8, NMETA = 16, SEQ = 2048;
constexpr int MP = NB_P * TP;
constexpr int MR = MP + NB_S * TS;
constexpr int MPAD = 17664;
constexpr int NCH_P = 33;
constexpr int NQ_P = NB_P * NCH_P;
constexpr int NQ_S = (NB_S * TS) / 64;
constexpr int NQ = NQ_P + NQ_S;
constexpr float EPS = 1e-6f;
constexpr int NWAVES = 8;

enum { I_XP = 0, I_XS, I_SCA, I_SCB, I_SH, I_META, I_GF1, I_W1G, I_W1U, I_W1D, I_GMIX, I_WIN, I_CAW, I_CAB, I_LNG, I_LNB, I_CBW, I_CBB,
       I_WRG, I_BRG, I_WIG, I_BIG, I_LAM, I_WOUT, I_GF2, I_W2G, I_W2U, I_W2D, I_GFIN, N_IN };
constexpr size_t O_YP = 0, O_YS = O_YP + (size_t)NB_P * SEQ * D, O_CAP = O_YS + (size_t)NB_S * TS * D, O_CBP = O_CAP + (size_t)2 * NB_P * 30 * DA,
                 O_HP = O_CBP + (size_t)2 * NB_P * 3 * DB, O_CAS = O_HP + (size_t)2 * NB_P * DB, O_CBS = O_CAS + (size_t)2 * NB_S * 30 * DA,
                 O_HS = O_CBS + (size_t)2 * NB_S * 3 * DB, O_END = O_HS + (size_t)2 * NB_S * DB;

constexpr size_t WS_SS = 0;
constexpr size_t WS_SUMM = 0x80000;
constexpr size_t WS_LAST = 0x1A0000;
constexpr size_t WS_W = 0x400000;
constexpr size_t SZ_WGU = (size_t)2 * FF * D * 2, SZ_WD = (size_t)D * FF * 2, SZ_WIN = (size_t)2048 * D * 2, SZ_WOUT = (size_t)D * D * 2;
constexpr size_t WS_WGU1 = WS_W, WS_WD1 = WS_WGU1 + SZ_WGU, WS_WIN = WS_WD1 + SZ_WD, WS_WOUT = WS_WIN + SZ_WIN, WS_WGU2 = WS_WOUT + SZ_WOUT, WS_WD2 = WS_WGU2 + SZ_WGU;
constexpr size_t WS_X = WS_WD2 + SZ_WD;
constexpr size_t WS_XB = WS_X + (size_t)MPAD * D * 4;
constexpr size_t WS_ACT = WS_XB + (size_t)MPAD * D * 2;
constexpr size_t WS_U = WS_ACT, WS_BX = WS_U + (size_t)MPAD * 512 * 2, WS_GG = WS_BX + (size_t)MPAD * 512 * 2, WS_YAB = WS_GG + (size_t)MPAD * 512 * 2;
constexpr size_t WS_END = WS_ACT + (size_t)MPAD * FF * 2;
static_assert(WS_YAB + (size_t)MPAD * D * 2 <= WS_END, "mixer overlay fits");
static_assert(WS_END <= 268435456, "ws map fits 256 MiB");
static_assert(WS_SS + 7 * (size_t)MPAD * 4 <= WS_SUMM && WS_SUMM + (size_t)NQ * 512 * 8 <= WS_LAST && WS_LAST + (size_t)128 * 512 * 8 <= WS_W, "small buffers");

constexpr int LDS_BYTES = 147456;

__device__ __forceinline__ float bf2f(bf16_t b) { return __uint_as_float(((unsigned)b) << 16); }
__device__ __forceinline__ unsigned pk2(float lo, float hi) { unsigned r; asm("v_cvt_pk_bf16_f32 %0, %1, %2" : "=v"(r) : "v"(lo), "v"(hi)); return r; }
__device__ __forceinline__ unsigned f2bf(float f) { return pk2(f, f) & 0xffffu; }
__device__ __forceinline__ float fast_rcp(float x) { return __builtin_amdgcn_rcpf(x); }
__device__ __forceinline__ float sigmoid_f(float x) { return fast_rcp(1.0f + __expf(-x)); }
__device__ __forceinline__ float silu_f(float x) { return x * sigmoid_f(x); }
__device__ __forceinline__ float gelu_tanh_f(float x) {
    const float u = 0.7978845608028654f * (x + 0.044715f * x * x * x);
    return x * sigmoid_f(2.0f * u);
}
__device__ __forceinline__ float neg_expm1_f(float x) {
    const float p = -x * (1.0f + x * (0.5f + x * (0.16666667f + x * (0.041666668f + x * (0.0083333338f + x * (0.0013888889f + x * 0.0001984127f))))));
    const float q = 1.0f - __expf(x);
    return x > -0.35f ? p : q;
}
__device__ __forceinline__ float wave_sum(float v) {
#pragma unroll
    for (int o = 1; o < 64; o <<= 1) v += __shfl_xor(v, o);
    return v;
}

#define XB_TMO      128
#define XB_XCNT(j)  (256  + 64 * (j))
#define XB_XSUB(j)  (1280 + 64 * (j))
#define XB_XGEN(j)  (2304 + 64 * (j))
#define XB_TOP      3328
#define XB_TOPGEN   3392
#define XCD_BAR_WORDS 3456
#define XB_SPIN_CAP (1u << 18)

__device__ __forceinline__ unsigned xb_ld(unsigned* p)              { return __hip_atomic_load(p, __ATOMIC_RELAXED, __HIP_MEMORY_SCOPE_AGENT); }
__device__ __forceinline__ unsigned xb_add(unsigned* p, unsigned v) { return __hip_atomic_fetch_add(p, v, __ATOMIC_RELAXED, __HIP_MEMORY_SCOPE_AGENT); }
__device__ __forceinline__ unsigned xb_xcc_id() { return (unsigned)__builtin_amdgcn_s_getreg((3 << 11) | 20) & 0xFu; }
#define XB_SPIN(cond, bar) do { unsigned _sp = 0; while (cond) { __builtin_amdgcn_s_sleep(1); \
    if ((++_sp & 255u) == 0u) { if (xb_ld(&(bar)[XB_TMO])) break; if (_sp > XB_SPIN_CAP) { atomicAdd(&(bar)[XB_TMO], 1u); break; } } } } while (0)

struct XcdBarrier {
    unsigned* bar; unsigned x;
    volatile LAS unsigned* st;
};

__device__ __forceinline__ XcdBarrier xcd_barrier_post(unsigned* bar, volatile LAS unsigned* st) {
    XcdBarrier b; b.bar = bar; b.x = xb_xcc_id(); b.st = st;
    if (threadIdx.x == 0) (void)xb_add(&bar[XB_XCNT(b.x)], 1u);
    return b;
}
__device__ __forceinline__ void xcd_barrier_complete(unsigned* bar, unsigned x, unsigned& nloc, unsigned& nx) {
    const unsigned G = gridDim.x * gridDim.y * gridDim.z;
    unsigned sum, cnt, mine, sp = 0u;
    for (;;) {
        sum = 0u; cnt = 0u; mine = 0u;
#pragma unroll
        for (unsigned j = 0; j < 16; ++j) { const unsigned c = xb_ld(&bar[XB_XCNT(j)]); sum += c; cnt += (c > 0u) ? 1u : 0u; mine = (j == x) ? c : mine; }
        if (sum == G) break;
        __builtin_amdgcn_s_sleep(1);
        if ((++sp & 255u) == 0u) { if (xb_ld(&bar[XB_TMO])) break; if (sp > XB_SPIN_CAP) { atomicAdd(&bar[XB_TMO], 1u); break; } }
    }
    nloc = mine > 0u ? mine : 1u; nx = cnt > 0u ? cnt : 1u;
}

__device__ __forceinline__ void xcd_barrier(const XcdBarrier& b, const bool is_t0) {
    asm volatile("s_waitcnt vmcnt(0)" ::: "memory");
    __syncthreads();
    if (is_t0) {
        unsigned* bar = b.bar;
        __builtin_amdgcn_s_waitcnt(0);
        unsigned nloc = b.st[0], nx = b.st[1];
        if (nloc == 0u) { xcd_barrier_complete(bar, b.x, nloc, nx); b.st[0] = nloc; b.st[1] = nx; }
        const unsigned old = xb_add(&bar[XB_XSUB(b.x)], 1u);
        const unsigned gen = old / nloc;
        if (old + 1u == (gen + 1u) * nloc) {
            __builtin_amdgcn_fence(__ATOMIC_RELEASE, "agent");
            asm volatile("s_waitcnt vmcnt(0)" ::: "memory");
            const unsigned og = xb_add(&bar[XB_TOP], 1u);
            const unsigned tg = og / nx;
            if (og + 1u == (tg + 1u) * nx) xb_add(&bar[XB_TOPGEN], 1u);
            else XB_SPIN(xb_ld(&bar[XB_TOPGEN]) == tg, bar);
            __builtin_amdgcn_fence(__ATOMIC_ACQUIRE, "agent");
            xb_add(&bar[XB_XGEN(b.x)], 1u);
            asm volatile("s_waitcnt vmcnt(0)" ::: "memory");
        } else {
            XB_SPIN(xb_ld(&bar[XB_XGEN(b.x)]) == gen, bar);
            __builtin_amdgcn_fence(__ATOMIC_ACQUIRE, "agent");
            asm volatile("s_waitcnt vmcnt(0)" ::: "memory");
        }
    }
    __syncthreads();
}

constexpr size_t WS_BAR = 0x380000;
constexpr int LDS_BARST = 139264;
constexpr size_t WS_SKF = 0x390000;

struct EpiGU {
    static constexpr bool PERM = true, AFTER_DRAIN = false, INIT_ACC = false;
    bf16_t* ACT; const float* ss;
    __device__ __forceinline__ void operator()(const f32x4 (&acc)[2][2][4][2], const pg8::Unit& u, int wr, int wc, int fr, int fq) const {
        const int row0 = u.pm * 256 + wr * 64 + fr, col0 = u.pn * 128 + wc * 32 + 8 * fq;
        float rs[2][4];
#pragma unroll
        for (int ai = 0; ai < 2; ++ai)
#pragma unroll
            for (int m = 0; m < 4; ++m) rs[ai][m] = ss[row0 + ai * 128 + m * 16];
#pragma unroll
        for (int ai = 0; ai < 2; ++ai)
#pragma unroll
            for (int m = 0; m < 4; ++m) {
                const int r = row0 + ai * 128 + m * 16;
                const float rstd = __builtin_amdgcn_rsqf(rs[ai][m] * (1.0f / D) + EPS);
                float o[8];
#pragma unroll
                for (int n = 0; n < 2; ++n)
#pragma unroll
                    for (int e = 0; e < 4; ++e) { const float g = acc[ai][0][m][n][e] * rstd, up = acc[ai][1][m][n][e] * rstd; o[4 * n + e] = silu_f(g) * up; }
                u32x4 w; w.x = pk2(o[0], o[1]); w.y = pk2(o[2], o[3]); w.z = pk2(o[4], o[5]); w.w = pk2(o[6], o[7]);
                *(u32x4*)(ACT + (size_t)r * FF + col0) = w;
            }
    }
};
struct EpiRes {
    static constexpr bool PERM = true, AFTER_DRAIN = false, INIT_ACC = true;
    float* X; bf16_t* XB; float* ssn; float scale;
    __device__ __forceinline__ void init(f32x4 (&acc)[2][2][4][2], const pg8::Unit& u, int wr, int wc, int fr, int fq) const {
        const int row0 = u.pm * 256 + wr * 64 + fr, col0 = u.pn * 256 + wc * 32 + 8 * fq; const float inv = 1.0f / scale;
#pragma unroll
        for (int ai = 0; ai < 2; ++ai)
#pragma unroll
            for (int m = 0; m < 4; ++m)
#pragma unroll
                for (int bj = 0; bj < 2; ++bj) { const float* xp = X + (size_t)(row0 + ai * 128 + m * 16) * D + col0 + bj * 128; acc[ai][bj][m][0] = *(const f32x4*)xp * inv; acc[ai][bj][m][1] = *(const f32x4*)(xp + 4) * inv; }
    }
    __device__ __forceinline__ void operator()(const f32x4 (&acc)[2][2][4][2], const pg8::Unit& u, int wr, int wc, int fr, int fq) const {
        const int row0 = u.pm * 256 + wr * 64 + fr, col0 = u.pn * 256 + wc * 32 + 8 * fq;
#pragma unroll
        for (int ai = 0; ai < 2; ++ai)
#pragma unroll
            for (int m = 0; m < 4; ++m) {
                const int r = row0 + ai * 128 + m * 16; float q = 0.f;
#pragma unroll
                for (int bj = 0; bj < 2; ++bj) {
                    float* xp = X + (size_t)r * D + col0 + bj * 128;
                    const f32x4 v0 = acc[ai][bj][m][0] * scale, v1 = acc[ai][bj][m][1] * scale;
                    *(f32x4*)xp = v0; *(f32x4*)(xp + 4) = v1;
                    u32x4 w; w.x = pk2(v0[0], v0[1]); w.y = pk2(v0[2], v0[3]); w.z = pk2(v1[0], v1[1]); w.w = pk2(v1[2], v1[3]);
                    *(u32x4*)(XB + (size_t)r * D + col0 + bj * 128) = w;
                    q += (v0[0] * v0[0] + v0[1] * v0[1]) + (v0[2] * v0[2] + v0[3] * v0[3]) + (v1[0] * v1[0] + v1[1] * v1[1]) + (v1[2] * v1[2] + v1[3] * v1[3]);
                }
                q += __shfl_xor(q, 16); q += __shfl_xor(q, 32);
                if (fq == 0) atomicAdd(ssn + r, q);
            }
    }
};
struct EpiWin {
    static constexpr bool PERM = true, AFTER_DRAIN = false, INIT_ACC = false;
    bf16_t *U, *BX, *GG; const float* ss;
    __device__ __forceinline__ void operator()(const f32x4 (&acc)[2][2][4][2], const pg8::Unit& u, int wr, int wc, int fr, int fq) const {
        const int row0 = u.pm * 256 + wr * 64 + fr, col0 = (u.pn & 3) * 128 + wc * 32 + 8 * fq;
        const bool isA = u.pn < 4;
        float rs[2][4];
#pragma unroll
        for (int ai = 0; ai < 2; ++ai)
#pragma unroll
            for (int m = 0; m < 4; ++m) rs[ai][m] = ss[row0 + ai * 128 + m * 16];
#pragma unroll
        for (int ai = 0; ai < 2; ++ai)
#pragma unroll
            for (int m = 0; m < 4; ++m) {
                const int r = row0 + ai * 128 + m * 16;
                const float rstd = __builtin_amdgcn_rsqf(rs[ai][m] * (1.0f / D) + EPS);
                float a0[8], a1[8];
#pragma unroll
                for (int n = 0; n < 2; ++n)
#pragma unroll
                    for (int e = 0; e < 4; ++e) { a0[4 * n + e] = acc[ai][0][m][n][e] * rstd; a1[4 * n + e] = acc[ai][1][m][n][e] * rstd; }
                if (isA) {
                    float o[8];
#pragma unroll
                    for (int e = 0; e < 8; ++e) o[e] = a0[e] * sigmoid_f(a1[e]);
                    u32x4 w; w.x = pk2(o[0], o[1]); w.y = pk2(o[2], o[3]); w.z = pk2(o[4], o[5]); w.w = pk2(o[6], o[7]);
                    *(u32x4*)(U + (size_t)r * 512 + col0) = w;
                } else {
                    float o[8];
#pragma unroll
                    for (int e = 0; e < 8; ++e) o[e] = gelu_tanh_f(a1[e]);
                    u32x4 w; w.x = pk2(a0[0], a0[1]); w.y = pk2(a0[2], a0[3]); w.z = pk2(a0[4], a0[5]); w.w = pk2(a0[6], a0[7]);
                    *(u32x4*)(BX + (size_t)r * 512 + col0) = w;
                    u32x4 g; g.x = pk2(o[0], o[1]); g.y = pk2(o[2], o[3]); g.z = pk2(o[4], o[5]); g.w = pk2(o[6], o[7]);
                    *(u32x4*)(GG + (size_t)r * 512 + col0) = g;
                }
            }
    }
};

struct Args { const float* in[N_IN]; float* out; unsigned char* ws; int ph_lo, ph_hi; };
struct Frame {
    LAS unsigned char* lds;
    int tid, lane, wave, G;
    const float* const __attribute__((address_space(4)))* in; float* out; unsigned char* ws;
};
#define LDS_WAIT() asm volatile("s_waitcnt lgkmcnt(0)" ::: "memory")

template <class FrameT>
__device__ __forceinline__ void res_fixup(FrameT& F, const EpiRes& E, const pg8::DpSplit& S) {
    const int nleft = S.nwg - S.G, tid = F.tid, wid = tid >> 6, lane = tid & 63, wr = wid >> 2, wc = wid & 3, fr = lane & 15, fq = lane >> 4;
    for (int item = blockIdx.x; item < nleft * 8; item += F.G) {
        const int j = item >> 3, ai = (item >> 2) & 1, m = item & 3;
        pg8::Unit u; S.unit_of(S.G + j, u);
        const int r = u.pm * 256 + wr * 64 + fr + ai * 128 + m * 16, col0 = u.pn * 256 + wc * 32 + 8 * fq;
        float q = 0.f;
#pragma unroll
        for (int bj = 0; bj < 2; ++bj) {
            f32x4 a0 = {0.f, 0.f, 0.f, 0.f}, a1 = {0.f, 0.f, 0.f, 0.f};
#pragma unroll
            for (int p = 0; p < 4; ++p) {
                const float* sp = S.slab + (size_t)(4 * j + p) * 65536 + (size_t)((((ai * 2 + bj) * 4 + m) * 2) * 2048) + tid * 4;
                a0 += __builtin_nontemporal_load((const f32x4*)sp); a1 += __builtin_nontemporal_load((const f32x4*)(sp + 2048));
            }
            float* xp = E.X + (size_t)r * D + col0 + bj * 128;
            f32x4 v0 = *(f32x4*)xp, v1 = *(f32x4*)(xp + 4);
            v0 = v0 + a0 * E.scale; v1 = v1 + a1 * E.scale;
            *(f32x4*)xp = v0; *(f32x4*)(xp + 4) = v1;
            u32x4 w; w.x = pk2(v0[0], v0[1]); w.y = pk2(v0[2], v0[3]); w.z = pk2(v1[0], v1[1]); w.w = pk2(v1[2], v1[3]);
            *(u32x4*)(E.XB + (size_t)r * D + col0 + bj * 128) = w;
            q += (v0[0] * v0[0] + v0[1] * v0[1]) + (v0[2] * v0[2] + v0[3] * v0[3]) + (v1[0] * v1[0] + v1[1] * v1[1]) + (v1[2] * v1[2] + v1[3] * v1[3]);
        }
        q += __shfl_xor(q, 16); q += __shfl_xor(q, 32);
        if (fq == 0) atomicAdd(E.ssn + r, q);
    }
}


__device__ __forceinline__ void transpose_item(const float* W, int K, int N, bf16_t* WT, const float* g, int mode, LAS float* scr, int item, int lane) {
    const int nblk = N / 32, kb = item / nblk, nb = item % nblk, k0 = 64 * kb, n0 = 32 * nb;
    float tv[32];
#pragma unroll
    for (int i = 0; i < 32; ++i) { const int kk = 2 * i + (lane >> 5); tv[i] = __builtin_nontemporal_load(W + (size_t)(k0 + kk) * N + n0 + (lane & 31)); }
    if (g) {
#pragma unroll
        for (int i = 0; i < 32; ++i) tv[i] *= g[k0 + 2 * i + (lane >> 5)];
    }
#pragma unroll
    for (int i = 0; i < 32; ++i) scr[(2 * i + (lane >> 5)) * 33 + (lane & 31)] = tv[i];
    LDS_WAIT(); asm volatile("" ::: "memory");
    int d0;
    if (mode == 0) d0 = n0;
    else if (mode == 1) d0 = 256 * (n0 >> 7) + (n0 & 127);
    else if (mode == 2) d0 = 256 * (n0 >> 7) + 128 + (n0 & 127);
    else { const int seg = n0 >> 9, cc = n0 & 511; d0 = 256 * ((seg >> 1) * 4 + (cc >> 7)) + 128 * (seg & 1) + (cc & 127); }
    const int c = lane & 7;
#pragma unroll
    for (int j = 0; j < 4; ++j) { const int n = (lane >> 3) + 8 * j; const LAS float* s = scr + (8 * c) * 33 + n;
        u32x4 o; o.x = pk2(s[0 * 33], s[1 * 33]); o.y = pk2(s[2 * 33], s[3 * 33]); o.z = pk2(s[4 * 33], s[5 * 33]); o.w = pk2(s[6 * 33], s[7 * 33]);
        *(u32x4*)(WT + (size_t)(d0 + n) * K + k0 + 8 * c) = o; }
    LDS_WAIT(); asm volatile("" ::: "memory");
}
constexpr int IT_G = (D / 64) * (FF / 32), IT_D = (FF / 64) * (D / 32), IT_WIN = (D / 64) * (2048 / 32), IT_WOUT = (D / 64) * (D / 32);
__device__ __forceinline__ void convert_mats(Frame& F, int l, int id_lo, int id_hi, int gw, int NGW) {
    LAS float* scr = (LAS float*)(F.lds + F.wave * 16384);
    unsigned char* ws = F.ws;
    for (int id = id_lo; id < id_hi; ++id) {
        const int nit = (id == 0 || id == 4) ? 2 * IT_G : (id == 1 || id == 5) ? IT_D : (id == 2 ? IT_WIN : IT_WOUT);
        for (int it = gw; it < nit; it += NGW) {
            if (id == 0) { const bool up = it >= IT_G; transpose_item(F.in[up ? I_W1U : I_W1G] + (size_t)l * D * FF, D, FF, (bf16_t*)(ws + WS_WGU1), F.in[I_GF1] + l * D, up ? 2 : 1, scr, up ? it - IT_G : it, F.lane); }
            else if (id == 4) { const bool up = it >= IT_G; transpose_item(F.in[up ? I_W2U : I_W2G] + (size_t)l * D * FF, D, FF, (bf16_t*)(ws + WS_WGU2), F.in[I_GF2] + l * D, up ? 2 : 1, scr, up ? it - IT_G : it, F.lane); }
            else if (id == 1) transpose_item(F.in[I_W1D] + (size_t)l * D * FF, FF, D, (bf16_t*)(ws + WS_WD1), nullptr, 0, scr, it, F.lane);
            else if (id == 5) transpose_item(F.in[I_W2D] + (size_t)l * D * FF, FF, D, (bf16_t*)(ws + WS_WD2), nullptr, 0, scr, it, F.lane);
            else if (id == 2) transpose_item(F.in[I_WIN] + (size_t)l * D * 2048, D, 2048, (bf16_t*)(ws + WS_WIN), F.in[I_GMIX] + l * D, 3, scr, it, F.lane);
            else transpose_item(F.in[I_WOUT] + (size_t)l * D * D, D, D, (bf16_t*)(ws + WS_WOUT), nullptr, 0, scr, it, F.lane);
        }
    }
}

__device__ __forceinline__ void p0_prologue(Frame& F) {
    convert_mats(F, 0, 0, 6, blockIdx.x * NWAVES + F.wave, F.G * NWAVES);
    const int gw = blockIdx.x * NWAVES + F.wave, NGW = F.G * NWAVES;
    float* X = (float*)(F.ws + WS_X); bf16_t* XB = (bf16_t*)(F.ws + WS_XB); float* ss = (float*)(F.ws + WS_SS);
    for (int r = gw; r < MPAD; r += NGW) {
        const float* src = nullptr;
        if (r < MP) { const int b = r / TP, tt = r - b * TP; src = tt < NMETA ? F.in[I_META] + (size_t)tt * D : F.in[I_XP] + ((size_t)b * SEQ + (tt - NMETA)) * D; }
        else if (r < MR) src = F.in[I_XS] + (size_t)(r - MP) * D;
        f32x4 v[4]; float s = 0.f;
#pragma unroll
        for (int j = 0; j < 4; ++j) { v[j] = src ? __builtin_nontemporal_load((const f32x4*)src + F.lane + 64 * j) : (f32x4){0.f, 0.f, 0.f, 0.f}; s += (v[j][0] * v[j][0] + v[j][1] * v[j][1]) + (v[j][2] * v[j][2] + v[j][3] * v[j][3]); }
        s = wave_sum(s);
#pragma unroll
        for (int j = 0; j < 4; ++j) { ((f32x4*)(X + (size_t)r * D))[F.lane + 64 * j] = v[j];
            u32x2 w; w.x = pk2(v[j][0], v[j][1]); w.y = pk2(v[j][2], v[j][3]); ((u32x2*)(XB + (size_t)r * D))[F.lane + 64 * j] = w; }
        if (F.lane == 0) ss[r] = s;
    }
    { const int i = blockIdx.x * 512 + F.tid; if (i < 6 * MPAD) ss[MPAD + i] = 0.f; }
}

__device__ __forceinline__ void final_phase(Frame& F) {
    const int gw = blockIdx.x * NWAVES + F.wave, NGW = F.G * NWAVES;
    const float* X = (const float*)(F.ws + WS_X); const float* ss = (const float*)(F.ws + WS_SS) + 6 * MPAD; const float* g = F.in[I_GFIN];
    f32x4 gv[4];
#pragma unroll
    for (int j = 0; j < 4; ++j) gv[j] = ((const f32x4*)g)[F.lane + 64 * j];
    for (int r = gw; r < MR; r += NGW) {
        float* dst;
        if (r < MP) { const int b = r / TP, tt = r - b * TP; if (tt < NMETA) continue; dst = F.out + O_YP + ((size_t)b * SEQ + (tt - NMETA)) * D; }
        else dst = F.out + O_YS + (size_t)(r - MP) * D;
        const float rstd = __builtin_amdgcn_rsqf(ss[r] * (1.0f / D) + EPS);
#pragma unroll
        for (int j = 0; j < 4; ++j) { const f32x4 v = ((const f32x4*)(X + (size_t)r * D))[F.lane + 64 * j]; __builtin_nontemporal_store(v * rstd * gv[j], (f32x4*)dst + F.lane + 64 * j); }
    }
}

constexpr int LDS_WR = 0, LDS_WI = 16384, LDS_CBT = 32768, LDS_GRP = LDS_CBT + 4 * 64 * 68 * 4, LDS_RED = 0;

__device__ __forceinline__ float reduce_scatter32(float (&v)[32], int lane) {
#define RS_STEP(H, M) { const bool up = (lane & (M)) != 0; _Pragma("unroll") for (int i = 0; i < (H); ++i) { const float snd = up ? v[i] : v[i + (H)], kp = up ? v[i + (H)] : v[i]; v[i] = kp + __shfl_xor(snd, (M)); } }
    RS_STEP(16, 32) RS_STEP(8, 16) RS_STEP(4, 8) RS_STEP(2, 4) RS_STEP(1, 2)
#undef RS_STEP
    return v[0] + __shfl_xor(v[0], 1);
}

__device__ __forceinline__ void mix_job_a(Frame& F, int l, int sp, int gi) {
    const int tid = F.tid, c = 128 * gi + (tid & 127), sub = tid >> 7;
    const bf16_t* U = (const bf16_t*)(F.ws + WS_U); bf16_t* YAB = (bf16_t*)(F.ws + WS_YAB);
    const float* cw = F.in[I_CAW] + (size_t)l * 31 * DA;
    float w[31];
#pragma unroll
    for (int k = 0; k < 31; ++k) w[k] = cw[k * DA + c];
    const float cbias = F.in[I_CAB][l * DA + c], lg = F.in[I_LNG][l * DA + c], lb = F.in[I_LNB][l * DA + c];
    float acc[32];
#pragma unroll
    for (int t = 0; t < 32; ++t) acc[t] = cbias;
    int rowbase, nval;
    if (sp < 136) {
        const int b = sp / 17, k2 = sp - b * 17, nvalid = (k2 == 16) ? 16 : 128, seqrow0 = b * TP, tb = 128 * k2 + 32 * sub;
        nval = nvalid - 32 * sub; rowbase = seqrow0 + tb;
        if (nval > 0) {
#pragma unroll
            for (int tt = 0; tt < 62; ++tt) {
                const int ti = tb - 30 + tt;
                const float v = ti >= 0 ? bf2f(U[(size_t)(seqrow0 + ti) * 512 + c]) : 0.f;
#pragma unroll
                for (int t = 0; t < 32; ++t) { const int kk = tt - t; if (kk >= 0 && kk <= 30) acc[t] += w[kk] * v; }
            }
        }
    } else {
        nval = 32; const int s0 = 16 * (sp - 136) + 4 * sub; rowbase = MP + 8 * s0;
        const float* st = F.in[I_SCA] + (size_t)l * NB_S * 30 * DA;
#pragma unroll
        for (int hs = 0; hs < 4; ++hs) {
            const int s = s0 + hs, rowS = MP + 8 * s;
#pragma unroll
            for (int tt = 0; tt < 38; ++tt) {
                const float v = tt < 30 ? st[((size_t)s * 30 + tt) * DA + c] : bf2f(U[(size_t)(rowS + tt - 30) * 512 + c]);
#pragma unroll
                for (int t = 0; t < 8; ++t) { const int kk = tt - t; if (kk >= 0 && kk <= 30) acc[8 * hs + t] += w[kk] * v; }
            }
        }
    }
    LAS f32x2* red = (LAS f32x2*)(F.lds + LDS_RED);
    float s1[32], s2[32];
#pragma unroll
    for (int t = 0; t < 32; ++t) { s1[t] = acc[t]; s2[t] = acc[t] * acc[t]; }
    const float r1 = reduce_scatter32(s1, F.lane), r2 = reduce_scatter32(s2, F.lane);
    __syncthreads();
    if ((F.lane & 1) == 0) red[F.wave * 32 + (F.lane >> 1)] = (f32x2){r1, r2};
    __syncthreads();
    if (nval > 0) {
#pragma unroll
        for (int t = 0; t < 32; ++t) {
            const f32x2 a = red[F.wave * 32 + t], o = red[(F.wave ^ 1) * 32 + t];
            const float mean = (a.x + o.x) * (1.0f / 128.0f), var = (a.y + o.y) * (1.0f / 128.0f) - mean * mean;
            const float rstd = __builtin_amdgcn_rsqf(fmaxf(var, 0.f) + EPS);
            const float y = (acc[t] - mean) * rstd * lg + lb;
            if (t < nval) YAB[(size_t)(rowbase + t) * D + c] = (bf16_t)f2bf(silu_f(y));
        }
    }
}

constexpr int WJ_TILE = 9728;
constexpr int LDS_WT = 8 * WJ_TILE;
typedef short bf16x8_t __attribute__((ext_vector_type(8)));

__device__ __forceinline__ void mix_b_wave_jobs(Frame& F, int l) {
    const int lane = F.lane, wave = F.wave, fr = lane & 15, fq = lane >> 4, h = blockIdx.x & 7;
    const bf16_t* BX = (const bf16_t*)(F.ws + WS_BX);
    bf16_t* YAB = (bf16_t*)(F.ws + WS_YAB); bf16_t* PCG = (bf16_t*)(F.ws + WS_XB);
    LAS bf16_t* WT = (LAS bf16_t*)(F.lds + LDS_WT);
    LAS bf16_t* tile = (LAS bf16_t*)(F.lds + wave * WJ_TILE);
    __syncthreads();
    {
        const f32x4* gr = (const f32x4*)(F.in[I_WRG] + (size_t)(l * 8 + h) * 4096); const f32x4* gx = (const f32x4*)(F.in[I_WIG] + (size_t)(l * 8 + h) * 4096);
#pragma unroll
        for (int e = 0; e < 2; ++e) {
            const int idx = F.tid + e * 512, i = idx >> 4, j4 = (idx & 15) * 4;
            const f32x4 a = gr[idx], b = gx[idx];
#pragma unroll
            for (int d = 0; d < 4; ++d) { WT[(j4 + d) * 72 + i] = (bf16_t)f2bf(a[d]); WT[(64 + j4 + d) * 72 + i] = (bf16_t)f2bf(b[d]); }
        }
    }
    float bra[4], bix[4], sp[4];
#pragma unroll
    for (int nt = 0; nt < 4; ++nt) {
        const int c = 64 * h + 16 * nt + fr;
        bra[nt] = F.in[I_BRG][l * DB + c]; bix[nt] = F.in[I_BIG][l * DB + c];
        sp[nt] = log1pf(expf(-F.in[I_LAM][l * DB + c]));
    }
    __syncthreads();
    for (int q = (int)(blockIdx.x >> 3) * 8 + wave; q < NQ; q += 256) {
        const bool prompt = q < NQ_P;
        int row0, t0, nvalid;
        if (prompt) { const int b_ = q / NCH_P, k = q - b_ * NCH_P; row0 = b_ * TP + 64 * k; t0 = 64 * k; nvalid = (k == NCH_P - 1) ? 16 : 64; }
        else { row0 = MP + 64 * (q - NQ_P); t0 = 0; nvalid = 64; }
        int ln = lane; asm volatile("" : "+v"(ln));
#pragma unroll
        for (int i = 0; i < 9; ++i) {
            const int p = ln + 64 * i;
            if (p < 536) {
                const int rr = p >> 3, pc = p & 7, row = rr - 3;
                const bool okr = prompt ? (t0 + row >= 0) : (row >= 0);
                u32x4 v = *(const u32x4*)(BX + (size_t)(row0 + (okr ? row : 0)) * 512 + 64 * h + 8 * pc);
                if (!okr) v = (u32x4){0u, 0u, 0u, 0u};
                *(LAS u32x4*)(tile + rr * 72 + 8 * pc) = v;
            }
        }
        float wb[4][4], bb[4];
        { int fr_l = fr; asm volatile("" : "+v"(fr_l));
#pragma unroll
        for (int nt = 0; nt < 4; ++nt) {
            const int c = 64 * h + 16 * nt + fr_l;
#pragma unroll
            for (int k = 0; k < 4; ++k) wb[k][nt] = F.in[I_CBW][((size_t)l * 4 + k) * DB + c];
            bb[nt] = F.in[I_CBB][l * DB + c];
        } }
        float cbv[4][4][4];
#pragma unroll
        for (int mt = 0; mt < 4; ++mt)
#pragma unroll
            for (int nt = 0; nt < 4; ++nt) {
                const int tb = 16 * mt + 4 * fq; float x[7];
#pragma unroll
                for (int i = 0; i < 7; ++i) x[i] = bf2f(tile[(tb + i) * 72 + 16 * nt + fr]);
                if (!prompt && !(fq & 1)) {
                    const int s = 8 * (q - NQ_P) + 2 * mt + (fq >> 1);
                    const float* st = F.in[I_SCB] + ((size_t)l * NB_S + s) * 3 * DB + 64 * h + 16 * nt + fr;
                    x[0] = st[0]; x[1] = st[DB]; x[2] = st[2 * DB];
                }
#pragma unroll
                for (int e = 0; e < 4; ++e) cbv[mt][nt][e] = bb[nt] + wb[0][nt] * x[e] + wb[1][nt] * x[e + 1] + wb[2][nt] * x[e + 2] + wb[3][nt] * x[e + 3];
            }
        asm volatile("s_waitcnt lgkmcnt(0)" ::: "memory");
#pragma unroll
        for (int mt = 0; mt < 4; ++mt)
#pragma unroll
            for (int nt = 0; nt < 4; ++nt)
#pragma unroll
                for (int e = 0; e < 4; ++e) tile[(16 * mt + 4 * fq + e) * 72 + 16 * nt + fr] = (bf16_t)f2bf(cbv[mt][nt][e]);
        asm volatile("s_waitcnt lgkmcnt(0)" ::: "memory");
        float Pc[4] = {1.f, 1.f, 1.f, 1.f}, Hc[4] = {0.f, 0.f, 0.f, 0.f};
#pragma unroll
        for (int mt = 0; mt < 4; ++mt) {
            const bf16x8_t a0 = *(const LAS bf16x8_t*)(tile + (16 * mt + fr) * 72 + 8 * fq), a1 = *(const LAS bf16x8_t*)(tile + (16 * mt + fr) * 72 + 32 + 8 * fq);
#pragma unroll
            for (int nt = 0; nt < 4; ++nt) {
                const int c = 64 * h + 16 * nt + fr;
                const bf16x8_t br0 = *(const LAS bf16x8_t*)(WT + (16 * nt + fr) * 72 + 8 * fq), br1 = *(const LAS bf16x8_t*)(WT + (16 * nt + fr) * 72 + 32 + 8 * fq);
                const bf16x8_t bi0 = *(const LAS bf16x8_t*)(WT + (64 + 16 * nt + fr) * 72 + 8 * fq), bi1 = *(const LAS bf16x8_t*)(WT + (64 + 16 * nt + fr) * 72 + 32 + 8 * fq);
                f32x4 accR = {0.f, 0.f, 0.f, 0.f}, accI = {0.f, 0.f, 0.f, 0.f};
                accR = __builtin_amdgcn_mfma_f32_16x16x32_bf16(a0, br0, accR, 0, 0, 0); accR = __builtin_amdgcn_mfma_f32_16x16x32_bf16(a1, br1, accR, 0, 0, 0);
                accI = __builtin_amdgcn_mfma_f32_16x16x32_bf16(a0, bi0, accI, 0, 0, 0); accI = __builtin_amdgcn_mfma_f32_16x16x32_bf16(a1, bi1, accI, 0, 0, 0);
                float P4[4], H4[4]; float hp = 0.f, pp = 1.f;
#pragma unroll
                for (int e = 0; e < 4; ++e) {
                    const float r = sigmoid_f(accR[e] + bra[nt]), ig = sigmoid_f(accI[e] + bix[nt]);
                    const float la = -8.0f * r * sp[nt], a = __expf(la), bt = __builtin_amdgcn_sqrtf(neg_expm1_f(2.0f * la)) * (ig * bf2f(tile[(16 * mt + 4 * fq + e) * 72 + 16 * nt + fr]));
                    hp = a * hp + bt; pp = pp * a; H4[e] = hp; P4[e] = pp;
                }
                float pex = 1.f, hex = 0.f;
#pragma unroll
                for (int d = 3; d >= 1; --d) {
                    const float ps = __shfl(pp, lane - 16 * d), hs = __shfl(hp, lane - 16 * d);
                    const bool use = prompt ? (fq >= d) : (d == 1 && (fq & 1));
                    if (use) { hex = ps * hex + hs; pex = pex * ps; }
                }
                const float pin = prompt ? Pc[nt] * pex : pex, hin = prompt ? pex * Hc[nt] + hex : hex;
                float Pf[4], Hf[4];
#pragma unroll
                for (int e = 0; e < 4; ++e) { Hf[e] = H4[e] + P4[e] * hin; Pf[e] = P4[e] * pin; }
                Pc[nt] = __shfl(Pf[3], fr + 48); Hc[nt] = __shfl(Hf[3], fr + 48);
#pragma unroll
                for (int e = 0; e < 4; ++e) {
                    const int tl = 16 * mt + 4 * fq + e;
                    if (tl < nvalid) { const size_t row = (size_t)(row0 + tl); YAB[row * D + 512 + c] = (bf16_t)f2bf(Hf[e]); PCG[row * 512 + c] = (bf16_t)f2bf(Pf[e]); }
                }
                if (prompt) { if (16 * (mt + 1) == nvalid && fq == 3) ((f32x2*)(F.ws + WS_SUMM))[(size_t)q * 512 + c] = (f32x2){Pf[3], Hf[3]}; }
                else if (fq & 1) { const int s = 8 * (q - NQ_P) + 2 * mt + (fq >> 1); ((f32x2*)(F.ws + WS_LAST))[(size_t)s * 512 + c] = (f32x2){Pf[3], Hf[3]}; }
            }
        }
    }
}

constexpr int LDS_ARED = 98304;
__device__ __forceinline__ float reduce_scatter16(float (&v)[16], int lane) {
#define RS_STEP(H, M) { const bool up = (lane & (M)) != 0; _Pragma("unroll") for (int i = 0; i < (H); ++i) { const float snd = up ? v[i] : v[i + (H)], kp = up ? v[i + (H)] : v[i]; v[i] = kp + __shfl_xor(snd, (M)); } }
    RS_STEP(8, 32) RS_STEP(4, 16) RS_STEP(2, 8) RS_STEP(1, 4)
#undef RS_STEP
    float r = v[0]; r += __shfl_xor(r, 2); r += __shfl_xor(r, 1); return r;
}
__device__ __forceinline__ void mix_a_wave_jobs(Frame& F, int l) {
    const int lane = F.lane, wave = F.wave, gi = wave & 3, c0 = 128 * gi + 2 * lane;
    const bf16_t* U = (const bf16_t*)(F.ws + WS_U); bf16_t* YAB = (bf16_t*)(F.ws + WS_YAB);
    const float* cw = F.in[I_CAW] + (size_t)l * 31 * DA;
    f32x2 w[31];
#pragma unroll
    for (int k = 0; k < 31; ++k) w[k] = *(const f32x2*)(cw + k * DA + c0);
    const f32x2 cbv = *(const f32x2*)(F.in[I_CAB] + l * DA + c0), lgv = *(const f32x2*)(F.in[I_LNG] + l * DA + c0), lbv = *(const f32x2*)(F.in[I_LNB] + l * DA + c0);
    LAS f32x2* red = (LAS f32x2*)(F.lds + LDS_ARED + wave * 128);
    for (int tb = 511 - ((int)blockIdx.x * 2 + (wave >> 2)); tb < 1096; tb += 512) {
        f32x2 a[16];
#pragma unroll
        for (int t = 0; t < 16; ++t) a[t] = cbv;
        int rowbase;
        if (tb < 1032) {
            const int b = tb / 129, kb = tb - b * 129, t0 = 16 * kb, seqrow0 = b * TP; rowbase = seqrow0 + t0;
            unsigned raw[46];
#pragma unroll
            for (int tt = 0; tt < 46; ++tt) { const int ti = t0 - 30 + tt; raw[tt] = *(const unsigned*)(U + (size_t)(seqrow0 + (ti < 0 ? 0 : ti)) * 512 + c0); }
#pragma unroll
            for (int tt = 0; tt < 46; ++tt) {
                const unsigned rw = ((t0 - 30 + tt) >= 0) ? raw[tt] : 0u;
                const f32x2 v = {__uint_as_float(rw << 16), __uint_as_float(rw & 0xffff0000u)};
#pragma unroll
                for (int t = 0; t < 16; ++t) { const int kk = tt - t; if (kk >= 0 && kk <= 30) a[t] += w[kk] * v; }
            }
        } else {
            const int s0 = 2 * (tb - 1032); rowbase = MP + 8 * s0;
            const float* st = F.in[I_SCA] + (size_t)l * NB_S * 30 * DA;
#pragma unroll
            for (int hs = 0; hs < 2; ++hs) {
                const int s = s0 + hs, rowS = MP + 8 * s;
#pragma unroll
                for (int tt = 0; tt < 38; ++tt) {
                    f32x2 v;
                    if (tt < 30) v = *(const f32x2*)(st + ((size_t)s * 30 + tt) * DA + c0);
                    else { const unsigned rw = *(const unsigned*)(U + (size_t)(rowS + tt - 30) * 512 + c0); v = (f32x2){__uint_as_float(rw << 16), __uint_as_float(rw & 0xffff0000u)}; }
#pragma unroll
                    for (int t = 0; t < 8; ++t) { const int kk = tt - t; if (kk >= 0 && kk <= 30) a[8 * hs + t] += w[kk] * v; }
                }
            }
        }
        float s1[16], s2[16];
#pragma unroll
        for (int t = 0; t < 16; ++t) { s1[t] = a[t].x + a[t].y; s2[t] = a[t].x * a[t].x + a[t].y * a[t].y; }
        const float r1 = reduce_scatter16(s1, lane), r2 = reduce_scatter16(s2, lane);
        if ((lane & 3) == 0) red[lane >> 2] = (f32x2){r1, r2};
        asm volatile("s_waitcnt lgkmcnt(0)" ::: "memory");
#pragma unroll
        for (int t = 0; t < 16; ++t) {
            const f32x2 st_ = red[t];
            const float mean = st_.x * (1.0f / 128.0f), var = st_.y * (1.0f / 128.0f) - mean * mean;
            const float rstd = __builtin_amdgcn_rsqf(fmaxf(var, 0.f) + EPS);
            const f32x2 y = (a[t] - mean) * rstd * lgv + lbv;
            *(unsigned*)(YAB + (size_t)(rowbase + t) * D + c0) = pk2(silu_f(y.x), silu_f(y.y));
        }
        asm volatile("s_waitcnt lgkmcnt(0)" ::: "memory");
    }
}

__device__ __forceinline__ void mix_job_state(Frame& F, int l, int s) {
    const int c = F.tid;
    const bf16_t* U = (const bf16_t*)(F.ws + WS_U); const bf16_t* BX = (const bf16_t*)(F.ws + WS_BX);
    if (s < NB_P) {
        const int b = s; float* oa = F.out + O_CAP + ((size_t)l * NB_P + b) * 30 * DA; float* ob = F.out + O_CBP + ((size_t)l * NB_P + b) * 3 * DB;
#pragma unroll 10
        for (int i = 0; i < 30; ++i) oa[i * DA + c] = bf2f(U[(size_t)(b * TP + TP - 30 + i) * 512 + c]);
#pragma unroll
        for (int i = 0; i < 3; ++i) ob[i * DB + c] = bf2f(BX[(size_t)(b * TP + TP - 3 + i) * 512 + c]);
    } else {
        const int b = s - NB_P, rowS = MP + 8 * b; float* oa = F.out + O_CAS + ((size_t)l * NB_S + b) * 30 * DA; float* ob = F.out + O_CBS + ((size_t)l * NB_S + b) * 3 * DB;
        const float* st = F.in[I_SCA] + ((size_t)l * NB_S + b) * 30 * DA;
#pragma unroll 11
        for (int i = 0; i < 22; ++i) oa[i * DA + c] = st[(8 + i) * DA + c];
#pragma unroll
        for (int i = 22; i < 30; ++i) oa[i * DA + c] = bf2f(U[(size_t)(rowS + i - 22) * 512 + c]);
#pragma unroll
        for (int i = 0; i < 3; ++i) ob[i * DB + c] = bf2f(BX[(size_t)(rowS + 5 + i) * 512 + c]);
    }
}

__device__ __forceinline__ void mix_a_phase(Frame& F, int l, int sel) {
    if (sel & 1) mix_b_wave_jobs(F, l);
    if (!(sel & 2)) return;
    { int t_ = F.tid; asm volatile("" : "+v"(t_)); F.tid = t_; F.lane = t_ & 63; }
    mix_a_wave_jobs(F, l);
    { int t_ = F.tid; asm volatile("" : "+v"(t_)); F.tid = t_; F.lane = t_ & 63; }
    const int b = blockIdx.x;
    if (b >= 64 && b - 64 < NB_P + NB_S) mix_job_state(F, l, b - 64);
}

__device__ __forceinline__ void mix_c_phase(Frame& F, int l, int rep) {
    const int c = F.tid;
    bf16_t* YAB = (bf16_t*)(F.ws + WS_YAB); const bf16_t* PCG = (const bf16_t*)(F.ws + WS_XB); const bf16_t* GGp = (const bf16_t*)(F.ws + WS_GG);
    const f32x2* SUMM = (const f32x2*)(F.ws + WS_SUMM); const f32x2* LAST = (const f32x2*)(F.ws + WS_LAST);
    for (int job = blockIdx.x; job < NQ * 2; job += F.G) {
        const int q = job >> 1, hh = job & 1;
        if (q < NQ_P) {
            const int b = q / NCH_P, k = q - b * NCH_P, nvalid = (k == NCH_P - 1) ? 16 : 64, row0 = b * TP + 64 * k;
            if (32 * hh >= nvalid) continue;
            float carry = 0.f;
            {
                f32x2 ph[32];
#pragma unroll
                for (int e = 0; e < 32; ++e) { const int kk = e < k ? e : 0; ph[e] = SUMM[(size_t)(b * NCH_P + kk) * 512 + c]; }
#pragma unroll
                for (int e = 0; e < 32; ++e) { const float px = e < k ? ph[e].x : 1.f, py = e < k ? ph[e].y : 0.f; carry = px * carry + py; }
            }
            const int r1 = (32 * hh + 32 < nvalid) ? 32 * hh + 32 : nvalid;
            for (int r = 32 * hh; r < r1; ++r) {
                const size_t row = row0 + r;
                const float y = (bf2f(YAB[row * D + 512 + c]) + bf2f(PCG[row * 512 + c]) * carry) * bf2f(GGp[row * 512 + c]);
                if (rep) ((bf16_t*)(F.ws + WS_U))[row * 512 + c] = (bf16_t)f2bf(y); else
                YAB[row * D + 512 + c] = (bf16_t)f2bf(y);
            }
            if (k == NCH_P - 1 && hh == 0) { const f32x2 ph = SUMM[(size_t)q * 512 + c]; F.out[O_HP + ((size_t)l * NB_P + b) * DB + c] = ph.y + ph.x * carry; }
        } else {
            const int row0 = MP + 64 * (q - NQ_P);
            for (int r = 32 * hh; r < 32 * hh + 32; ++r) {
                const int s = 8 * (q - NQ_P) + (r >> 3); const size_t row = row0 + r;
                const float carry = F.in[I_SH][((size_t)l * NB_S + s) * DB + c];
                const float y = (bf2f(YAB[row * D + 512 + c]) + bf2f(PCG[row * 512 + c]) * carry) * bf2f(GGp[row * 512 + c]);
                if (rep) ((bf16_t*)(F.ws + WS_U))[row * 512 + c] = (bf16_t)f2bf(y); else
                YAB[row * D + 512 + c] = (bf16_t)f2bf(y);
                if ((r & 7) == 7) { const f32x2 ph = LAST[(size_t)s * 512 + c]; F.out[O_HS + ((size_t)l * NB_S + s) * DB + c] = ph.y + ph.x * carry; }
            }
        }
    }
}

constexpr int NPH = 18;
#ifndef PHMASK
#define PHMASK 127
#endif
#define DUPMASK 0
#define MIXSEL 1
__global__ void __launch_bounds__(NWAVES * 64, 2) mega_fwd(Args args) {
    extern __shared__ __attribute__((aligned(16))) unsigned char lds[];
    Frame F;
    F.lds = (LAS unsigned char*)lds; F.G = gridDim.x;
    if (threadIdx.x < 2) ((volatile LAS unsigned*)(F.lds + LDS_BARST))[threadIdx.x] = 0u;
    __syncthreads();
    if (args.ph_hi - args.ph_lo > 1) (void)xcd_barrier_post((unsigned*)(args.ws + WS_BAR), (volatile LAS unsigned*)(F.lds + LDS_BARST));
    const int ph_lo = args.ph_lo, ph_hi = args.ph_hi;
    const int wave_s = __builtin_amdgcn_readfirstlane(threadIdx.x >> 6);
    for (int st = 2 * ph_lo; st < 2 * ph_hi; ++st) {
        const int ph = st >> 1, rep = st & 1;
        bool run = true;
        if (rep == 1) { const int ty = (ph == 0) ? 1 : (ph == NPH - 1) ? 2 : (int)((0x0804084020100804ull >> (8 * ((ph - 1) & 7))) & 255ull);
            run = (DUPMASK & ty) != 0; }
        if (run) {
        const __attribute__((address_space(4))) unsigned char* kp = (const __attribute__((address_space(4))) unsigned char*)__builtin_amdgcn_kernarg_segment_ptr();
        asm volatile("" : "+s"(kp));
        const __attribute__((address_space(4))) Args* ap = (const __attribute__((address_space(4))) Args*)kp;
        F.in = ap->in; F.out = ap->out; F.ws = ap->ws;
        { int t_ = wave_s * 64 + hw_lane_id(); asm volatile("" : "+v"(t_)); F.tid = t_; F.lane = t_ & 63; F.wave = wave_s; }
        unsigned char* ws = F.ws;
        float* SS = (float*)(ws + WS_SS);
        if ((PHMASK & 1) && ph == 0) p0_prologue(F);
        else if ((PHMASK & 2) && ph == NPH - 1) final_phase(F);
        else {
            const int l = (ph - 1) >> 3, s = (ph - 1) & 7;
            if ((PHMASK & 4) && (s == 0 || s == 6)) {
                pg8::Gemm g{(const bf16_t*)(ws + WS_XB), (const bf16_t*)(ws + (s == 0 ? WS_WGU1 : WS_WGU2)), MPAD, 2 * FF, D};
                pg8::StaticOrder S; S.init(MPAD, 2 * FF, D, F.G, (int)blockIdx.x);
                EpiGU E{(bf16_t*)(ws + WS_ACT), SS + (size_t)(s == 0 ? 3 * l : 3 * l + 2) * MPAD};
                pg8::gemm_phase<EpiGU, pg8::StaticOrder, true, true>(F.lds, g, S, E, wave_s);
            } else if ((PHMASK & 8) && (s == 1 || s == 7 || s == 5)) {
                const bool down = (s != 5);
                pg8::Gemm g{(const bf16_t*)(ws + (down ? WS_ACT : WS_YAB)), (const bf16_t*)(ws + (s == 1 ? WS_WD1 : (s == 7 ? WS_WD2 : WS_WOUT))), MPAD, D, down ? FF : D};
                pg8::DpSplit S; S.init(MPAD, D, down ? FF : D, F.G, (int)blockIdx.x, F.out);
                EpiRes E{(float*)(ws + WS_X), (bf16_t*)(ws + WS_XB), (rep ? (float*)(ws + 0x300000) : SS + (size_t)(s == 1 ? 3 * l + 1 : (s == 5 ? 3 * l + 2 : 3 * l + 3)) * MPAD), rep ? 0.0f : (down ? 0.5f : 1.0f)};
                pg8::gemm_phase<EpiRes, pg8::DpSplit, true, true>(F.lds, g, S, E, wave_s);
                if (blockIdx.x >= 80 && rep == 0) {
                    const int gw = ((int)blockIdx.x - 80) * NWAVES + F.wave, NGW = (F.G - 80) * NWAVES;
                    if (l == 0 && s == 1) convert_mats(F, 1, 0, 1, gw, NGW);
                    else if (l == 0 && s == 7) convert_mats(F, 1, 1, 3, gw, NGW);
                    else if (l == 1 && s == 1) convert_mats(F, 1, 3, 5, gw, NGW);
                    else if (l == 1 && s == 5) convert_mats(F, 1, 5, 6, gw, NGW);
                }
                { XcdBarrier xb; xb.bar = (unsigned*)(ws + WS_BAR); xb.x = xb_xcc_id(); xb.st = (volatile LAS unsigned*)(F.lds + LDS_BARST); xcd_barrier(xb, wave_s == 0 && hw_lane_id() == 0); }
                res_fixup(F, E, S);
            } else if ((PHMASK & 16) && s == 2) {
                pg8::Gemm g{(const bf16_t*)(ws + WS_XB), (const bf16_t*)(ws + WS_WIN), MPAD, 2048, D};
                pg8::StaticOrder S; S.init(MPAD, 2048, D, F.G, (int)blockIdx.x);
                EpiWin E{(bf16_t*)(ws + WS_U), (bf16_t*)(ws + WS_BX), (bf16_t*)(ws + WS_GG), SS + (size_t)(3 * l + 1) * MPAD};
                pg8::gemm_phase<EpiWin, pg8::StaticOrder, true, true>(F.lds, g, S, E, wave_s);
            } else if ((PHMASK & 32) && s == 3) mix_a_phase(F, l, rep ? MIXSEL : 3);
            else if ((PHMASK & 64) && s == 4) mix_c_phase(F, l, rep);
        }
        }
        if (rep == 1 && ph + 1 < ph_hi) {
            const __attribute__((address_space(4))) Args* ap2 = (const __attribute__((address_space(4))) Args*)__builtin_amdgcn_kernarg_segment_ptr();
            unsigned* barw = (unsigned*)(ap2->ws + WS_BAR);
            if (ph_hi > 1000) cg::this_grid().sync();
            XcdBarrier xb; xb.bar = barw; xb.x = xb_xcc_id(); xb.st = (volatile LAS unsigned*)(F.lds + LDS_BARST);
            xcd_barrier(xb, wave_s == 0 && hw_lane_id() == 0);
        }
    }
}

#ifndef MK_FUSED
#define MK_FUSED 1
#endif
extern "C" void kernel_launch(void* const* d_in, const int* in_sizes, int n_in, void* d_out, int out_size, void* d_ws, size_t ws_size, hipStream_t stream) {
    static int grid = 0;
    if (grid == 0) {
        if (n_in != N_IN || (size_t)out_size != O_END || ws_size < WS_END) { fprintf(stderr, "kernel_launch: unexpected shapes: n_in %d out %d ws %zu (need %zu)\n", n_in, out_size, ws_size, (size_t)WS_END); grid = -1; return; }
        int dev = 0, cus = 0, per_cu = 0;
        hipGetDevice(&dev); hipDeviceGetAttribute(&cus, hipDeviceAttributeMultiprocessorCount, dev);
        if (hipFuncSetAttribute((const void*)mega_fwd, hipFuncAttributeMaxDynamicSharedMemorySize, LDS_BYTES) != hipSuccess) { fprintf(stderr, "kernel_launch: hipFuncSetAttribute failed\n"); grid = -1; return; }
        if (hipOccupancyMaxActiveBlocksPerMultiprocessor(&per_cu, (const void*)mega_fwd, NWAVES * 64, LDS_BYTES) != hipSuccess || per_cu < 1) { fprintf(stderr, "kernel_launch: occupancy query failed (%d)\n", per_cu); (void)hipGetLastError(); per_cu = 1; }
        grid = cus * 1;
        fprintf(stderr, "kernel_launch: cus %d per_cu %d grid %d ws %zu\n", cus, per_cu, grid, ws_size);
    }
    if (grid < 0) return;
    Args a{};
    for (int i = 0; i < N_IN; ++i) a.in[i] = (const float*)d_in[i];
    a.out = (float*)d_out; a.ws = (unsigned char*)d_ws;
#if MK_FUSED
    a.ph_lo = 0; a.ph_hi = NPH;
    if (hipMemsetAsync((unsigned char*)d_ws + WS_BAR, 0, 0x10000, stream) != hipSuccess) { fprintf(stderr, "kernel_launch: memset of the barrier words failed\n"); return; }
    void* kargs[] = {&a};
    hipError_t e = hipLaunchCooperativeKernel((const void*)mega_fwd, dim3(grid), dim3(NWAVES * 64), kargs, LDS_BYTES, stream);
    if (e != hipSuccess) fprintf(stderr, "cooperative launch failed: %s (grid %d)\n", hipGetErrorString(e), grid);
#else
    for (int ph = 0; ph < NPH; ++ph) { a.ph_lo = ph; a.ph_hi = ph + 1; hipLaunchKernelGGL(mega_fwd, dim3(grid), dim3(NWAVES * 64), LDS_BYTES, stream, a); }
#endif
}
```

```cpp
#include <hip/hip_runtime.h>
#include <hip/hip_cooperative_groups.h>
#include <cstdio>
#include <cstdint>
namespace cg = cooperative_groups;
__device__ __forceinline__ int hw_lane_id() { int l; asm volatile("v_mbcnt_lo_u32_b32 %0, -1, 0\n\tv_mbcnt_hi_u32_b32 %0, -1, %0" : "=v"(l)); return l; }
namespace pg8 {
#define PG8_LAS __attribute__((address_space(3)))
typedef unsigned short bf16_t;
typedef short bf16x8 __attribute__((ext_vector_type(8)));
typedef float f32x4 __attribute__((ext_vector_type(4)));
typedef unsigned u32x4 __attribute__((ext_vector_type(4)));
constexpr int BM = 256, BK = 64, HALF = 128, HTB = HALF * BK * 2  , STAGE_BYTES = 8 * HTB, NXCD = 8, WGM = 8;

__host__ __device__ __forceinline__ int lds_byte(int r, int c) { const int st = (r >> 4) * 2 + (c >> 5), rr = r & 15, cc = c & 31, ob = rr * 64 + cc * 2; return st * 1024 + (ob ^ (((ob >> 9) & 1) << 5)); }
__host__ __device__ __forceinline__ void stage_rc(int b, int& R, int& C) { const int st = b / 1024, sb = b % 1024, swz = sb ^ (((sb >> 9) & 1) << 5); R = (st >> 1) * 16 + swz / 64; C = (st & 1) * 32 + (swz % 64) / 2; }
__host__ __device__ __forceinline__ int perm32(int rho) { const int n = rho >> 4, i = rho & 15; return 8 * (i >> 2) + 4 * n + (i & 3); }

struct Unit { int pm, pn, k0, len, kind; };
struct Gemm { const bf16_t* A; const bf16_t* Bt; int M, N, K; };

struct StaticOrder {
    static constexpr bool STREAMK = false;
    int nM, nN, nwg, G, c, nt;
    __host__ __device__ void init(int M, int N, int K, int G_, int c_) { nM = M / BM; nN = N / BM; nwg = nM * nN; G = G_; c = c_; nt = K / BK; }
    __host__ __device__ bool next(int i, Unit& u) const {
        const long L = (long)i * G + c; if (L >= nwg) return false;
        int wgid = (int)L; { const int q = nwg / NXCD, r = nwg % NXCD, xcd = wgid % NXCD, off = wgid / NXCD; wgid = (xcd < r ? xcd * (q + 1) : r * (q + 1) + (xcd - r) * q) + off; }
        const int nig = WGM * nN, gid = wgid / nig, fm = gid * WGM, gsz = (nM - fm) < WGM ? (nM - fm) : WGM;
        u.pm = fm + ((wgid % nig) % gsz); u.pn = (wgid % nig) / gsz; u.k0 = 0; u.len = nt; u.kind = 0; return true;
    }
    __device__ __forceinline__ void a_ready(const Unit&) const {}
    __device__ __forceinline__ void done(const Unit&) const {}
    __device__ __forceinline__ void store_partial(const f32x4 (&)[2][2][4][2], int, int, int) const {}
    __device__ __forceinline__ void load_partial(f32x4 (&)[2][2][4][2], int, int, int) const {}
};
struct DpSplit {
    static constexpr bool STREAMK = true;
    int nM, nN, nwg, G, c, nt; float* slab;
    __device__ __forceinline__ void init(int M, int N, int K, int G_, int c_, float* slab_) { nM = M / BM; nN = N / BM; nwg = nM * nN; G = G_; c = c_; nt = K / BK; slab = slab_; }
    __device__ __forceinline__ void unit_of(int L, Unit& u) const {
        int wgid = L; { const int q = nwg / NXCD, r = nwg % NXCD, xcd = wgid % NXCD, off = wgid / NXCD; wgid = (xcd < r ? xcd * (q + 1) : r * (q + 1) + (xcd - r) * q) + off; }
        const int nig = WGM * nN, gid = wgid / nig, fm = gid * WGM, gsz = (nM - fm) < WGM ? (nM - fm) : WGM;
        u.pm = fm + ((wgid % nig) % gsz); u.pn = (wgid % nig) / gsz;
    }
    __device__ __forceinline__ bool next(int i, Unit& u) const {
        if (i == 0) { if (c >= nwg) return false; unit_of(c, u); u.k0 = 0; u.len = nt; u.kind = 0; return true; }
        if (i == 1 && c < 4 * (nwg - G)) {
            unit_of(G + (c >> 2), u);
            const int part = c & 3, lenp = (nt >> 2) & ~1, rem2 = (nt - 4 * lenp) >> 1;
            u.len = lenp + (part < rem2 ? 2 : 0); u.k0 = part * lenp + 2 * (part < rem2 ? part : rem2); u.kind = 1; return true;
        }
        return false;
    }
    __device__ __forceinline__ void a_ready(const Unit&) const {}
    __device__ __forceinline__ void done(const Unit&) const {}
    __device__ __forceinline__ void store_partial(const f32x4 (&acc)[2][2][4][2], int tid, int wid, int lane) const {
        typedef unsigned u32x4v __attribute__((ext_vector_type(4)));
        asm volatile("" : "+v"(tid));
        const __amdgpu_buffer_rsrc_t r = __builtin_amdgcn_make_buffer_rsrc((void*)(slab + (size_t)c * 65536), 0, 262144, 0x00020000);
        const int vo = tid * 16;
#pragma unroll
        for (int ai = 0; ai < 2; ++ai)
#pragma unroll
            for (int bj = 0; bj < 2; ++bj)
#pragma unroll
                for (int m = 0; m < 4; ++m)
#pragma unroll
                    for (int n = 0; n < 2; ++n) __builtin_amdgcn_raw_buffer_store_b128(__builtin_bit_cast(u32x4v, acc[ai][bj][m][n]), r, vo, (((ai * 2 + bj) * 4 + m) * 2 + n) * 8192, 16);
    }
    __device__ __forceinline__ void load_partial(f32x4 (&)[2][2][4][2], int, int, int) const {}
};

template <class Epi, class Sched, bool ALIGN_EPI = false, bool SP2 = false>
__device__ __forceinline__ void gemm_phase(PG8_LAS unsigned char* lds, const Gemm g, const Sched& S, const Epi& E, const int wave_s) {
    int tid_l = wave_s * 64 + hw_lane_id(); asm volatile("" : "+v"(tid_l));
    const int tid = tid_l, wid = __builtin_amdgcn_readfirstlane(tid >> 6), lane = tid & 63, wr = wid >> 2, wc = wid & 3, fr = lane & 15, fq = lane >> 4;
    const int K = g.K, nt = K / BK;
    unsigned voffA[2], voffB[2];
#pragma unroll
    for (int i = 0; i < 2; ++i) { int R, C; stage_rc(tid * 16 + i * 8192, R, C); const int Rb = Epi::PERM ? ((R & ~31) + perm32(R & 31)) : R;
        voffA[i] = (unsigned)(R * K + C) * 2u; voffB[i] = (unsigned)(Rb * K + C) * 2u; }
    const size_t kstep = (size_t)(BK * 2);
    const size_t hstep = (size_t)HALF * K * 2;
    const size_t tstep = 2 * hstep;
    const unsigned ldsw = (unsigned)wid * 1024u;
    const int aoff = lds_byte(wr * 64 + fr, fq * 8), boff = lds_byte(wc * 32 + fr, fq * 8);
#define PG8_SA(b, h) (((b) * 2 + (h)) * HTB)
#define PG8_SB(b, h) ((4 + (b) * 2 + (h)) * HTB)
#define PG8_STAGE(bufoff, gbase, voff) do { _Pragma("unroll") for (int _i = 0; _i < 2; ++_i) \
        __builtin_amdgcn_global_load_lds((const unsigned*)((const char*)(gbase) + (voff)[_i]), (PG8_LAS unsigned*)(lds + (bufoff) + ldsw + _i * 8192), 16, 0, 0); } while (0)
#define PG8_LDA(dst, b, h) do { _Pragma("unroll") for (int m = 0; m < 4; ++m) _Pragma("unroll") for (int k = 0; k < 2; ++k) dst[m][k] = *(const PG8_LAS bf16x8*)(lds + PG8_SA(b, h) + aoff + m * 2048 + k * 1024); } while (0)
#define PG8_LDB(dst, b, h) do { _Pragma("unroll") for (int n = 0; n < 2; ++n) _Pragma("unroll") for (int k = 0; k < 2; ++k) dst[n][k] = *(const PG8_LAS bf16x8*)(lds + PG8_SB(b, h) + boff + n * 2048 + k * 1024); } while (0)
#define PG8_MMA(ai, bj, At, Bt) do { __builtin_amdgcn_s_setprio(1); _Pragma("unroll") for (int m = 0; m < 4; ++m) _Pragma("unroll") for (int n = 0; n < 2; ++n) _Pragma("unroll") for (int k = 0; k < 2; ++k) \
        acc[ai][bj][m][n] = __builtin_amdgcn_mfma_f32_16x16x32_bf16(Bt[n][k], At[m][k], acc[ai][bj][m][n], 0, 0, 0); __builtin_amdgcn_s_setprio(0); } while (0)
#define PG8_WAIT_V(n) asm volatile("s_waitcnt vmcnt(" #n ")" ::: "memory")
#define PG8_WAIT_L(n) asm volatile("s_waitcnt lgkmcnt(" #n ")" ::: "memory")
#define PG8_BAR __builtin_amdgcn_s_barrier()
#define PG8_SCHED __builtin_amdgcn_sched_barrier(0)
    Unit cur, nxt; int ui = 0;
    if (!S.next(0, cur)) return;
    f32x4 acc[2][2][4][2];
#pragma unroll
    for (int a = 0; a < 2; ++a)
#pragma unroll
        for (int b = 0; b < 2; ++b)
#pragma unroll
            for (int m = 0; m < 4; ++m)
#pragma unroll
                for (int n = 0; n < 2; ++n) acc[a][b][m][n] = (f32x4){0.f, 0.f, 0.f, 0.f};
    if (Sched::STREAMK && cur.kind == 2) S.load_partial(acc, tid, wid, lane);
    if constexpr (Epi::INIT_ACC) { if (cur.kind == 0) E.init(acc, cur, wr, wc, fr, fq); }
    bf16x8 At[4][2], B0[2][2], B1[2][2];
    const char* cA = (const char*)g.A + (size_t)cur.pm * tstep + (size_t)cur.k0 * kstep; const char* cB = (const char*)g.Bt + (size_t)cur.pn * tstep + (size_t)cur.k0 * kstep;
    S.a_ready(cur);
    if constexpr (SP2) {
        PG8_STAGE(PG8_SB(0, 0), cB, voffB); PG8_STAGE(PG8_SB(0, 1), cB + hstep, voffB); PG8_STAGE(PG8_SA(0, 0), cA, voffA); PG8_STAGE(PG8_SA(0, 1), cA + hstep, voffA);
        if (wr == 1) PG8_BAR;
        PG8_WAIT_V(2); PG8_BAR;
        PG8_STAGE(PG8_SB(1, 0), cB + kstep, voffB); PG8_STAGE(PG8_SA(1, 0), cA + kstep, voffA); PG8_STAGE(PG8_SB(1, 1), cB + hstep + kstep, voffB);
        PG8_WAIT_V(6); PG8_BAR;
    } else {
        PG8_STAGE(PG8_SB(0, 0), cB, voffB); PG8_STAGE(PG8_SA(0, 0), cA, voffA); PG8_STAGE(PG8_SB(0, 1), cB + hstep, voffB); PG8_STAGE(PG8_SA(0, 1), cA + hstep, voffA);
        if (wr == 1) PG8_BAR;
        PG8_WAIT_V(4); PG8_BAR;
        PG8_STAGE(PG8_SB(1, 0), cB + kstep, voffB); PG8_STAGE(PG8_SA(1, 0), cA + kstep, voffA); PG8_STAGE(PG8_SB(1, 1), cB + hstep + kstep, voffB);
        PG8_WAIT_V(6); PG8_BAR;
    }
    for (;;) {
        const bool has_next = S.next(ui + 1, nxt);
        const char* nA = has_next ? (const char*)g.A + (size_t)nxt.pm * tstep + (size_t)nxt.k0 * kstep : cA; const char* nB = has_next ? (const char*)g.Bt + (size_t)nxt.pn * tstep + (size_t)nxt.k0 * kstep : cB;
        const int clen = cur.len;
        for (int t = 0; t < clen; t += 2) {
            const bool last = (t == clen - 2);
            const char* a1 = cA + (size_t)(t + 1) * kstep;
            const char* a2 = last ? nA : cA + (size_t)(t + 2) * kstep; const char* b2 = last ? nB : cB + (size_t)(t + 2) * kstep;
            const char* a3 = a2 + kstep; const char* b3 = b2 + kstep;
            if (last && has_next) S.a_ready(nxt);
            if constexpr (SP2) {
            PG8_LDB(B0, 0, 0); PG8_LDB(B1, 0, 1); PG8_SCHED; PG8_LDA(At, 0, 0); PG8_STAGE(PG8_SA(1, 1), a1 + hstep, voffA);
            PG8_WAIT_V(8); PG8_WAIT_L(0); PG8_BAR; PG8_MMA(0, 0, At, B0); PG8_MMA(0, 1, At, B1); PG8_BAR; PG8_SCHED;
            PG8_LDA(At, 0, 1); PG8_STAGE(PG8_SB(0, 0), b2, voffB); PG8_STAGE(PG8_SB(0, 1), b2 + hstep, voffB); PG8_STAGE(PG8_SA(0, 0), a2, voffA);
            PG8_WAIT_V(8); PG8_WAIT_L(0); PG8_BAR; PG8_MMA(1, 0, At, B0); PG8_MMA(1, 1, At, B1); PG8_BAR; PG8_SCHED;
            PG8_LDB(B0, 1, 0); PG8_LDB(B1, 1, 1); PG8_SCHED; PG8_LDA(At, 1, 0); PG8_STAGE(PG8_SA(0, 1), a2 + hstep, voffA);
            PG8_WAIT_V(8); PG8_WAIT_L(0); PG8_BAR; PG8_MMA(0, 0, At, B0); PG8_MMA(0, 1, At, B1); PG8_BAR; PG8_SCHED;
            PG8_LDA(At, 1, 1); PG8_STAGE(PG8_SB(1, 0), b3, voffB); PG8_STAGE(PG8_SB(1, 1), b3 + hstep, voffB); PG8_STAGE(PG8_SA(1, 0), a3, voffA);
            PG8_WAIT_V(8); PG8_WAIT_L(0); PG8_BAR; PG8_MMA(1, 0, At, B0); PG8_MMA(1, 1, At, B1); PG8_BAR; PG8_SCHED;
            } else {
            PG8_LDB(B0, 0, 0); PG8_SCHED; PG8_LDA(At, 0, 0); PG8_STAGE(PG8_SA(1, 1), a1 + hstep, voffA);
            PG8_WAIT_L(8); PG8_BAR; PG8_WAIT_L(0); PG8_MMA(0, 0, At, B0); PG8_BAR; PG8_SCHED;
            PG8_LDB(B1, 0, 1); PG8_STAGE(PG8_SB(0, 0), b2, voffB);
            PG8_BAR; PG8_WAIT_L(0); PG8_MMA(0, 1, At, B1); PG8_BAR;
            PG8_LDA(At, 0, 1); PG8_STAGE(PG8_SA(0, 0), a2, voffA);
            PG8_BAR; PG8_WAIT_L(0); PG8_MMA(1, 0, At, B0); PG8_BAR; PG8_SCHED;
            PG8_STAGE(PG8_SB(0, 1), b2 + hstep, voffB);
            PG8_WAIT_V(6); PG8_BAR; PG8_MMA(1, 1, At, B1); PG8_BAR;
            PG8_LDB(B0, 1, 0); PG8_SCHED; PG8_LDA(At, 1, 0); PG8_STAGE(PG8_SA(0, 1), a2 + hstep, voffA);
            PG8_WAIT_L(8); PG8_BAR; PG8_WAIT_L(0); PG8_MMA(0, 0, At, B0); PG8_BAR; PG8_SCHED;
            PG8_LDB(B1, 1, 1); PG8_STAGE(PG8_SB(1, 0), b3, voffB);
            PG8_BAR; PG8_WAIT_L(0); PG8_MMA(0, 1, At, B1); PG8_BAR;
            PG8_LDA(At, 1, 1); PG8_STAGE(PG8_SA(1, 0), a3, voffA);
            PG8_BAR; PG8_WAIT_L(0); PG8_MMA(1, 0, At, B0); PG8_BAR; PG8_SCHED;
            PG8_STAGE(PG8_SB(1, 1), b3 + hstep, voffB);
            PG8_WAIT_V(6); PG8_BAR; PG8_MMA(1, 1, At, B1); PG8_BAR;
            }
        }
        if constexpr (ALIGN_EPI) { if (wr == 0) PG8_BAR; }
        if constexpr (!Epi::AFTER_DRAIN) {
            int fr_l = fr, fq_l = fq; asm volatile("" : "+v"(fr_l), "+v"(fq_l));
            if constexpr (Sched::STREAMK) {
                if (cur.kind == 1) S.store_partial(acc, tid, wid, lane);
                else E(acc, cur, wr, wc, fr_l, fq_l);
            } else E(acc, cur, wr, wc, fr_l, fq_l);
            S.done(cur); }
        if (!has_next) break;
#define PG8_ZERO_ACC() do { _Pragma("unroll") for (int a = 0; a < 2; ++a) _Pragma("unroll") for (int b = 0; b < 2; ++b) _Pragma("unroll") for (int m = 0; m < 4; ++m) _Pragma("unroll") for (int n = 0; n < 2; ++n) acc[a][b][m][n] = (f32x4){0.f, 0.f, 0.f, 0.f}; } while (0)
        if constexpr (Epi::INIT_ACC) {
            if (Sched::STREAMK && nxt.kind == 2) S.load_partial(acc, tid, wid, lane);
            else if (nxt.kind == 0) { int fr_i = fr, fq_i = fq; asm volatile("" : "+v"(fr_i), "+v"(fq_i)); E.init(acc, nxt, wr, wc, fr_i, fq_i); }
            else PG8_ZERO_ACC();
        } else {
            if (Sched::STREAMK && nxt.kind == 2) S.load_partial(acc, tid, wid, lane);
            else PG8_ZERO_ACC();
        }
#undef PG8_ZERO_ACC
        cur = nxt; cA = nA; cB = nB; ++ui;
        if constexpr (ALIGN_EPI) { if (wr == 1) PG8_BAR; }
    }
    PG8_WAIT_V(0);
    if constexpr (!ALIGN_EPI) { if (wr == 0) PG8_BAR; }
    PG8_BAR;
    if constexpr (Epi::AFTER_DRAIN) { E.fused(acc, cur, wr, wc, fr, fq, lds, wid, lane); S.done(cur); }
#undef PG8_SA
#undef PG8_SB
#undef PG8_STAGE
#undef PG8_LDA
#undef PG8_LDB
#undef PG8_MMA
#undef PG8_WAIT_V
#undef PG8_WAIT_L
#undef PG8_BAR
#undef PG8_SCHED
}
}

#define LAS __attribute__((address_space(3)))
typedef unsigned short bf16_t;
typedef float f32x4 __attribute__((ext_vector_type(4)));
typedef float f32x2 __attribute__((ext_vector_type(2)));
typedef unsigned u32x4 __attribute__((ext_vector_type(4)));
typedef unsigned u32x2 __attribute__((ext_vector_type(2)));

constexpr int D = 1024, FF = 2816, DA = 512, DB = 512;
constexpr int NB_P = 8, TP = 2064, NB_S = 128, TS = 8, NMETA = 16, SEQ = 2048;
constexpr int MP = NB_P * TP;
constexpr int MR = MP + NB_S * TS;
constexpr int MPAD = 17664;
constexpr int NCH_P = 33;
constexpr int NQ_P = NB_P * NCH_P;
constexpr int NQ_S = (NB_S * TS) / 64;
constexpr int NQ = NQ_P + NQ_S;
constexpr float EPS = 1e-6f;
constexpr int NWAVES = 8;

enum { I_XP = 0, I_XS, I_SCA, I_SCB, I_SH, I_META, I_GF1, I_W1G, I_W1U, I_W1D, I_GMIX, I_WIN, I_CAW, I_CAB, I_LNG, I_LNB, I_CBW, I_CBB,
       I_WRG, I_BRG, I_WIG, I_BIG, I_LAM, I_WOUT, I_GF2, I_W2G, I_W2U, I_W2D, I_GFIN, N_IN };
constexpr size_t O_YP = 0, O_YS = O_YP + (size_t)NB_P * SEQ * D, O_CAP = O_YS + (size_t)NB_S * TS * D, O_CBP = O_CAP + (size_t)2 * NB_P * 30 * DA,
                 O_HP = O_CBP + (size_t)2 * NB_P * 3 * DB, O_CAS = O_HP + (size_t)2 * NB_P * DB, O_CBS = O_CAS + (size_t)2 * NB_S * 30 * DA,
                 O_HS = O_CBS + (size_t)2 * NB_S * 3 * DB, O_END = O_HS + (size_t)2 * NB_S * DB;

constexpr size_t WS_SS = 0;
constexpr size_t WS_SUMM = 0x80000;
constexpr size_t WS_LAST = 0x1A0000;
constexpr size_t WS_W = 0x400000;
constexpr size_t SZ_WGU = (size_t)2 * FF * D * 2, SZ_WD = (size_t)D * FF * 2, SZ_WIN = (size_t)2048 * D * 2, SZ_WOUT = (size_t)D * D * 2;
constexpr size_t WS_WGU1 = WS_W, WS_WD1 = WS_WGU1 + SZ_WGU, WS_WIN = WS_WD1 + SZ_WD, WS_WOUT = WS_WIN + SZ_WIN, WS_WGU2 = WS_WOUT + SZ_WOUT, WS_WD2 = WS_WGU2 + SZ_WGU;
constexpr size_t WS_X = WS_WD2 + SZ_WD;
constexpr size_t WS_XB = WS_X + (size_t)MPAD * D * 4;
constexpr size_t WS_ACT = WS_XB + (size_t)MPAD * D * 2;
constexpr size_t WS_U = WS_ACT, WS_BX = WS_U + (size_t)MPAD * 512 * 2, WS_GG = WS_BX + (size_t)MPAD * 512 * 2, WS_YAB = WS_GG + (size_t)MPAD * 512 * 2;
constexpr size_t WS_END = WS_ACT + (size_t)MPAD * FF * 2;
static_assert(WS_YAB + (size_t)MPAD * D * 2 <= WS_END, "mixer overlay fits");
static_assert(WS_END <= 268435456, "ws map fits 256 MiB");
static_assert(WS_SS + 7 * (size_t)MPAD * 4 <= WS_SUMM && WS_SUMM + (size_t)NQ * 512 * 8 <= WS_LAST && WS_LAST + (size_t)128 * 512 * 8 <= WS_W, "small buffers");

constexpr int LDS_BYTES = 147456;

__device__ __forceinline__ float bf2f(bf16_t b) { return __uint_as_float(((unsigned)b) << 16); }
__device__ __forceinline__ unsigned pk2(float lo, float hi) { unsigned r; asm("v_cvt_pk_bf16_f32 %0, %1, %2" : "=v"(r) : "v"(lo), "v"(hi)); return r; }
__device__ __forceinline__ unsigned f2bf(float f) { return pk2(f, f) & 0xffffu; }
__device__ __forceinline__ float fast_rcp(float x) { return __builtin_amdgcn_rcpf(x); }
__device__ __forceinline__ float sigmoid_f(float x) { return fast_rcp(1.0f + __expf(-x)); }
__device__ __forceinline__ float silu_f(float x) { return x * sigmoid_f(x); }
__device__ __forceinline__ float gelu_tanh_f(float x) {
    const float u = 0.7978845608028654f * (x + 0.044715f * x * x * x);
    return x * sigmoid_f(2.0f * u);
}
__device__ __forceinline__ float neg_expm1_f(float x) {
    const float p = -x * (1.0f + x * (0.5f + x * (0.16666667f + x * (0.041666668f + x * (0.0083333338f + x * (0.0013888889f + x * 0.0001984127f))))));
    const float q = 1.0f - __expf(x);
    return x > -0.35f ? p : q;
}
__device__ __forceinline__ float wave_sum(float v) {
#pragma unroll
    for (int o = 1; o < 64; o <<= 1) v += __shfl_xor(v, o);
    return v;
}

#define XB_TMO      128
#define XB_XCNT(j)  (256  + 64 * (j))
#define XB_XSUB(j)  (1280 + 64 * (j))
#define XB_XGEN(j)  (2304 + 64 * (j))
#define XB_TOP      3328
#define XB_TOPGEN   3392
#define XCD_BAR_WORDS 3456
#define XB_SPIN_CAP (1u << 18)

__device__ __forceinline__ unsigned xb_ld(unsigned* p)              { return __hip_atomic_load(p, __ATOMIC_RELAXED, __HIP_MEMORY_SCOPE_AGENT); }
__device__ __forceinline__ unsigned xb_add(unsigned* p, unsigned v) { return __hip_atomic_fetch_add(p, v, __ATOMIC_RELAXED, __HIP_MEMORY_SCOPE_AGENT); }
__device__ __forceinline__ unsigned xb_xcc_id() { return (unsigned)__builtin_amdgcn_s_getreg((3 << 11) | 20) & 0xFu; }
#define XB_SPIN(cond, bar) do { unsigned _sp = 0; while (cond) { __builtin_amdgcn_s_sleep(1); \
    if ((++_sp & 255u) == 0u) { if (xb_ld(&(bar)[XB_TMO])) break; if (_sp > XB_SPIN_CAP) { atomicAdd(&(bar)[XB_TMO], 1u); break; } } } } while (0)

struct XcdBarrier {
    unsigned* bar; unsigned x;
    volatile LAS unsigned* st;
};

__device__ __forceinline__ XcdBarrier xcd_barrier_post(unsigned* bar, volatile LAS unsigned* st) {
    XcdBarrier b; b.bar = bar; b.x = xb_xcc_id(); b.st = st;
    if (threadIdx.x == 0) (void)xb_add(&bar[XB_XCNT(b.x)], 1u);
    return b;
}
__device__ __forceinline__ void xcd_barrier_complete(unsigned* bar, unsigned x, unsigned& nloc, unsigned& nx) {
    const unsigned G = gridDim.x * gridDim.y * gridDim.z;
    unsigned sum, cnt, mine, sp = 0u;
    for (;;) {
        sum = 0u; cnt = 0u; mine = 0u;
#pragma unroll
        for (unsigned j = 0; j < 16; ++j) { const unsigned c = xb_ld(&bar[XB_XCNT(j)]); sum += c; cnt += (c > 0u) ? 1u : 0u; mine = (j == x) ? c : mine; }
        if (sum == G) break;
        __builtin_amdgcn_s_sleep(1);
        if ((++sp & 255u) == 0u) { if (xb_ld(&bar[XB_TMO])) break; if (sp > XB_SPIN_CAP) { atomicAdd(&bar[XB_TMO], 1u); break; } }
    }
    nloc = mine > 0u ? mine : 1u; nx = cnt > 0u ? cnt : 1u;
}

__device__ __forceinline__ void xcd_barrier(const XcdBarrier& b, const bool is_t0) {
    asm volatile("s_waitcnt vmcnt(0)" ::: "memory");
    __syncthreads();
    if (is_t0) {
        unsigned* bar = b.bar;
        __builtin_amdgcn_s_waitcnt(0);
        unsigned nloc = b.st[0], nx = b.st[1];
        if (nloc == 0u) { xcd_barrier_complete(bar, b.x, nloc, nx); b.st[0] = nloc; b.st[1] = nx; }
        const unsigned old = xb_add(&bar[XB_XSUB(b.x)], 1u);
        const unsigned gen = old / nloc;
        if (old + 1u == (gen + 1u) * nloc) {
            __builtin_amdgcn_fence(__ATOMIC_RELEASE, "agent");
            asm volatile("s_waitcnt vmcnt(0)" ::: "memory");
            const unsigned og = xb_add(&bar[XB_TOP], 1u);
            const unsigned tg = og / nx;
            if (og + 1u == (tg + 1u) * nx) xb_add(&bar[XB_TOPGEN], 1u);
            else XB_SPIN(xb_ld(&bar[XB_TOPGEN]) == tg, bar);
            __builtin_amdgcn_fence(__ATOMIC_ACQUIRE, "agent");
            xb_add(&bar[XB_XGEN(b.x)], 1u);
            asm volatile("s_waitcnt vmcnt(0)" ::: "memory");
        } else {
            XB_SPIN(xb_ld(&bar[XB_XGEN(b.x)]) == gen, bar);
            __builtin_amdgcn_fence(__ATOMIC_ACQUIRE, "agent");
            asm volatile("s_waitcnt vmcnt(0)" ::: "memory");
        }
    }
    __syncthreads();
}

constexpr size_t WS_BAR = 0x380000;
constexpr int LDS_BARST = 139264;
constexpr size_t WS_SKF = 0x390000;

struct EpiGU {
    static constexpr bool PERM = true, AFTER_DRAIN = false, INIT_ACC = false;
    bf16_t* ACT; const float* ss;
    __device__ __forceinline__ void operator()(const f32x4 (&acc)[2][2][4][2], const pg8::Unit& u, int wr, int wc, int fr, int fq) const {
        const int row0 = u.pm * 256 + wr * 64 + fr, col0 = u.pn * 128 + wc * 32 + 8 * fq;
        float rs[2][4];
#pragma unroll
        for (int ai = 0; ai < 2; ++ai)
#pragma unroll
            for (int m = 0; m < 4; ++m) rs[ai][m] = ss[row0 + ai * 128 + m * 16];
#pragma unroll
        for (int ai = 0; ai < 2; ++ai)
#pragma unroll
            for (int m = 0; m < 4; ++m) {
                const int r = row0 + ai * 128 + m * 16;
                const float rstd = __builtin_amdgcn_rsqf(rs[ai][m] * (1.0f / D) + EPS);
                float o[8];
#pragma unroll
                for (int n = 0; n < 2; ++n)
#pragma unroll
                    for (int e = 0; e < 4; ++e) { const float g = acc[ai][0][m][n][e] * rstd, up = acc[ai][1][m][n][e] * rstd; o[4 * n + e] = silu_f(g) * up; }
                u32x4 w; w.x = pk2(o[0], o[1]); w.y = pk2(o[2], o[3]); w.z = pk2(o[4], o[5]); w.w = pk2(o[6], o[7]);
                *(u32x4*)(ACT + (size_t)r * FF + col0) = w;
            }
    }
};
struct EpiRes {
    static constexpr bool PERM = true, AFTER_DRAIN = false, INIT_ACC = true;
    float* X; bf16_t* XB; float* ssn; float scale;
    __device__ __forceinline__ void init(f32x4 (&acc)[2][2][4][2], const pg8::Unit& u, int wr, int wc, int fr, int fq) const {
        const int row0 = u.pm * 256 + wr * 64 + fr, col0 = u.pn * 256 + wc * 32 + 8 * fq; const float inv = 1.0f / scale;
#pragma unroll
        for (int ai = 0; ai < 2; ++ai)
#pragma unroll
            for (int m = 0; m < 4; ++m)
#pragma unroll
                for (int bj = 0; bj < 2; ++bj) { const float* xp = X + (size_t)(row0 + ai * 128 + m * 16) * D + col0 + bj * 128; acc[ai][bj][m][0] = *(const f32x4*)xp * inv; acc[ai][bj][m][1] = *(const f32x4*)(xp + 4) * inv; }
    }
    __device__ __forceinline__ void operator()(const f32x4 (&acc)[2][2][4][2], const pg8::Unit& u, int wr, int wc, int fr, int fq) const {
        const int row0 = u.pm * 256 + wr * 64 + fr, col0 = u.pn * 256 + wc * 32 + 8 * fq;
#pragma unroll
        for (int ai = 0; ai < 2; ++ai)
#pragma unroll
            for (int m = 0; m < 4; ++m) {
                const int r = row0 + ai * 128 + m * 16; float q = 0.f;
#pragma unroll
                for (int bj = 0; bj < 2; ++bj) {
                    float* xp = X + (size_t)r * D + col0 + bj * 128;
                    const f32x4 v0 = acc[ai][bj][m][0] * scale, v1 = acc[ai][bj][m][1] * scale;
                    *(f32x4*)xp = v0; *(f32x4*)(xp + 4) = v1;
                    u32x4 w; w.x = pk2(v0[0], v0[1]); w.y = pk2(v0[2], v0[3]); w.z = pk2(v1[0], v1[1]); w.w = pk2(v1[2], v1[3]);
                    *(u32x4*)(XB + (size_t)r * D + col0 + bj * 128) = w;
                    q += (v0[0] * v0[0] + v0[1] * v0[1]) + (v0[2] * v0[2] + v0[3] * v0[3]) + (v1[0] * v1[0] + v1[1] * v1[1]) + (v1[2] * v1[2] + v1[3] * v1[3]);
                }
                q += __shfl_xor(q, 16); q += __shfl_xor(q, 32);
                if (fq == 0) atomicAdd(ssn + r, q);
            }
    }
};
struct EpiWin {
    static constexpr bool PERM = true, AFTER_DRAIN = false, INIT_ACC = false;
    bf16_t *U, *BX, *GG; const float* ss;
    __device__ __forceinline__ void operator()(const f32x4 (&acc)[2][2][4][2], const pg8::Unit& u, int wr, int wc, int fr, int fq) const {
        const int row0 = u.pm * 256 + wr * 64 + fr, col0 = (u.pn & 3) * 128 + wc * 32 + 8 * fq;
        const bool isA = u.pn < 4;
        float rs[2][4];
#pragma unroll
        for (int ai = 0; ai < 2; ++ai)
#pragma unroll
            for (int m = 0; m < 4; ++m) rs[ai][m] = ss[row0 + ai * 128 + m * 16];
#pragma unroll
        for (int ai = 0; ai < 2; ++ai)
#pragma unroll
            for (int m = 0; m < 4; ++m) {
                const int r = row0 + ai * 128 + m * 16;
                const float rstd = __builtin_amdgcn_rsqf(rs[ai][m] * (1.0f / D) + EPS);
                float a0[8], a1[8];
#pragma unroll
                for (int n = 0; n < 2; ++n)
#pragma unroll
                    for (int e = 0; e < 4; ++e) { a0[4 * n + e] = acc[ai][0][m][n][e] * rstd; a1[4 * n + e] = acc[ai][1][m][n][e] * rstd; }
                if (isA) {
                    float o[8];
#pragma unroll
                    for (int e = 0; e < 8; ++e) o[e] = a0[e] * sigmoid_f(a1[e]);
                    u32x4 w; w.x = pk2(o[0], o[1]); w.y = pk2(o[2], o[3]); w.z = pk2(o[4], o[5]); w.w = pk2(o[6], o[7]);
                    *(u32x4*)(U + (size_t)r * 512 + col0) = w;
                } else {
                    float o[8];
#pragma unroll
                    for (int e = 0; e < 8; ++e) o[e] = gelu_tanh_f(a1[e]);
                    u32x4 w; w.x = pk2(a0[0], a0[1]); w.y = pk2(a0[2], a0[3]); w.z = pk2(a0[4], a0[5]); w.w = pk2(a0[6], a0[7]);
                    *(u32x4*)(BX + (size_t)r * 512 + col0) = w;
                    u32x4 g; g.x = pk2(o[0], o[1]); g.y = pk2(o[2], o[3]); g.z = pk2(o[4], o[5]); g.w = pk2(o[6], o[7]);
                    *(u32x4*)(GG + (size_t)r * 512 + col0) = g;
                }
            }
    }
};

struct Args { const float* in[N_IN]; float* out; unsigned char* ws; int ph_lo, ph_hi; };
struct Frame {
    LAS unsigned char* lds;
    int tid, lane, wave, G;
    const float* const __attribute__((address_space(4)))* in; float* out; unsigned char* ws;
};
#define LDS_WAIT() asm volatile("s_waitcnt lgkmcnt(0)" ::: "memory")

template <class FrameT>
__device__ __forceinline__ void res_fixup(FrameT& F, const EpiRes& E, const pg8::DpSplit& S) {
    const int nleft = S.nwg - S.G, tid = F.tid, wid = tid >> 6, lane = tid & 63, wr = wid >> 2, wc = wid & 3, fr = lane & 15, fq = lane >> 4;
    for (int item = blockIdx.x; item < nleft * 8; item += F.G) {
        const int j = item >> 3, ai = (item >> 2) & 1, m = item & 3;
        pg8::Unit u; S.unit_of(S.G + j, u);
        const int r = u.pm * 256 + wr * 64 + fr + ai * 128 + m * 16, col0 = u.pn * 256 + wc * 32 + 8 * fq;
        float q = 0.f;
#pragma unroll
        for (int bj = 0; bj < 2; ++bj) {
            f32x4 a0 = {0.f, 0.f, 0.f, 0.f}, a1 = {0.f, 0.f, 0.f, 0.f};
#pragma unroll
            for (int p = 0; p < 4; ++p) {
                const float* sp = S.slab + (size_t)(4 * j + p) * 65536 + (size_t)((((ai * 2 + bj) * 4 + m) * 2) * 2048) + tid * 4;
                a0 += __builtin_nontemporal_load((const f32x4*)sp); a1 += __builtin_nontemporal_load((const f32x4*)(sp + 2048));
            }
            float* xp = E.X + (size_t)r * D + col0 + bj * 128;
            f32x4 v0 = *(f32x4*)xp, v1 = *(f32x4*)(xp + 4);
            v0 = v0 + a0 * E.scale; v1 = v1 + a1 * E.scale;
            *(f32x4*)xp = v0; *(f32x4*)(xp + 4) = v1;
            u32x4 w; w.x = pk2(v0[0], v0[1]); w.y = pk2(v0[2], v0[3]); w.z = pk2(v1[0], v1[1]); w.w = pk2(v1[2], v1[3]);
            *(u32x4*)(E.XB + (size_t)r * D + col0 + bj * 128) = w;
            q += (v0[0] * v0[0] + v0[1] * v0[1]) + (v0[2] * v0[2] + v0[3] * v0[3]) + (v1[0] * v1[0] + v1[1] * v1[1]) + (v1[2] * v1[2] + v1[3] * v1[3]);
        }
        q += __shfl_xor(q, 16); q += __shfl_xor(q, 32);
        if (fq == 0) atomicAdd(E.ssn + r, q);
    }
}


__device__ __forceinline__ void transpose_item(const float* W, int K, int N, bf16_t* WT, const float* g, int mode, LAS float* scr, int item, int lane) {
    const int nblk = N / 32, kb = item / nblk, nb = item % nblk, k0 = 64 * kb, n0 = 32 * nb;
    float tv[32];
#pragma unroll
    for (int i = 0; i < 32; ++i) { const int kk = 2 * i + (lane >> 5); tv[i] = __builtin_nontemporal_load(W + (size_t)(k0 + kk) * N + n0 + (lane & 31)); }
    if (g) {
#pragma unroll
        for (int i = 0; i < 32; ++i) tv[i] *= g[k0 + 2 * i + (lane >> 5)];
    }
#pragma unroll
    for (int i = 0; i < 32; ++i) scr[(2 * i + (lane >> 5)) * 33 + (lane & 31)] = tv[i];
    LDS_WAIT(); asm volatile("" ::: "memory");
    int d0;
    if (mode == 0) d0 = n0;
    else if (mode == 1) d0 = 256 * (n0 >> 7) + (n0 & 127);
    else if (mode == 2) d0 = 256 * (n0 >> 7) + 128 + (n0 & 127);
    else { const int seg = n0 >> 9, cc = n0 & 511; d0 = 256 * ((seg >> 1) * 4 + (cc >> 7)) + 128 * (seg & 1) + (cc & 127); }
    const int c = lane & 7;
#pragma unroll
    for (int j = 0; j < 4; ++j) { const int n = (lane >> 3) + 8 * j; const LAS float* s = scr + (8 * c) * 33 + n;
        u32x4 o; o.x = pk2(s[0 * 33], s[1 * 33]); o.y = pk2(s[2 * 33], s[3 * 33]); o.z = pk2(s[4 * 33], s[5 * 33]); o.w = pk2(s[6 * 33], s[7 * 33]);
        *(u32x4*)(WT + (size_t)(d0 + n) * K + k0 + 8 * c) = o; }
    LDS_WAIT(); asm volatile("" ::: "memory");
}
constexpr int IT_G = (D / 64) * (FF / 32), IT_D = (FF / 64) * (D / 32), IT_WIN = (D / 64) * (2048 / 32), IT_WOUT = (D / 64) * (D / 32);
__device__ __forceinline__ void convert_mats(Frame& F, int l, int id_lo, int id_hi, int gw, int NGW) {
    LAS float* scr = (LAS float*)(F.lds + F.wave * 16384);
    unsigned char* ws = F.ws;
    for (int id = id_lo; id < id_hi; ++id) {
        const int nit = (id == 0 || id == 4) ? 2 * IT_G : (id == 1 || id == 5) ? IT_D : (id == 2 ? IT_WIN : IT_WOUT);
        for (int it = gw; it < nit; it += NGW) {
            if (id == 0) { const bool up = it >= IT_G; transpose_item(F.in[up ? I_W1U : I_W1G] + (size_t)l * D * FF, D, FF, (bf16_t*)(ws + WS_WGU1), F.in[I_GF1] + l * D, up ? 2 : 1, scr, up ? it - IT_G : it, F.lane); }
            else if (id == 4) { const bool up = it >= IT_G; transpose_item(F.in[up ? I_W2U : I_W2G] + (size_t)l * D * FF, D, FF, (bf16_t*)(ws + WS_WGU2), F.in[I_GF2] + l * D, up ? 2 : 1, scr, up ? it - IT_G : it, F.lane); }
            else if (id == 1) transpose_item(F.in[I_W1D] + (size_t)l * D * FF, FF, D, (bf16_t*)(ws + WS_WD1), nullptr, 0, scr, it, F.lane);
            else if (id == 5) transpose_item(F.in[I_W2D] + (size_t)l * D * FF, FF, D, (bf16_t*)(ws + WS_WD2), nullptr, 0, scr, it, F.lane);
            else if (id == 2) transpose_item(F.in[I_WIN] + (size_t)l * D * 2048, D, 2048, (bf16_t*)(ws + WS_WIN), F.in[I_GMIX] + l * D, 3, scr, it, F.lane);
            else transpose_item(F.in[I_WOUT] + (size_t)l * D * D, D, D, (bf16_t*)(ws + WS_WOUT), nullptr, 0, scr, it, F.lane);
        }
    }
}

__device__ __forceinline__ void p0_prologue(Frame& F) {
    convert_mats(F, 0, 0, 6, blockIdx.x * NWAVES + F.wave, F.G * NWAVES);
    const int gw = blockIdx.x * NWAVES + F.wave, NGW = F.G * NWAVES;
    float* X = (float*)(F.ws + WS_X); bf16_t* XB = (bf16_t*)(F.ws + WS_XB); float* ss = (float*)(F.ws + WS_SS);
    for (int r = gw; r < MPAD; r += NGW) {
        const float* src = nullptr;
        if (r < MP) { const int b = r / TP, tt = r - b * TP; src = tt < NMETA ? F.in[I_META] + (size_t)tt * D : F.in[I_XP] + ((size_t)b * SEQ + (tt - NMETA)) * D; }
        else if (r < MR) src = F.in[I_XS] + (size_t)(r - MP) * D;
        f32x4 v[4]; float s = 0.f;
#pragma unroll
        for (int j = 0; j < 4; ++j) { v[j] = src ? __builtin_nontemporal_load((const f32x4*)src + F.lane + 64 * j) : (f32x4){0.f, 0.f, 0.f, 0.f}; s += (v[j][0] * v[j][0] + v[j][1] * v[j][1]) + (v[j][2] * v[j][2] + v[j][3] * v[j][3]); }
        s = wave_sum(s);
#pragma unroll
        for (int j = 0; j < 4; ++j) { ((f32x4*)(X + (size_t)r * D))[F.lane + 64 * j] = v[j];
            u32x2 w; w.x = pk2(v[j][0], v[j][1]); w.y = pk2(v[j][2], v[j][3]); ((u32x2*)(XB + (size_t)r * D))[F.lane + 64 * j] = w; }
        if (F.lane == 0) ss[r] = s;
    }
    { const int i = blockIdx.x * 512 + F.tid; if (i < 6 * MPAD) ss[MPAD + i] = 0.f; }
}

__device__ __forceinline__ void final_phase(Frame& F) {
    const int gw = blockIdx.x * NWAVES + F.wave, NGW = F.G * NWAVES;
    const float* X = (const float*)(F.ws + WS_X); const float* ss = (const float*)(F.ws + WS_SS) + 6 * MPAD; const float* g = F.in[I_GFIN];
    f32x4 gv[4];
#pragma unroll
    for (int j = 0; j < 4; ++j) gv[j] = ((const f32x4*)g)[F.lane + 64 * j];
    for (int r = gw; r < MR; r += NGW) {
        float* dst;
        if (r < MP) { const int b = r / TP, tt = r - b * TP; if (tt < NMETA) continue; dst = F.out + O_YP + ((size_t)b * SEQ + (tt - NMETA)) * D; }
        else dst = F.out + O_YS + (size_t)(r - MP) * D;
        const float rstd = __builtin_amdgcn_rsqf(ss[r] * (1.0f / D) + EPS);
#pragma unroll
        for (int j = 0; j < 4; ++j) { const f32x4 v = ((const f32x4*)(X + (size_t)r * D))[F.lane + 64 * j]; __builtin_nontemporal_store(v * rstd * gv[j], (f32x4*)dst + F.lane + 64 * j); }
    }
}

constexpr int LDS_WR = 0, LDS_WI = 16384, LDS_CBT = 32768, LDS_GRP = LDS_CBT + 4 * 64 * 68 * 4, LDS_RED = 0;

__device__ __forceinline__ float reduce_scatter32(float (&v)[32], int lane) {
#define RS_STEP(H, M) { const bool up = (lane & (M)) != 0; _Pragma("unroll") for (int i = 0; i < (H); ++i) { const float snd = up ? v[i] : v[i + (H)], kp = up ? v[i + (H)] : v[i]; v[i] = kp + __shfl_xor(snd, (M)); } }
    RS_STEP(16, 32) RS_STEP(8, 16) RS_STEP(4, 8) RS_STEP(2, 4) RS_STEP(1, 2)
#undef RS_STEP
    return v[0] + __shfl_xor(v[0], 1);
}

__device__ __forceinline__ void mix_job_a(Frame& F, int l, int sp, int gi) {
    const int tid = F.tid, c = 128 * gi + (tid & 127), sub = tid >> 7;
    const bf16_t* U = (const bf16_t*)(F.ws + WS_U); bf16_t* YAB = (bf16_t*)(F.ws + WS_YAB);
    const float* cw = F.in[I_CAW] + (size_t)l * 31 * DA;
    float w[31];
#pragma unroll
    for (int k = 0; k < 31; ++k) w[k] = cw[k * DA + c];
    const float cbias = F.in[I_CAB][l * DA + c], lg = F.in[I_LNG][l * DA + c], lb = F.in[I_LNB][l * DA + c];
    float acc[32];
#pragma unroll
    for (int t = 0; t < 32; ++t) acc[t] = cbias;
    int rowbase, nval;
    if (sp < 136) {
        const int b = sp / 17, k2 = sp - b * 17, nvalid = (k2 == 16) ? 16 : 128, seqrow0 = b * TP, tb = 128 * k2 + 32 * sub;
        nval = nvalid - 32 * sub; rowbase = seqrow0 + tb;
        if (nval > 0) {
#pragma unroll
            for (int tt = 0; tt < 62; ++tt) {
                const int ti = tb - 30 + tt;
                const float v = ti >= 0 ? bf2f(U[(size_t)(seqrow0 + ti) * 512 + c]) : 0.f;
#pragma unroll
                for (int t = 0; t < 32; ++t) { const int kk = tt - t; if (kk >= 0 && kk <= 30) acc[t] += w[kk] * v; }
            }
        }
    } else {
        nval = 32; const int s0 = 16 * (sp - 136) + 4 * sub; rowbase = MP + 8 * s0;
        const float* st = F.in[I_SCA] + (size_t)l * NB_S * 30 * DA;
#pragma unroll
        for (int hs = 0; hs < 4; ++hs) {
            const int s = s0 + hs, rowS = MP + 8 * s;
#pragma unroll
            for (int tt = 0; tt < 38; ++tt) {
                const float v = tt < 30 ? st[((size_t)s * 30 + tt) * DA + c] : bf2f(U[(size_t)(rowS + tt - 30) * 512 + c]);
#pragma unroll
                for (int t = 0; t < 8; ++t) { const int kk = tt - t; if (kk >= 0 && kk <= 30) acc[8 * hs + t] += w[kk] * v; }
            }
        }
    }
    LAS f32x2* red = (LAS f32x2*)(F.lds + LDS_RED);
    float s1[32], s2[32];
#pragma unroll
    for (int t = 0; t < 32; ++t) { s1[t] = acc[t]; s2[t] = acc[t] * acc[t]; }
    const float r1 = reduce_scatter32(s1, F.lane), r2 = reduce_scatter32(s2, F.lane);
    __syncthreads();
    if ((F.lane & 1) == 0) red[F.wave * 32 + (F.lane >> 1)] = (f32x2){r1, r2};
    __syncthreads();
    if (nval > 0) {
#pragma unroll
        for (int t = 0; t < 32; ++t) {
            const f32x2 a = red[F.wave * 32 + t], o = red[(F.wave ^ 1) * 32 + t];
            const float mean = (a.x + o.x) * (1.0f / 128.0f), var = (a.y + o.y) * (1.0f / 128.0f) - mean * mean;
            const float rstd = __builtin_amdgcn_rsqf(fmaxf(var, 0.f) + EPS);
            const float y = (acc[t] - mean) * rstd * lg + lb;
            if (t < nval) YAB[(size_t)(rowbase + t) * D + c] = (bf16_t)f2bf(silu_f(y));
        }
    }
}

constexpr int WJ_TILE = 9728;
constexpr int LDS_WT = 8 * WJ_TILE;
typedef short bf16x8_t __attribute__((ext_vector_type(8)));

__device__ __forceinline__ void mix_b_wave_jobs(Frame& F, int l) {
    const int lane = F.lane, wave = F.wave, fr = lane & 15, fq = lane >> 4, h = blockIdx.x & 7;
    const bf16_t* BX = (const bf16_t*)(F.ws + WS_BX);
    bf16_t* YAB = (bf16_t*)(F.ws + WS_YAB); bf16_t* PCG = (bf16_t*)(F.ws + WS_XB);
    LAS bf16_t* WT = (LAS bf16_t*)(F.lds + LDS_WT);
    LAS bf16_t* tile = (LAS bf16_t*)(F.lds + wave * WJ_TILE);
    __syncthreads();
    {
        const f32x4* gr = (const f32x4*)(F.in[I_WRG] + (size_t)(l * 8 + h) * 4096); const f32x4* gx = (const f32x4*)(F.in[I_WIG] + (size_t)(l * 8 + h) * 4096);
#pragma unroll
        for (int e = 0; e < 2; ++e) {
            const int idx = F.tid + e * 512, i = idx >> 4, j4 = (idx & 15) * 4;
            const f32x4 a = gr[idx], b = gx[idx];
#pragma unroll
            for (int d = 0; d < 4; ++d) { WT[(j4 + d) * 72 + i] = (bf16_t)f2bf(a[d]); WT[(64 + j4 + d) * 72 + i] = (bf16_t)f2bf(b[d]); }
        }
    }
    float bra[4], bix[4], sp[4];
#pragma unroll
    for (int nt = 0; nt < 4; ++nt) {
        const int c = 64 * h + 16 * nt + fr;
        bra[nt] = F.in[I_BRG][l * DB + c]; bix[nt] = F.in[I_BIG][l * DB + c];
        sp[nt] = log1pf(expf(-F.in[I_LAM][l * DB + c]));
    }
    __syncthreads();
    for (int q = (int)(blockIdx.x >> 3) * 8 + wave; q < NQ; q += 256) {
        const bool prompt = q < NQ_P;
        int row0, t0, nvalid;
        if (prompt) { const int b_ = q / NCH_P, k = q - b_ * NCH_P; row0 = b_ * TP + 64 * k; t0 = 64 * k; nvalid = (k == NCH_P - 1) ? 16 : 64; }
        else { row0 = MP + 64 * (q - NQ_P); t0 = 0; nvalid = 64; }
        int ln = lane; asm volatile("" : "+v"(ln));
#pragma unroll
        for (int i = 0; i < 9; ++i) {
            const int p = ln + 64 * i;
            if (p < 536) {
                const int rr = p >> 3, pc = p & 7, row = rr - 3;
                const bool okr = prompt ? (t0 + row >= 0) : (row >= 0);
                u32x4 v = *(const u32x4*)(BX + (size_t)(row0 + (okr ? row : 0)) * 512 + 64 * h + 8 * pc);
                if (!okr) v = (u32x4){0u, 0u, 0u, 0u};
                *(LAS u32x4*)(tile + rr * 72 + 8 * pc) = v;
            }
        }
        float wb[4][4], bb[4];
        { int fr_l = fr; asm volatile("" : "+v"(fr_l));
#pragma unroll
        for (int nt = 0; nt < 4; ++nt) {
            const int c = 64 * h + 16 * nt + fr_l;
#pragma unroll
            for (int k = 0; k < 4; ++k) wb[k][nt] = F.in[I_CBW][((size_t)l * 4 + k) * DB + c];
            bb[nt] = F.in[I_CBB][l * DB + c];
        } }
        float cbv[4][4][4];
#pragma unroll
        for (int mt = 0; mt < 4; ++mt)
#pragma unroll
            for (int nt = 0; nt < 4; ++nt) {
                const int tb = 16 * mt + 4 * fq; float x[7];
#pragma unroll
                for (int i = 0; i < 7; ++i) x[i] = bf2f(tile[(tb + i) * 72 + 16 * nt + fr]);
                if (!prompt && !(fq & 1)) {
                    const int s = 8 * (q - NQ_P) + 2 * mt + (fq >> 1);
                    const float* st = F.in[I_SCB] + ((size_t)l * NB_S + s) * 3 * DB + 64 * h + 16 * nt + fr;
                    x[0] = st[0]; x[1] = st[DB]; x[2] = st[2 * DB];
                }
#pragma unroll
                for (int e = 0; e < 4; ++e) cbv[mt][nt][e] = bb[nt] + wb[0][nt] * x[e] + wb[1][nt] * x[e + 1] + wb[2][nt] * x[e + 2] + wb[3][nt] * x[e + 3];
            }
        asm volatile("s_waitcnt lgkmcnt(0)" ::: "memory");
#pragma unroll
        for (int mt = 0; mt < 4; ++mt)
#pragma unroll
            for (int nt = 0; nt < 4; ++nt)
#pragma unroll
                for (int e = 0; e < 4; ++e) tile[(16 * mt + 4 * fq + e) * 72 + 16 * nt + fr] = (bf16_t)f2bf(cbv[mt][nt][e]);
        asm volatile("s_waitcnt lgkmcnt(0)" ::: "memory");
        float Pc[4] = {1.f, 1.f, 1.f, 1.f}, Hc[4] = {0.f, 0.f, 0.f, 0.f};
#pragma unroll
        for (int mt = 0; mt < 4; ++mt) {
            const bf16x8_t a0 = *(const LAS bf16x8_t*)(tile + (16 * mt + fr) * 72 + 8 * fq), a1 = *(const LAS bf16x8_t*)(tile + (16 * mt + fr) * 72 + 32 + 8 * fq);
#pragma unroll
            for (int nt = 0; nt < 4; ++nt) {
                const int c = 64 * h + 16 * nt + fr;
                const bf16x8_t br0 = *(const LAS bf16x8_t*)(WT + (16 * nt + fr) * 72 + 8 * fq), br1 = *(const LAS bf16x8_t*)(WT + (16 * nt + fr) * 72 + 32 + 8 * fq);
                const bf16x8_t bi0 = *(const LAS bf16x8_t*)(WT + (64 + 16 * nt + fr) * 72 + 8 * fq), bi1 = *(const LAS bf16x8_t*)(WT + (64 + 16 * nt + fr) * 72 + 32 + 8 * fq);
                f32x4 accR = {0.f, 0.f, 0.f, 0.f}, accI = {0.f, 0.f, 0.f, 0.f};
                accR = __builtin_amdgcn_mfma_f32_16x16x32_bf16(a0, br0, accR, 0, 0, 0); accR = __builtin_amdgcn_mfma_f32_16x16x32_bf16(a1, br1, accR, 0, 0, 0);
                accI = __builtin_amdgcn_mfma_f32_16x16x32_bf16(a0, bi0, accI, 0, 0, 0); accI = __builtin_amdgcn_mfma_f32_16x16x32_bf16(a1, bi1, accI, 0, 0, 0);
                float P4[4], H4[4]; float hp = 0.f, pp = 1.f;
#pragma unroll
                for (int e = 0; e < 4; ++e) {
                    const float r = sigmoid_f(accR[e] + bra[nt]), ig = sigmoid_f(accI[e] + bix[nt]);
                    const float la = -8.0f * r * sp[nt], a = __expf(la), bt = __builtin_amdgcn_sqrtf(neg_expm1_f(2.0f * la)) * (ig * bf2f(tile[(16 * mt + 4 * fq + e) * 72 + 16 * nt + fr]));
                    hp = a * hp + bt; pp = pp * a; H4[e] = hp; P4[e] = pp;
                }
                float pex = 1.f, hex = 0.f;
#pragma unroll
                for (int d = 3; d >= 1; --d) {
                    const float ps = __shfl(pp, lane - 16 * d), hs = __shfl(hp, lane - 16 * d);
                    const bool use = prompt ? (fq >= d) : (d == 1 && (fq & 1));
                    if (use) { hex = ps * hex + hs; pex = pex * ps; }
                }
                const float pin = prompt ? Pc[nt] * pex : pex, hin = prompt ? pex * Hc[nt] + hex : hex;
                float Pf[4], Hf[4];
#pragma unroll
                for (int e = 0; e < 4; ++e) { Hf[e] = H4[e] + P4[e] * hin; Pf[e] = P4[e] * pin; }
                Pc[nt] = __shfl(Pf[3], fr + 48); Hc[nt] = __shfl(Hf[3], fr + 48);
#pragma unroll
                for (int e = 0; e < 4; ++e) {
                    const int tl = 16 * mt + 4 * fq + e;
                    if (tl < nvalid) { const size_t row = (size_t)(row0 + tl); YAB[row * D + 512 + c] = (bf16_t)f2bf(Hf[e]); PCG[row * 512 + c] = (bf16_t)f2bf(Pf[e]); }
                }
                if (prompt) { if (16 * (mt + 1) == nvalid && fq == 3) ((f32x2*)(F.ws + WS_SUMM))[(size_t)q * 512 + c] = (f32x2){Pf[3], Hf[3]}; }
                else if (fq & 1) { const int s = 8 * (q - NQ_P) + 2 * mt + (fq >> 1); ((f32x2*)(F.ws + WS_LAST))[(size_t)s * 512 + c] = (f32x2){Pf[3], Hf[3]}; }
            }
        }
    }
}

constexpr int LDS_ARED = 98304;
__device__ __forceinline__ float reduce_scatter16(float (&v)[16], int lane) {
#define RS_STEP(H, M) { const bool up = (lane & (M)) != 0; _Pragma("unroll") for (int i = 0; i < (H); ++i) { const float snd = up ? v[i] : v[i + (H)], kp = up ? v[i + (H)] : v[i]; v[i] = kp + __shfl_xor(snd, (M)); } }
    RS_STEP(8, 32) RS_STEP(4, 16) RS_STEP(2, 8) RS_STEP(1, 4)
#undef RS_STEP
    float r = v[0]; r += __shfl_xor(r, 2); r += __shfl_xor(r, 1); return r;
}
__device__ __forceinline__ void mix_a_wave_jobs(Frame& F, int l) {
    const int lane = F.lane, wave = F.wave, gi = wave & 3, c0 = 128 * gi + 2 * lane;
    const bf16_t* U = (const bf16_t*)(F.ws + WS_U); bf16_t* YAB = (bf16_t*)(F.ws + WS_YAB);
    const float* cw = F.in[I_CAW] + (size_t)l * 31 * DA;
    f32x2 w[31];
#pragma unroll
    for (int k = 0; k < 31; ++k) w[k] = *(const f32x2*)(cw + k * DA + c0);
    const f32x2 cbv = *(const f32x2*)(F.in[I_CAB] + l * DA + c0), lgv = *(const f32x2*)(F.in[I_LNG] + l * DA + c0), lbv = *(const f32x2*)(F.in[I_LNB] + l * DA + c0);
    LAS f32x2* red = (LAS f32x2*)(F.lds + LDS_ARED + wave * 128);
    for (int tb = 511 - ((int)blockIdx.x * 2 + (wave >> 2)); tb < 1096; tb += 512) {
        f32x2 a[16];
#pragma unroll
        for (int t = 0; t < 16; ++t) a[t] = cbv;
        int rowbase;
        if (tb < 1032) {
            const int b = tb / 129, kb = tb - b * 129, t0 = 16 * kb, seqrow0 = b * TP; rowbase = seqrow0 + t0;
            unsigned raw[46];
#pragma unroll
            for (int tt = 0; tt < 46; ++tt) { const int ti = t0 - 30 + tt; raw[tt] = *(const unsigned*)(U + (size_t)(seqrow0 + (ti < 0 ? 0 : ti)) * 512 + c0); }
#pragma unroll
            for (int tt = 0; tt < 46; ++tt) {
                const unsigned rw = ((t0 - 30 + tt) >= 0) ? raw[tt] : 0u;
                const f32x2 v = {__uint_as_float(rw << 16), __uint_as_float(rw & 0xffff0000u)};
#pragma unroll
                for (int t = 0; t < 16; ++t) { const int kk = tt - t; if (kk >= 0 && kk <= 30) a[t] += w[kk] * v; }
            }
        } else {
            const int s0 = 2 * (tb - 1032); rowbase = MP + 8 * s0;
            const float* st = F.in[I_SCA] + (size_t)l * NB_S * 30 * DA;
#pragma unroll
            for (int hs = 0; hs < 2; ++hs) {
                const int s = s0 + hs, rowS = MP + 8 * s;
#pragma unroll
                for (int tt = 0; tt < 38; ++tt) {
                    f32x2 v;
                    if (tt < 30) v = *(const f32x2*)(st + ((size_t)s * 30 + tt) * DA + c0);
                    else { const unsigned rw = *(const unsigned*)(U + (size_t)(rowS + tt - 30) * 512 + c0); v = (f32x2){__uint_as_float(rw << 16), __uint_as_float(rw & 0xffff0000u)}; }
#pragma unroll
                    for (int t = 0; t < 8; ++t) { const int kk = tt - t; if (kk >= 0 && kk <= 30) a[8 * hs + t] += w[kk] * v; }
                }
            }
        }
        float s1[16], s2[16];
#pragma unroll
        for (int t = 0; t < 16; ++t) { s1[t] = a[t].x + a[t].y; s2[t] = a[t].x * a[t].x + a[t].y * a[t].y; }
        const float r1 = reduce_scatter16(s1, lane), r2 = reduce_scatter16(s2, lane);
        if ((lane & 3) == 0) red[lane >> 2] = (f32x2){r1, r2};
        asm volatile("s_waitcnt lgkmcnt(0)" ::: "memory");
#pragma unroll
        for (int t = 0; t < 16; ++t) {
            const f32x2 st_ = red[t];
            const float mean = st_.x * (1.0f / 128.0f), var = st_.y * (1.0f / 128.0f) - mean * mean;
            const float rstd = __builtin_amdgcn_rsqf(fmaxf(var, 0.f) + EPS);
            const f32x2 y = (a[t] - mean) * rstd * lgv + lbv;
            *(unsigned*)(YAB + (size_t)(rowbase + t) * D + c0) = pk2(silu_f(y.x), silu_f(y.y));
        }
        asm volatile("s_waitcnt lgkmcnt(0)" ::: "memory");
    }
}

__device__ __forceinline__ void mix_job_state(Frame& F, int l, int s) {
    const int c = F.tid;
    const bf16_t* U = (const bf16_t*)(F.ws + WS_U); const bf16_t* BX = (const bf16_t*)(F.ws + WS_BX);
    if (s < NB_P) {
        const int b = s; float* oa = F.out + O_CAP + ((size_t)l * NB_P + b) * 30 * DA; float* ob = F.out + O_CBP + ((size_t)l * NB_P + b) * 3 * DB;
#pragma unroll 10
        for (int i = 0; i < 30; ++i) __builtin_nontemporal_store(bf2f(U[(size_t)(b * TP + TP - 30 + i) * 512 + c]), oa + i * DA + c);
#pragma unroll
        for (int i = 0; i < 3; ++i) __builtin_nontemporal_store(bf2f(BX[(size_t)(b * TP + TP - 3 + i) * 512 + c]), ob + i * DB + c);
    } else {
        const int b = s - NB_P, rowS = MP + 8 * b; float* oa = F.out + O_CAS + ((size_t)l * NB_S + b) * 30 * DA; float* ob = F.out + O_CBS + ((size_t)l * NB_S + b) * 3 * DB;
        const float* st = F.in[I_SCA] + ((size_t)l * NB_S + b) * 30 * DA;
#pragma unroll 11
        for (int i = 0; i < 22; ++i) __builtin_nontemporal_store(__builtin_nontemporal_load(st + (8 + i) * DA + c), oa + i * DA + c);
#pragma unroll
        for (int i = 22; i < 30; ++i) __builtin_nontemporal_store(bf2f(U[(size_t)(rowS + i - 22) * 512 + c]), oa + i * DA + c);
#pragma unroll
        for (int i = 0; i < 3; ++i) __builtin_nontemporal_store(bf2f(BX[(size_t)(rowS + 5 + i) * 512 + c]), ob + i * DB + c);
    }
}

__device__ __forceinline__ void mix_a_phase(Frame& F, int l, int sel) {
    if (sel & 1) mix_b_wave_jobs(F, l);
    if (!(sel & 2)) return;
    { int t_ = F.tid; asm volatile("" : "+v"(t_)); F.tid = t_; F.lane = t_ & 63; }
    mix_a_wave_jobs(F, l);
    { int t_ = F.tid; asm volatile("" : "+v"(t_)); F.tid = t_; F.lane = t_ & 63; }
    const int b = blockIdx.x;
    if (b >= 64 && b - 64 < NB_P + NB_S) mix_job_state(F, l, b - 64);
}

__device__ __forceinline__ void mix_c_phase(Frame& F, int l, int rep) {
    const int c = F.tid;
    bf16_t* YAB = (bf16_t*)(F.ws + WS_YAB); const bf16_t* PCG = (const bf16_t*)(F.ws + WS_XB); const bf16_t* GGp = (const bf16_t*)(F.ws + WS_GG);
    const f32x2* SUMM = (const f32x2*)(F.ws + WS_SUMM); const f32x2* LAST = (const f32x2*)(F.ws + WS_LAST);
    for (int job = blockIdx.x; job < NQ * 2; job += F.G) {
        const int q = job >> 1, hh = job & 1;
        if (q < NQ_P) {
            const int b = q / NCH_P, k = q - b * NCH_P, nvalid = (k == NCH_P - 1) ? 16 : 64, row0 = b * TP + 64 * k;
            if (32 * hh >= nvalid) continue;
            float carry = 0.f;
            {
                f32x2 ph[32];
#pragma unroll
                for (int e = 0; e < 32; ++e) { const int kk = e < k ? e : 0; ph[e] = SUMM[(size_t)(b * NCH_P + kk) * 512 + c]; }
#pragma unroll
                for (int e = 0; e < 32; ++e) { const float px = e < k ? ph[e].x : 1.f, py = e < k ? ph[e].y : 0.f; carry = px * carry + py; }
            }
            const int r1 = (32 * hh + 32 < nvalid) ? 32 * hh + 32 : nvalid;
            for (int r = 32 * hh; r < r1; ++r) {
                const size_t row = row0 + r;
                const float y = (bf2f(YAB[row * D + 512 + c]) + bf2f(PCG[row * 512 + c]) * carry) * bf2f(GGp[row * 512 + c]);
                if (rep) ((bf16_t*)(F.ws + WS_U))[row * 512 + c] = (bf16_t)f2bf(y); else
                YAB[row * D + 512 + c] = (bf16_t)f2bf(y);
            }
            if (k == NCH_P - 1 && hh == 0) { const f32x2 ph = SUMM[(size_t)q * 512 + c]; F.out[O_HP + ((size_t)l * NB_P + b) * DB + c] = ph.y + ph.x * carry; }
        } else {
            const int row0 = MP + 64 * (q - NQ_P);
            for (int r = 32 * hh; r < 32 * hh + 32; ++r) {
                const int s = 8 * (q - NQ_P) + (r >> 3); const size_t row = row0 + r;
                const float carry = F.in[I_SH][((size_t)l * NB_S + s) * DB + c];
                const float y = (bf2f(YAB[row * D + 512 + c]) + bf2f(PCG[row * 512 + c]) * carry) * bf2f(GGp[row * 512 + c]);
                if (rep) ((bf16_t*)(F.ws + WS_U))[row * 512 + c] = (bf16_t)f2bf(y); else
                YAB[row * D + 512 + c] = (bf16_t)f2bf(y);
                if ((r & 7) == 7) { const f32x2 ph = LAST[(size_t)s * 512 + c]; F.out[O_HS + ((size_t)l * NB_S + s) * DB + c] = ph.y + ph.x * carry; }
            }
        }
    }
}

constexpr int NPH = 18;
#ifndef PHMASK
#define PHMASK 127
#endif
#define DUPMASK 0
#define MIXSEL 1
__global__ void __launch_bounds__(NWAVES * 64, 2) mega_fwd(Args args) {
    extern __shared__ __attribute__((aligned(16))) unsigned char lds[];
    Frame F;
    F.lds = (LAS unsigned char*)lds; F.G = gridDim.x;
    if (threadIdx.x < 2) ((volatile LAS unsigned*)(F.lds + LDS_BARST))[threadIdx.x] = 0u;
    __syncthreads();
    if (args.ph_hi - args.ph_lo > 1) (void)xcd_barrier_post((unsigned*)(args.ws + WS_BAR), (volatile LAS unsigned*)(F.lds + LDS_BARST));
    const int ph_lo = args.ph_lo, ph_hi = args.ph_hi;
    const int wave_s = __builtin_amdgcn_readfirstlane(threadIdx.x >> 6);
    for (int st = 2 * ph_lo; st < 2 * ph_hi; ++st) {
        const int ph = st >> 1, rep = st & 1;
        bool run = true;
        if (rep == 1) { const int ty = (ph == 0) ? 1 : (ph == NPH - 1) ? 2 : (int)((0x0804084020100804ull >> (8 * ((ph - 1) & 7))) & 255ull);
            run = (DUPMASK & ty) != 0; }
        if (run) {
        const __attribute__((address_space(4))) unsigned char* kp = (const __attribute__((address_space(4))) unsigned char*)__builtin_amdgcn_kernarg_segment_ptr();
        asm volatile("" : "+s"(kp));
        const __attribute__((address_space(4))) Args* ap = (const __attribute__((address_space(4))) Args*)kp;
        F.in = ap->in; F.out = ap->out; F.ws = ap->ws;
        { int t_ = wave_s * 64 + hw_lane_id(); asm volatile("" : "+v"(t_)); F.tid = t_; F.lane = t_ & 63; F.wave = wave_s; }
        unsigned char* ws = F.ws;
        float* SS = (float*)(ws + WS_SS);
        if ((PHMASK & 1) && ph == 0) p0_prologue(F);
        else if ((PHMASK & 2) && ph == NPH - 1) final_phase(F);
        else {
            const int l = (ph - 1) >> 3, s = (ph - 1) & 7;
            if ((PHMASK & 4) && (s == 0 || s == 6)) {
                pg8::Gemm g{(const bf16_t*)(ws + WS_XB), (const bf16_t*)(ws + (s == 0 ? WS_WGU1 : WS_WGU2)), MPAD, 2 * FF, D};
                pg8::StaticOrder S; S.init(MPAD, 2 * FF, D, F.G, (int)blockIdx.x);
                EpiGU E{(bf16_t*)(ws + WS_ACT), SS + (size_t)(s == 0 ? 3 * l : 3 * l + 2) * MPAD};
                pg8::gemm_phase<EpiGU, pg8::StaticOrder, true, true>(F.lds, g, S, E, wave_s);
            } else if ((PHMASK & 8) && (s == 1 || s == 7 || s == 5)) {
                const bool down = (s != 5);
                pg8::Gemm g{(const bf16_t*)(ws + (down ? WS_ACT : WS_YAB)), (const bf16_t*)(ws + (s == 1 ? WS_WD1 : (s == 7 ? WS_WD2 : WS_WOUT))), MPAD, D, down ? FF : D};
                pg8::DpSplit S; S.init(MPAD, D, down ? FF : D, F.G, (int)blockIdx.x, F.out);
                EpiRes E{(float*)(ws + WS_X), (bf16_t*)(ws + WS_XB), (rep ? (float*)(ws + 0x300000) : SS + (size_t)(s == 1 ? 3 * l + 1 : (s == 5 ? 3 * l + 2 : 3 * l + 3)) * MPAD), rep ? 0.0f : (down ? 0.5f : 1.0f)};
                pg8::gemm_phase<EpiRes, pg8::DpSplit, true, true>(F.lds, g, S, E, wave_s);
                if (blockIdx.x >= 80 && rep == 0) {
                    const int gw = ((int)blockIdx.x - 80) * NWAVES + F.wave, NGW = (F.G - 80) * NWAVES;
                    if (l == 0 && s == 1) convert_mats(F, 1, 0, 1, gw, NGW);
                    else if (l == 0 && s == 7) convert_mats(F, 1, 1, 3, gw, NGW);
                    else if (l == 1 && s == 1) convert_mats(F, 1, 3, 5, gw, NGW);
                    else if (l == 1 && s == 5) convert_mats(F, 1, 5, 6, gw, NGW);
                }
                { XcdBarrier xb; xb.bar = (unsigned*)(ws + WS_BAR); xb.x = xb_xcc_id(); xb.st = (volatile LAS unsigned*)(F.lds + LDS_BARST); xcd_barrier(xb, wave_s == 0 && hw_lane_id() == 0); }
                res_fixup(F, E, S);
            } else if ((PHMASK & 16) && s == 2) {
                pg8::Gemm g{(const bf16_t*)(ws + WS_XB), (const bf16_t*)(ws + WS_WIN), MPAD, 2048, D};
                pg8::StaticOrder S; S.init(MPAD, 2048, D, F.G, (int)blockIdx.x);
                EpiWin E{(bf16_t*)(ws + WS_U), (bf16_t*)(ws + WS_BX), (bf16_t*)(ws + WS_GG), SS + (size_t)(3 * l + 1) * MPAD};
                pg8::gemm_phase<EpiWin, pg8::StaticOrder, true, true>(F.lds, g, S, E, wave_s);
            } else if ((PHMASK & 32) && s == 3) mix_a_phase(F, l, rep ? MIXSEL : 3);
            else if ((PHMASK & 64) && s == 4) mix_c_phase(F, l, rep);
        }
        }
        if (rep == 1 && ph + 1 < ph_hi) {
            const __attribute__((address_space(4))) Args* ap2 = (const __attribute__((address_space(4))) Args*)__builtin_amdgcn_kernarg_segment_ptr();
            unsigned* barw = (unsigned*)(ap2->ws + WS_BAR);
            if (ph_hi > 1000) cg::this_grid().sync();
            XcdBarrier xb; xb.bar = barw; xb.x = xb_xcc_id(); xb.st = (volatile LAS unsigned*)(F.lds + LDS_BARST);
            xcd_barrier(xb, wave_s == 0 && hw_lane_id() == 0);
        }
    }
}

#ifndef MK_FUSED
#define MK_FUSED 1
#endif
extern "C" void kernel_launch(void* const* d_in, const int* in_sizes, int n_in, void* d_out, int out_size, void* d_ws, size_t ws_size, hipStream_t stream) {
    static int grid = 0;
    if (grid == 0) {
        if (n_in != N_IN || (size_t)out_size != O_END || ws_size < WS_END) { fprintf(stderr, "kernel_launch: unexpected shapes: n_in %d out %d ws %zu (need %zu)\n", n_in, out_size, ws_size, (size_t)WS_END); grid = -1; return; }
        int dev = 0, cus = 0, per_cu = 0;
        hipGetDevice(&dev); hipDeviceGetAttribute(&cus, hipDeviceAttributeMultiprocessorCount, dev);
        if (hipFuncSetAttribute((const void*)mega_fwd, hipFuncAttributeMaxDynamicSharedMemorySize, LDS_BYTES) != hipSuccess) { fprintf(stderr, "kernel_launch: hipFuncSetAttribute failed\n"); grid = -1; return; }
        if (hipOccupancyMaxActiveBlocksPerMultiprocessor(&per_cu, (const void*)mega_fwd, NWAVES * 64, LDS_BYTES) != hipSuccess || per_cu < 1) { fprintf(stderr, "kernel_launch: occupancy query failed (%d)\n", per_cu); (void)hipGetLastError(); per_cu = 1; }
        grid = cus * 1;
        fprintf(stderr, "kernel_launch: cus %d per_cu %d grid %d ws %zu\n", cus, per_cu, grid, ws_size);
    }
    if (grid < 0) return;
    Args a{};
    for (int i = 0; i < N_IN; ++i) a.in[i] = (const float*)d_in[i];
    a.out = (float*)d_out; a.ws = (unsigned char*)d_ws;
#if MK_FUSED
    a.ph_lo = 0; a.ph_hi = NPH;
    if (hipMemsetAsync((unsigned char*)d_ws + WS_BAR, 0, 0x10000, stream) != hipSuccess) { fprintf(stderr, "kernel_launch: memset of the barrier words failed\n"); return; }
    void* kargs[] = {&a};
    hipError_t e = hipLaunchCooperativeKernel((const void*)mega_fwd, dim3(grid), dim3(NWAVES * 64), kargs, LDS_BYTES, stream);
    if (e != hipSuccess) fprintf(stderr, "cooperative launch failed: %s (grid %d)\n", hipGetErrorString(e), grid);
#else
    for (int ph = 0; ph < NPH; ++ph) { a.ph_lo = ph; a.ph_hi = ph + 1; hipLaunchKernelGGL(mega_fwd, dim3(grid), dim3(NWAVES * 64), LDS_BYTES, stream, a); }
#endif
}
```

```cpp
#include <hip/hip_runtime.h>
#include <hip/hip_cooperative_groups.h>
#include <cstdio>
#include <cstdint>
namespace cg = cooperative_groups;
__device__ __forceinline__ int hw_lane_id() { int l; asm volatile("v_mbcnt_lo_u32_b32 %0, -1, 0\n\tv_mbcnt_hi_u32_b32 %0, -1, %0" : "=v"(l)); return l; }
namespace pg8 {
#define PG8_LAS __attribute__((address_space(3)))
typedef unsigned short bf16_t;
typedef short bf16x8 __attribute__((ext_vector_type(8)));
typedef float f32x4 __attribute__((ext_vector_type(4)));
typedef unsigned u32x4 __attribute__((ext_vector_type(4)));
constexpr int BM = 256, BK = 64, HALF = 128, HTB = HALF * BK * 2  , STAGE_BYTES = 8 * HTB, NXCD = 8, WGM = 8;

__host__ __device__ __forceinline__ int lds_byte(int r, int c) { const int st = (r >> 4) * 2 + (c >> 5), rr = r & 15, cc = c & 31, ob = rr * 64 + cc * 2; return st * 1024 + (ob ^ (((ob >> 9) & 1) << 5)); }
__host__ __device__ __forceinline__ void stage_rc(int b, int& R, int& C) { const int st = b / 1024, sb = b % 1024, swz = sb ^ (((sb >> 9) & 1) << 5); R = (st >> 1) * 16 + swz / 64; C = (st & 1) * 32 + (swz % 64) / 2; }
__host__ __device__ __forceinline__ int perm32(int rho) { const int n = rho >> 4, i = rho & 15; return 8 * (i >> 2) + 4 * n + (i & 3); }

struct Unit { int pm, pn, k0, len, kind; };
struct Gemm { const bf16_t* A; const bf16_t* Bt; int M, N, K; };

struct StaticOrder {
    static constexpr bool STREAMK = false;
    int nM, nN, nwg, G, c, nt;
    __host__ __device__ void init(int M, int N, int K, int G_, int c_) { nM = M / BM; nN = N / BM; nwg = nM * nN; G = G_; c = c_; nt = K / BK; }
    __host__ __device__ bool next(int i, Unit& u) const {
        const long L = (long)i * G + c; if (L >= nwg) return false;
        int wgid = (int)L; { const int q = nwg / NXCD, r = nwg % NXCD, xcd = wgid % NXCD, off = wgid / NXCD; wgid = (xcd < r ? xcd * (q + 1) : r * (q + 1) + (xcd - r) * q) + off; }
        const int nig = WGM * nN, gid = wgid / nig, fm = gid * WGM, gsz = (nM - fm) < WGM ? (nM - fm) : WGM;
        u.pm = fm + ((wgid % nig) % gsz); u.pn = (wgid % nig) / gsz; u.k0 = 0; u.len = nt; u.kind = 0; return true;
    }
    __device__ __forceinline__ void a_ready(const Unit&) const {}
    __device__ __forceinline__ void done(const Unit&) const {}
    __device__ __forceinline__ void store_partial(const f32x4 (&)[2][2][4][2], int, int, int) const {}
    __device__ __forceinline__ void load_partial(f32x4 (&)[2][2][4][2], int, int, int) const {}
};
struct DpSplit {
    static constexpr bool STREAMK = true;
    int nM, nN, nwg, G, c, nt; float* slab;
    __device__ __forceinline__ void init(int M, int N, int K, int G_, int c_, float* slab_) { nM = M / BM; nN = N / BM; nwg = nM * nN; G = G_; c = c_; nt = K / BK; slab = slab_; }
    __device__ __forceinline__ void unit_of(int L, Unit& u) const {
        int wgid = L; { const int q = nwg / NXCD, r = nwg % NXCD, xcd = wgid % NXCD, off = wgid / NXCD; wgid = (xcd < r ? xcd * (q + 1) : r * (q + 1) + (xcd - r) * q) + off; }
        const int nig = WGM * nN, gid = wgid / nig, fm = gid * WGM, gsz = (nM - fm) < WGM ? (nM - fm) : WGM;
        u.pm = fm + ((wgid % nig) % gsz); u.pn = (wgid % nig) / gsz;
    }
    __device__ __forceinline__ bool next(int i, Unit& u) const {
        if (i == 0) { if (c >= nwg) return false; unit_of(c, u); u.k0 = 0; u.len = nt; u.kind = 0; return true; }
        if (i == 1 && c < 4 * (nwg - G)) {
            unit_of(G + (c >> 2), u);
            const int part = c & 3, lenp = (nt >> 2) & ~1, rem2 = (nt - 4 * lenp) >> 1;
            u.len = lenp + (part < rem2 ? 2 : 0); u.k0 = part * lenp + 2 * (part < rem2 ? part : rem2); u.kind = 1; return true;
        }
        return false;
    }
    __device__ __forceinline__ void a_ready(const Unit&) const {}
    __device__ __forceinline__ void done(const Unit&) const {}
    __device__ __forceinline__ void store_partial(const f32x4 (&acc)[2][2][4][2], int tid, int wid, int lane) const {
        typedef unsigned u32x4v __attribute__((ext_vector_type(4)));
        asm volatile("" : "+v"(tid));
        const __amdgpu_buffer_rsrc_t r = __builtin_amdgcn_make_buffer_rsrc((void*)(slab + (size_t)c * 65536), 0, 262144, 0x00020000);
        const int vo = tid * 16;
#pragma unroll
        for (int ai = 0; ai < 2; ++ai)
#pragma unroll
            for (int bj = 0; bj < 2; ++bj)
#pragma unroll
                for (int m = 0; m < 4; ++m)
#pragma unroll
                    for (int n = 0; n < 2; ++n) __builtin_amdgcn_raw_buffer_store_b128(__builtin_bit_cast(u32x4v, acc[ai][bj][m][n]), r, vo, (((ai * 2 + bj) * 4 + m) * 2 + n) * 8192, 16);
    }
    __device__ __forceinline__ void load_partial(f32x4 (&)[2][2][4][2], int, int, int) const {}
};

template <class Epi, class Sched, bool ALIGN_EPI = false, bool SP2 = false>
__device__ __forceinline__ void gemm_phase(PG8_LAS unsigned char* lds, const Gemm g, const Sched& S, const Epi& E, const int wave_s) {
    int tid_l = wave_s * 64 + hw_lane_id(); asm volatile("" : "+v"(tid_l));
    const int tid = tid_l, wid = __builtin_amdgcn_readfirstlane(tid >> 6), lane = tid & 63, wr = wid >> 2, wc = wid & 3, fr = lane & 15, fq = lane >> 4;
    const int K = g.K, nt = K / BK;
    unsigned voffA[2], voffB[2];
#pragma unroll
    for (int i = 0; i < 2; ++i) { int R, C; stage_rc(tid * 16 + i * 8192, R, C); const int Rb = Epi::PERM ? ((R & ~31) + perm32(R & 31)) : R;
        voffA[i] = (unsigned)(R * K + C) * 2u; voffB[i] = (unsigned)(Rb * K + C) * 2u; }
    const size_t kstep = (size_t)(BK * 2);
    const size_t hstep = (size_t)HALF * K * 2;
    const size_t tstep = 2 * hstep;
    const unsigned ldsw = (unsigned)wid * 1024u;
    const int aoff = lds_byte(wr * 64 + fr, fq * 8), boff = lds_byte(wc * 32 + fr, fq * 8);
#define PG8_SA(b, h) (((b) * 2 + (h)) * HTB)
#define PG8_SB(b, h) ((4 + (b) * 2 + (h)) * HTB)
#define PG8_STAGE(bufoff, gbase, voff) do { _Pragma("unroll") for (int _i = 0; _i < 2; ++_i) \
        __builtin_amdgcn_global_load_lds((const unsigned*)((const char*)(gbase) + (voff)[_i]), (PG8_LAS unsigned*)(lds + (bufoff) + ldsw + _i * 8192), 16, 0, 0); } while (0)
#define PG8_LDA(dst, b, h) do { _Pragma("unroll") for (int m = 0; m < 4; ++m) _Pragma("unroll") for (int k = 0; k < 2; ++k) dst[m][k] = *(const PG8_LAS bf16x8*)(lds + PG8_SA(b, h) + aoff + m * 2048 + k * 1024); } while (0)
#define PG8_LDB(dst, b, h) do { _Pragma("unroll") for (int n = 0; n < 2; ++n) _Pragma("unroll") for (int k = 0; k < 2; ++k) dst[n][k] = *(const PG8_LAS bf16x8*)(lds + PG8_SB(b, h) + boff + n * 2048 + k * 1024); } while (0)
#define PG8_MMA(ai, bj, At, Bt) do { __builtin_amdgcn_s_setprio(1); _Pragma("unroll") for (int m = 0; m < 4; ++m) _Pragma("unroll") for (int n = 0; n < 2; ++n) _Pragma("unroll") for (int k = 0; k < 2; ++k) \
        acc[ai][bj][m][n] = __builtin_amdgcn_mfma_f32_16x16x32_bf16(Bt[n][k], At[m][k], acc[ai][bj][m][n], 0, 0, 0); __builtin_amdgcn_s_setprio(0); } while (0)
#define PG8_WAIT_V(n) asm volatile("s_waitcnt vmcnt(" #n ")" ::: "memory")
#define PG8_WAIT_L(n) asm volatile("s_waitcnt lgkmcnt(" #n ")" ::: "memory")
#define PG8_BAR __builtin_amdgcn_s_barrier()
#define PG8_SCHED __builtin_amdgcn_sched_barrier(0)
    Unit cur, nxt; int ui = 0;
    if (!S.next(0, cur)) return;
    f32x4 acc[2][2][4][2];
#pragma unroll
    for (int a = 0; a < 2; ++a)
#pragma unroll
        for (int b = 0; b < 2; ++b)
#pragma unroll
            for (int m = 0; m < 4; ++m)
#pragma unroll
                for (int n = 0; n < 2; ++n) acc[a][b][m][n] = (f32x4){0.f, 0.f, 0.f, 0.f};
    if (Sched::STREAMK && cur.kind == 2) S.load_partial(acc, tid, wid, lane);
    if constexpr (Epi::INIT_ACC) { if (cur.kind == 0) E.init(acc, cur, wr, wc, fr, fq); }
    bf16x8 At[4][2], B0[2][2], B1[2][2];
    const char* cA = (const char*)g.A + (size_t)cur.pm * tstep + (size_t)cur.k0 * kstep; const char* cB = (const char*)g.Bt + (size_t)cur.pn * tstep + (size_t)cur.k0 * kstep;
    S.a_ready(cur);
    if constexpr (SP2) {
        PG8_STAGE(PG8_SB(0, 0), cB, voffB); PG8_STAGE(PG8_SB(0, 1), cB + hstep, voffB); PG8_STAGE(PG8_SA(0, 0), cA, voffA); PG8_STAGE(PG8_SA(0, 1), cA + hstep, voffA);
        if (wr == 1) PG8_BAR;
        PG8_WAIT_V(2); PG8_BAR;
        PG8_STAGE(PG8_SB(1, 0), cB + kstep, voffB); PG8_STAGE(PG8_SA(1, 0), cA + kstep, voffA); PG8_STAGE(PG8_SB(1, 1), cB + hstep + kstep, voffB);
        PG8_WAIT_V(6); PG8_BAR;
    } else {
        PG8_STAGE(PG8_SB(0, 0), cB, voffB); PG8_STAGE(PG8_SA(0, 0), cA, voffA); PG8_STAGE(PG8_SB(0, 1), cB + hstep, voffB); PG8_STAGE(PG8_SA(0, 1), cA + hstep, voffA);
        if (wr == 1) PG8_BAR;
        PG8_WAIT_V(4); PG8_BAR;
        PG8_STAGE(PG8_SB(1, 0), cB + kstep, voffB); PG8_STAGE(PG8_SA(1, 0), cA + kstep, voffA); PG8_STAGE(PG8_SB(1, 1), cB + hstep + kstep, voffB);
        PG8_WAIT_V(6); PG8_BAR;
    }
    for (;;) {
        const bool has_next = S.next(ui + 1, nxt);
        const char* nA = has_next ? (const char*)g.A + (size_t)nxt.pm * tstep + (size_t)nxt.k0 * kstep : cA; const char* nB = has_next ? (const char*)g.Bt + (size_t)nxt.pn * tstep + (size_t)nxt.k0 * kstep : cB;
        const int clen = cur.len;
        for (int t = 0; t < clen; t += 2) {
            const bool last = (t == clen - 2);
            const char* a1 = cA + (size_t)(t + 1) * kstep;
            const char* a2 = last ? nA : cA + (size_t)(t + 2) * kstep; const char* b2 = last ? nB : cB + (size_t)(t + 2) * kstep;
            const char* a3 = a2 + kstep; const char* b3 = b2 + kstep;
            if (last && has_next) S.a_ready(nxt);
            if constexpr (SP2) {
            PG8_LDB(B0, 0, 0); PG8_LDB(B1, 0, 1); PG8_SCHED; PG8_LDA(At, 0, 0); PG8_STAGE(PG8_SA(1, 1), a1 + hstep, voffA);
            PG8_WAIT_V(8); PG8_WAIT_L(0); PG8_BAR; PG8_MMA(0, 0, At, B0); PG8_MMA(0, 1, At, B1); PG8_BAR; PG8_SCHED;
            PG8_LDA(At, 0, 1); PG8_STAGE(PG8_SB(0, 0), b2, voffB); PG8_STAGE(PG8_SB(0, 1), b2 + hstep, voffB); PG8_STAGE(PG8_SA(0, 0), a2, voffA);
            PG8_WAIT_V(8); PG8_WAIT_L(0); PG8_BAR; PG8_MMA(1, 0, At, B0); PG8_MMA(1, 1, At, B1); PG8_BAR; PG8_SCHED;
            PG8_LDB(B0, 1, 0); PG8_LDB(B1, 1, 1); PG8_SCHED; PG8_LDA(At, 1, 0); PG8_STAGE(PG8_SA(0, 1), a2 + hstep, voffA);
            PG8_WAIT_V(8); PG8_WAIT_L(0); PG8_BAR; PG8_MMA(0, 0, At, B0); PG8_MMA(0, 1, At, B1); PG8_BAR; PG8_SCHED;
            PG8_LDA(At, 1, 1); PG8_STAGE(PG8_SB(1, 0), b3, voffB); PG8_STAGE(PG8_SB(1, 1), b3 + hstep, voffB); PG8_STAGE(PG8_SA(1, 0), a3, voffA);
            PG8_WAIT_V(8); PG8_WAIT_L(0); PG8_BAR; PG8_MMA(1, 0, At, B0); PG8_MMA(1, 1, At, B1); PG8_BAR; PG8_SCHED;
            } else {
            PG8_LDB(B0, 0, 0); PG8_SCHED; PG8_LDA(At, 0, 0); PG8_STAGE(PG8_SA(1, 1), a1 + hstep, voffA);
            PG8_WAIT_L(8); PG8_BAR; PG8_WAIT_L(0); PG8_MMA(0, 0, At, B0); PG8_BAR; PG8_SCHED;
            PG8_LDB(B1, 0, 1); PG8_STAGE(PG8_SB(0, 0), b2, voffB);
            PG8_BAR; PG8_WAIT_L(0); PG8_MMA(0, 1, At, B1); PG8_BAR;
            PG8_LDA(At, 0, 1); PG8_STAGE(PG8_SA(0, 0), a2, voffA);
            PG8_BAR; PG8_WAIT_L(0); PG8_MMA(1, 0, At, B0); PG8_BAR; PG8_SCHED;
            PG8_STAGE(PG8_SB(0, 1), b2 + hstep, voffB);
            PG8_WAIT_V(6); PG8_BAR; PG8_MMA(1, 1, At, B1); PG8_BAR;
            PG8_LDB(B0, 1, 0); PG8_SCHED; PG8_LDA(At, 1, 0); PG8_STAGE(PG8_SA(0, 1), a2 + hstep, voffA);
            PG8_WAIT_L(8); PG8_BAR; PG8_WAIT_L(0); PG8_MMA(0, 0, At, B0); PG8_BAR; PG8_SCHED;
            PG8_LDB(B1, 1, 1); PG8_STAGE(PG8_SB(1, 0), b3, voffB);
            PG8_BAR; PG8_WAIT_L(0); PG8_MMA(0, 1, At, B1); PG8_BAR;
            PG8_LDA(At, 1, 1); PG8_STAGE(PG8_SA(1, 0), a3, voffA);
            PG8_BAR; PG8_WAIT_L(0); PG8_MMA(1, 0, At, B0); PG8_BAR; PG8_SCHED;
            PG8_STAGE(PG8_SB(1, 1), b3 + hstep, voffB);
            PG8_WAIT_V(6); PG8_BAR; PG8_MMA(1, 1, At, B1); PG8_BAR;
            }
        }
        if constexpr (ALIGN_EPI) { if (wr == 0) PG8_BAR; }
        if constexpr (!Epi::AFTER_DRAIN) {
            int fr_l = fr, fq_l = fq; asm volatile("" : "+v"(fr_l), "+v"(fq_l));
            if constexpr (Sched::STREAMK) {
                if (cur.kind == 1) S.store_partial(acc, tid, wid, lane);
                else E(acc, cur, wr, wc, fr_l, fq_l);
            } else E(acc, cur, wr, wc, fr_l, fq_l);
            S.done(cur); }
        if (!has_next) break;
#define PG8_ZERO_ACC() do { _Pragma("unroll") for (int a = 0; a < 2; ++a) _Pragma("unroll") for (int b = 0; b < 2; ++b) _Pragma("unroll") for (int m = 0; m < 4; ++m) _Pragma("unroll") for (int n = 0; n < 2; ++n) acc[a][b][m][n] = (f32x4){0.f, 0.f, 0.f, 0.f}; } while (0)
        if constexpr (Epi::INIT_ACC) {
            if (Sched::STREAMK && nxt.kind == 2) S.load_partial(acc, tid, wid, lane);
            else if (nxt.kind == 0) { int fr_i = fr, fq_i = fq; asm volatile("" : "+v"(fr_i), "+v"(fq_i)); E.init(acc, nxt, wr, wc, fr_i, fq_i); }
            else PG8_ZERO_ACC();
        } else {
            if (Sched::STREAMK && nxt.kind == 2) S.load_partial(acc, tid, wid, lane);
            else PG8_ZERO_ACC();
        }
#undef PG8_ZERO_ACC
        cur = nxt; cA = nA; cB = nB; ++ui;
        if constexpr (ALIGN_EPI) { if (wr == 1) PG8_BAR; }
    }
    PG8_WAIT_V(0);
    if constexpr (!ALIGN_EPI) { if (wr == 0) PG8_BAR; }
    PG8_BAR;
    if constexpr (Epi::AFTER_DRAIN) { E.fused(acc, cur, wr, wc, fr, fq, lds, wid, lane); S.done(cur); }
#undef PG8_SA
#undef PG8_SB
#undef PG8_STAGE
#undef PG8_LDA
#undef PG8_LDB
#undef PG8_MMA
#undef PG8_WAIT_V
#undef PG8_WAIT_L
#undef PG8_BAR
#undef PG8_SCHED
}
}

#define LAS __attribute__((address_space(3)))
typedef unsigned short bf16_t;
typedef float f32x4 __attribute__((ext_vector_type(4)));
typedef float f32x2 __attribute__((ext_vector_type(2)));
typedef unsigned u32x4 __attribute__((ext_vector_type(4)));
typedef unsigned u32x2 __attribute__((ext_vector_type(2)));

constexpr int D = 1024, FF = 2816, DA = 512, DB = 512;
constexpr int NB_P = 8, TP = 2064, NB_S = 128, TS = 8, NMETA = 16, SEQ = 2048;
constexpr int MP = NB_P * TP;
constexpr int MR = MP + NB_S * TS;
constexpr int MPAD = 17664;
constexpr int NCH_P = 33;
constexpr int NQ_P = NB_P * NCH_P;
constexpr int NQ_S = (NB_S * TS) / 64;
constexpr int NQ = NQ_P + NQ_S;
constexpr float EPS = 1e-6f;
constexpr int NWAVES = 8;

enum { I_XP = 0, I_XS, I_SCA, I_SCB, I_SH, I_META, I_GF1, I_W1G, I_W1U, I_W1D, I_GMIX, I_WIN, I_CAW, I_CAB, I_LNG, I_LNB, I_CBW, I_CBB,
       I_WRG, I_BRG, I_WIG, I_BIG, I_LAM, I_WOUT, I_GF2, I_W2G, I_W2U, I_W2D, I_GFIN, N_IN };
constexpr size_t O_YP = 0, O_YS = O_YP + (size_t)NB_P * SEQ * D, O_CAP = O_YS + (size_t)NB_S * TS * D, O_CBP = O_CAP + (size_t)2 * NB_P * 30 * DA,
                 O_HP = O_CBP + (size_t)2 * NB_P * 3 * DB, O_CAS = O_HP + (size_t)2 * NB_P * DB, O_CBS = O_CAS + (size_t)2 * NB_S * 30 * DA,
                 O_HS = O_CBS + (size_t)2 * NB_S * 3 * DB, O_END = O_HS + (size_t)2 * NB_S * DB;

constexpr size_t WS_SS = 0;
constexpr size_t WS_SUMM = 0x80000;
constexpr size_t WS_LAST = 0x1A0000;
constexpr size_t WS_W = 0x400000;
constexpr size_t SZ_WGU = (size_t)2 * FF * D * 2, SZ_WD = (size_t)D * FF * 2, SZ_WIN = (size_t)2048 * D * 2, SZ_WOUT = (size_t)D * D * 2;
constexpr size_t WS_WGU1 = WS_W, WS_WD1 = WS_WGU1 + SZ_WGU, WS_WIN = WS_WD1 + SZ_WD, WS_WOUT = WS_WIN + SZ_WIN, WS_WGU2 = WS_WOUT + SZ_WOUT, WS_WD2 = WS_WGU2 + SZ_WGU;
constexpr size_t WS_X = WS_WD2 + SZ_WD;
constexpr size_t WS_XB = WS_X + (size_t)MPAD * D * 4;
constexpr size_t WS_ACT = WS_XB + (size_t)MPAD * D * 2;
constexpr size_t WS_U = WS_ACT, WS_BX = WS_U + (size_t)MPAD * 512 * 2, WS_GG = WS_BX + (size_t)MPAD * 512 * 2, WS_YAB = WS_GG + (size_t)MPAD * 512 * 2;
constexpr size_t WS_END = WS_ACT + (size_t)MPAD * FF * 2;
static_assert(WS_YAB + (size_t)MPAD * D * 2 <= WS_END, "mixer overlay fits");
static_assert(WS_END <= 268435456, "ws map fits 256 MiB");
static_assert(WS_SS + 7 * (size_t)MPAD * 4 <= WS_SUMM && WS_SUMM + (size_t)NQ * 512 * 8 <= WS_LAST && WS_LAST + (size_t)128 * 512 * 8 <= WS_W, "small buffers");

constexpr int LDS_BYTES = 147456;

__device__ __forceinline__ float bf2f(bf16_t b) { return __uint_as_float(((unsigned)b) << 16); }
__device__ __forceinline__ unsigned pk2(float lo, float hi) { unsigned r; asm("v_cvt_pk_bf16_f32 %0, %1, %2" : "=v"(r) : "v"(lo), "v"(hi)); return r; }
__device__ __forceinline__ unsigned f2bf(float f) { return pk2(f, f) & 0xffffu; }
__device__ __forceinline__ float fast_rcp(float x) { return __builtin_amdgcn_rcpf(x); }
__device__ __forceinline__ float sigmoid_f(float x) { return fast_rcp(1.0f + __expf(-x)); }
__device__ __forceinline__ float silu_f(float x) { return x * sigmoid_f(x); }
__device__ __forceinline__ float gelu_tanh_f(float x) {
    const float u = 0.7978845608028654f * (x + 0.044715f * x * x * x);
    return x * sigmoid_f(2.0f * u);
}
__device__ __forceinline__ float neg_expm1_f(float x) {
    const float p = -x * (1.0f + x * (0.5f + x * (0.16666667f + x * (0.041666668f + x * (0.0083333338f + x * (0.0013888889f + x * 0.0001984127f))))));
    const float q = 1.0f - __expf(x);
    return x > -0.35f ? p : q;
}
__device__ __forceinline__ float wave_sum(float v) {
#pragma unroll
    for (int o = 1; o < 64; o <<= 1) v += __shfl_xor(v, o);
    return v;
}

#define XB_TMO      128
#define XB_XCNT(j)  (256  + 64 * (j))
#define XB_XSUB(j)  (1280 + 64 * (j))
#define XB_XGEN(j)  (2304 + 64 * (j))
#define XB_TOP      3328
#define XB_TOPGEN   3392
#define XCD_BAR_WORDS 3456
#define XB_SPIN_CAP (1u << 18)

__device__ __forceinline__ unsigned xb_ld(unsigned* p)              { return __hip_atomic_load(p, __ATOMIC_RELAXED, __HIP_MEMORY_SCOPE_AGENT); }
__device__ __forceinline__ unsigned xb_add(unsigned* p, unsigned v) { return __hip_atomic_fetch_add(p, v, __ATOMIC_RELAXED, __HIP_MEMORY_SCOPE_AGENT); }
__device__ __forceinline__ unsigned xb_xcc_id() { return (unsigned)__builtin_amdgcn_s_getreg((3 << 11) | 20) & 0xFu; }
#define XB_SPIN(cond, bar) do { unsigned _sp = 0; while (cond) { __builtin_amdgcn_s_sleep(1); \
    if ((++_sp & 255u) == 0u) { if (xb_ld(&(bar)[XB_TMO])) break; if (_sp > XB_SPIN_CAP) { atomicAdd(&(bar)[XB_TMO], 1u); break; } } } } while (0)

struct XcdBarrier {
    unsigned* bar; unsigned x;
    volatile LAS unsigned* st;
};

__device__ __forceinline__ XcdBarrier xcd_barrier_post(unsigned* bar, volatile LAS unsigned* st) {
    XcdBarrier b; b.bar = bar; b.x = xb_xcc_id(); b.st = st;
    if (threadIdx.x == 0) (void)xb_add(&bar[XB_XCNT(b.x)], 1u);
    return b;
}
__device__ __forceinline__ void xcd_barrier_complete(unsigned* bar, unsigned x, unsigned& nloc, unsigned& nx) {
    const unsigned G = gridDim.x * gridDim.y * gridDim.z;
    unsigned sum, cnt, mine, sp = 0u;
    for (;;) {
        sum = 0u; cnt = 0u; mine = 0u;
#pragma unroll
        for (unsigned j = 0; j < 16; ++j) { const unsigned c = xb_ld(&bar[XB_XCNT(j)]); sum += c; cnt += (c > 0u) ? 1u : 0u; mine = (j == x) ? c : mine; }
        if (sum == G) break;
        __builtin_amdgcn_s_sleep(1);
        if ((++sp & 255u) == 0u) { if (xb_ld(&bar[XB_TMO])) break; if (sp > XB_SPIN_CAP) { atomicAdd(&bar[XB_TMO], 1u); break; } }
    }
    nloc = mine > 0u ? mine : 1u; nx = cnt > 0u ? cnt : 1u;
}

__device__ __forceinline__ void xcd_barrier(const XcdBarrier& b, const bool is_t0) {
    asm volatile("s_waitcnt vmcnt(0)" ::: "memory");
    __syncthreads();
    if (is_t0) {
        unsigned* bar = b.bar;
        __builtin_amdgcn_s_waitcnt(0);
        unsigned nloc = b.st[0], nx = b.st[1];
        if (nloc == 0u) { xcd_barrier_complete(bar, b.x, nloc, nx); b.st[0] = nloc; b.st[1] = nx; }
        const unsigned old = xb_add(&bar[XB_XSUB(b.x)], 1u);
        const unsigned gen = old / nloc;
        if (old + 1u == (gen + 1u) * nloc) {
            __builtin_amdgcn_fence(__ATOMIC_RELEASE, "agent");
            asm volatile("s_waitcnt vmcnt(0)" ::: "memory");
            const unsigned og = xb_add(&bar[XB_TOP], 1u);
            const unsigned tg = og / nx;
            if (og + 1u == (tg + 1u) * nx) xb_add(&bar[XB_TOPGEN], 1u);
            else XB_SPIN(xb_ld(&bar[XB_TOPGEN]) == tg, bar);
            __builtin_amdgcn_fence(__ATOMIC_ACQUIRE, "agent");
            xb_add(&bar[XB_XGEN(b.x)], 1u);
            asm volatile("s_waitcnt vmcnt(0)" ::: "memory");
        } else {
            XB_SPIN(xb_ld(&bar[XB_XGEN(b.x)]) == gen, bar);
            __builtin_amdgcn_fence(__ATOMIC_ACQUIRE, "agent");
            asm volatile("s_waitcnt vmcnt(0)" ::: "memory");
        }
    }
    __syncthreads();
}

constexpr size_t WS_BAR = 0x380000;
constexpr int LDS_BARST = 139264;
constexpr size_t WS_SKF = 0x390000;

struct EpiGU {
    static constexpr bool PERM = true, AFTER_DRAIN = false, INIT_ACC = false;
    bf16_t* ACT; const float* ss;
    __device__ __forceinline__ void operator()(const f32x4 (&acc)[2][2][4][2], const pg8::Unit& u, int wr, int wc, int fr, int fq) const {
        const int row0 = u.pm * 256 + wr * 64 + fr, col0 = u.pn * 128 + wc * 32 + 8 * fq;
        float rs[2][4];
#pragma unroll
        for (int ai = 0; ai < 2; ++ai)
#pragma unroll
            for (int m = 0; m < 4; ++m) rs[ai][m] = ss[row0 + ai * 128 + m * 16];
#pragma unroll
        for (int ai = 0; ai < 2; ++ai)
#pragma unroll
            for (int m = 0; m < 4; ++m) {
                const int r = row0 + ai * 128 + m * 16;
                const float rstd = __builtin_amdgcn_rsqf(rs[ai][m] * (1.0f / D) + EPS);
                float o[8];
#pragma unroll
                for (int n = 0; n < 2; ++n)
#pragma unroll
                    for (int e = 0; e < 4; ++e) { const float g = acc[ai][0][m][n][e] * rstd, up = acc[ai][1][m][n][e] * rstd; o[4 * n + e] = silu_f(g) * up; }
                u32x4 w; w.x = pk2(o[0], o[1]); w.y = pk2(o[2], o[3]); w.z = pk2(o[4], o[5]); w.w = pk2(o[6], o[7]);
                *(u32x4*)(ACT + (size_t)r * FF + col0) = w;
            }
    }
};
struct EpiRes {
    static constexpr bool PERM = true, AFTER_DRAIN = false, INIT_ACC = true;
    float* X; bf16_t* XB; float* ssn; float scale;
    __device__ __forceinline__ void init(f32x4 (&acc)[2][2][4][2], const pg8::Unit& u, int wr, int wc, int fr, int fq) const {
        const int row0 = u.pm * 256 + wr * 64 + fr, col0 = u.pn * 256 + wc * 32 + 8 * fq; const float inv = 1.0f / scale;
#pragma unroll
        for (int ai = 0; ai < 2; ++ai)
#pragma unroll
            for (int m = 0; m < 4; ++m)
#pragma unroll
                for (int bj = 0; bj < 2; ++bj) { const float* xp = X + (size_t)(row0 + ai * 128 + m * 16) * D + col0 + bj * 128; acc[ai][bj][m][0] = *(const f32x4*)xp * inv; acc[ai][bj][m][1] = *(const f32x4*)(xp + 4) * inv; }
    }
    __device__ __forceinline__ void operator()(const f32x4 (&acc)[2][2][4][2], const pg8::Unit& u, int wr, int wc, int fr, int fq) const {
        const int row0 = u.pm * 256 + wr * 64 + fr, col0 = u.pn * 256 + wc * 32 + 8 * fq;
#pragma unroll
        for (int ai = 0; ai < 2; ++ai)
#pragma unroll
            for (int m = 0; m < 4; ++m) {
                const int r = row0 + ai * 128 + m * 16; float q = 0.f;
#pragma unroll
                for (int bj = 0; bj < 2; ++bj) {
                    float* xp = X + (size_t)r * D + col0 + bj * 128;
                    const f32x4 v0 = acc[ai][bj][m][0] * scale, v1 = acc[ai][bj][m][1] * scale;
                    *(f32x4*)xp = v0; *(f32x4*)(xp + 4) = v1;
                    u32x4 w; w.x = pk2(v0[0], v0[1]); w.y = pk2(v0[2], v0[3]); w.z = pk2(v1[0], v1[1]); w.w = pk2(v1[2], v1[3]);
                    *(u32x4*)(XB + (size_t)r * D + col0 + bj * 128) = w;
                    q += (v0[0] * v0[0] + v0[1] * v0[1]) + (v0[2] * v0[2] + v0[3] * v0[3]) + (v1[0] * v1[0] + v1[1] * v1[1]) + (v1[2] * v1[2] + v1[3] * v1[3]);
                }
                q += __shfl_xor(q, 16); q += __shfl_xor(q, 32);
                if (fq == 0) atomicAdd(ssn + r, q);
            }
    }
};
struct EpiWin {
    static constexpr bool PERM = true, AFTER_DRAIN = false, INIT_ACC = false;
    bf16_t *U, *BX, *GG; const float* ss;
    __device__ __forceinline__ void operator()(const f32x4 (&acc)[2][2][4][2], const pg8::Unit& u, int wr, int wc, int fr, int fq) const {
        const int row0 = u.pm * 256 + wr * 64 + fr, col0 = (u.pn & 3) * 128 + wc * 32 + 8 * fq;
        const bool isA = u.pn < 4;
        float rs[2][4];
#pragma unroll
        for (int ai = 0; ai < 2; ++ai)
#pragma unroll
            for (int m = 0; m < 4; ++m) rs[ai][m] = ss[row0 + ai * 128 + m * 16];
#pragma unroll
        for (int ai = 0; ai < 2; ++ai)
#pragma unroll
            for (int m = 0; m < 4; ++m) {
                const int r = row0 + ai * 128 + m * 16;
                const float rstd = __builtin_amdgcn_rsqf(rs[ai][m] * (1.0f / D) + EPS);
                float a0[8], a1[8];
#pragma unroll
                for (int n = 0; n < 2; ++n)
#pragma unroll
                    for (int e = 0; e < 4; ++e) { a0[4 * n + e] = acc[ai][0][m][n][e] * rstd; a1[4 * n + e] = acc[ai][1][m][n][e] * rstd; }
                if (isA) {
                    float o[8];
#pragma unroll
                    for (int e = 0; e < 8; ++e) o[e] = a0[e] * sigmoid_f(a1[e]);
                    u32x4 w; w.x = pk2(o[0], o[1]); w.y = pk2(o[2], o[3]); w.z = pk2(o[4], o[5]); w.w = pk2(o[6], o[7]);
                    *(u32x4*)(U + (size_t)r * 512 + col0) = w;
                } else {
                    float o[8];
#pragma unroll
                    for (int e = 0; e < 8; ++e) o[e] = gelu_tanh_f(a1[e]);
                    u32x4 w; w.x = pk2(a0[0], a0[1]); w.y = pk2(a0[2], a0[3]); w.z = pk2(a0[4], a0[5]); w.w = pk2(a0[6], a0[7]);
                    *(u32x4*)(BX + (size_t)r * 512 + col0) = w;
                    u32x4 g; g.x = pk2(o[0], o[1]); g.y = pk2(o[2], o[3]); g.z = pk2(o[4], o[5]); g.w = pk2(o[6], o[7]);
                    *(u32x4*)(GG + (size_t)r * 512 + col0) = g;
                }
            }
    }
};

struct Args { const float* in[N_IN]; float* out; unsigned char* ws; int ph_lo, ph_hi; };
struct Frame {
    LAS unsigned char* lds;
    int tid, lane, wave, G;
    const float* const __attribute__((address_space(4)))* in; float* out; unsigned char* ws;
};
#define LDS_WAIT() asm volatile("s_waitcnt lgkmcnt(0)" ::: "memory")

template <class FrameT>
__device__ __forceinline__ void res_fixup(FrameT& F, const EpiRes& E, const pg8::DpSplit& S) {
    const int nleft = S.nwg - S.G, tid = F.tid, wid = tid >> 6, lane = tid & 63, wr = wid >> 2, wc = wid & 3, fr = lane & 15, fq = lane >> 4;
    for (int item = blockIdx.x; item < nleft * 8; item += F.G) {
        const int j = item >> 3, ai = (item >> 2) & 1, m = item & 3;
        pg8::Unit u; S.unit_of(S.G + j, u);
        const int r = u.pm * 256 + wr * 64 + fr + ai * 128 + m * 16, col0 = u.pn * 256 + wc * 32 + 8 * fq;
        float q = 0.f;
#pragma unroll
        for (int bj = 0; bj < 2; ++bj) {
            f32x4 a0 = {0.f, 0.f, 0.f, 0.f}, a1 = {0.f, 0.f, 0.f, 0.f};
#pragma unroll
            for (int p = 0; p < 4; ++p) {
                const float* sp = S.slab + (size_t)(4 * j + p) * 65536 + (size_t)((((ai * 2 + bj) * 4 + m) * 2) * 2048) + tid * 4;
                a0 += __builtin_nontemporal_load((const f32x4*)sp); a1 += __builtin_nontemporal_load((const f32x4*)(sp + 2048));
            }
            float* xp = E.X + (size_t)r * D + col0 + bj * 128;
            f32x4 v0 = *(f32x4*)xp, v1 = *(f32x4*)(xp + 4);
            v0 = v0 + a0 * E.scale; v1 = v1 + a1 * E.scale;
            *(f32x4*)xp = v0; *(f32x4*)(xp + 4) = v1;
            u32x4 w; w.x = pk2(v0[0], v0[1]); w.y = pk2(v0[2], v0[3]); w.z = pk2(v1[0], v1[1]); w.w = pk2(v1[2], v1[3]);
            *(u32x4*)(E.XB + (size_t)r * D + col0 + bj * 128) = w;
            q += (v0[0] * v0[0] + v0[1] * v0[1]) + (v0[2] * v0[2] + v0[3] * v0[3]) + (v1[0] * v1[0] + v1[1] * v1[1]) + (v1[2] * v1[2] + v1[3] * v1[3]);
        }
        q += __shfl_xor(q, 16); q += __shfl_xor(q, 32);
        if (fq == 0) atomicAdd(E.ssn + r, q);
    }
}


__device__ __forceinline__ void transpose_item(const float* W, int K, int N, bf16_t* WT, const float* g, int mode, LAS float* scr, int item, int lane) {
    const int nblk = N / 32, kb = item / nblk, nb = item % nblk, k0 = 64 * kb, n0 = 32 * nb;
    float tv[32];
#pragma unroll
    for (int i = 0; i < 32; ++i) { const int kk = 2 * i + (lane >> 5); tv[i] = __builtin_nontemporal_load(W + (size_t)(k0 + kk) * N + n0 + (lane & 31)); }
    if (g) {
#pragma unroll
        for (int i = 0; i < 32; ++i) tv[i] *= g[k0 + 2 * i + (lane >> 5)];
    }
#pragma unroll
    for (int i = 0; i < 32; ++i) scr[(2 * i + (lane >> 5)) * 33 + (lane & 31)] = tv[i];
    LDS_WAIT(); asm volatile("" ::: "memory");
    int d0;
    if (mode == 0) d0 = n0;
    else if (mode == 1) d0 = 256 * (n0 >> 7) + (n0 & 127);
    else if (mode == 2) d0 = 256 * (n0 >> 7) + 128 + (n0 & 127);
    else { const int seg = n0 >> 9, cc = n0 & 511; d0 = 256 * ((seg >> 1) * 4 + (cc >> 7)) + 128 * (seg & 1) + (cc & 127); }
    const int c = lane & 7;
#pragma unroll
    for (int j = 0; j < 4; ++j) { const int n = (lane >> 3) + 8 * j; const LAS float* s = scr + (8 * c) * 33 + n;
        u32x4 o; o.x = pk2(s[0 * 33], s[1 * 33]); o.y = pk2(s[2 * 33], s[3 * 33]); o.z = pk2(s[4 * 33], s[5 * 33]); o.w = pk2(s[6 * 33], s[7 * 33]);
        *(u32x4*)(WT + (size_t)(d0 + n) * K + k0 + 8 * c) = o; }
    LDS_WAIT(); asm volatile("" ::: "memory");
}
constexpr int IT_G = (D / 64) * (FF / 32), IT_D = (FF / 64) * (D / 32), IT_WIN = (D / 64) * (2048 / 32), IT_WOUT = (D / 64) * (D / 32);
__device__ __forceinline__ void convert_mats(Frame& F, int l, int id_lo, int id_hi, int gw, int NGW) {
    LAS float* scr = (LAS float*)(F.lds + F.wave * 16384);
    unsigned char* ws = F.ws;
    for (int id = id_lo; id < id_hi; ++id) {
        const int nit = (id == 0 || id == 4) ? 2 * IT_G : (id == 1 || id == 5) ? IT_D : (id == 2 ? IT_WIN : IT_WOUT);
        for (int it = gw; it < nit; it += NGW) {
            if (id == 0) { const bool up = it >= IT_G; transpose_item(F.in[up ? I_W1U : I_W1G] + (size_t)l * D * FF, D, FF, (bf16_t*)(ws + WS_WGU1), F.in[I_GF1] + l * D, up ? 2 : 1, scr, up ? it - IT_G : it, F.lane); }
            else if (id == 4) { const bool up = it >= IT_G; transpose_item(F.in[up ? I_W2U : I_W2G] + (size_t)l * D * FF, D, FF, (bf16_t*)(ws + WS_WGU2), F.in[I_GF2] + l * D, up ? 2 : 1, scr, up ? it - IT_G : it, F.lane); }
            else if (id == 1) transpose_item(F.in[I_W1D] + (size_t)l * D * FF, FF, D, (bf16_t*)(ws + WS_WD1), nullptr, 0, scr, it, F.lane);
            else if (id == 5) transpose_item(F.in[I_W2D] + (size_t)l * D * FF, FF, D, (bf16_t*)(ws + WS_WD2), nullptr, 0, scr, it, F.lane);
            else if (id == 2) transpose_item(F.in[I_WIN] + (size_t)l * D * 2048, D, 2048, (bf16_t*)(ws + WS_WIN), F.in[I_GMIX] + l * D, 3, scr, it, F.lane);
            else transpose_item(F.in[I_WOUT] + (size_t)l * D * D, D, D, (bf16_t*)(ws + WS_WOUT), nullptr, 0, scr, it, F.lane);
        }
    }
}

__device__ __forceinline__ void p0_prologue(Frame& F) {
    convert_mats(F, 0, 0, 6, blockIdx.x * NWAVES + F.wave, F.G * NWAVES);
    const int gw = blockIdx.x * NWAVES + F.wave, NGW = F.G * NWAVES;
    float* X = (float*)(F.ws + WS_X); bf16_t* XB = (bf16_t*)(F.ws + WS_XB); float* ss = (float*)(F.ws + WS_SS);
    for (int r = gw; r < MPAD; r += NGW) {
        const float* src = nullptr;
        if (r < MP) { const int b = r / TP, tt = r - b * TP; src = tt < NMETA ? F.in[I_META] + (size_t)tt * D : F.in[I_XP] + ((size_t)b * SEQ + (tt - NMETA)) * D; }
        else if (r < MR) src = F.in[I_XS] + (size_t)(r - MP) * D;
        f32x4 v[4]; float s = 0.f;
#pragma unroll
        for (int j = 0; j < 4; ++j) { v[j] = src ? __builtin_nontemporal_load((const f32x4*)src + F.lane + 64 * j) : (f32x4){0.f, 0.f, 0.f, 0.f}; s += (v[j][0] * v[j][0] + v[j][1] * v[j][1]) + (v[j][2] * v[j][2] + v[j][3] * v[j][3]); }
        s = wave_sum(s);
#pragma unroll
        for (int j = 0; j < 4; ++j) { ((f32x4*)(X + (size_t)r * D))[F.lane + 64 * j] = v[j];
            u32x2 w; w.x = pk2(v[j][0], v[j][1]); w.y = pk2(v[j][2], v[j][3]); ((u32x2*)(XB + (size_t)r * D))[F.lane + 64 * j] = w; }
        if (F.lane == 0) ss[r] = s;
    }
    { const int i = blockIdx.x * 512 + F.tid; if (i < 6 * MPAD) ss[MPAD + i] = 0.f; }
}

__device__ __forceinline__ void final_phase(Frame& F) {
    const int gw = blockIdx.x * NWAVES + F.wave, NGW = F.G * NWAVES;
    const float* X = (const float*)(F.ws + WS_X); const float* ss = (const float*)(F.ws + WS_SS) + 6 * MPAD; const float* g = F.in[I_GFIN];
    f32x4 gv[4];
#pragma unroll
    for (int j = 0; j < 4; ++j) gv[j] = ((const f32x4*)g)[F.lane + 64 * j];
    for (int r = gw; r < MR; r += NGW) {
        float* dst;
        if (r < MP) { const int b = r / TP, tt = r - b * TP; if (tt < NMETA) continue; dst = F.out + O_YP + ((size_t)b * SEQ + (tt - NMETA)) * D; }
        else dst = F.out + O_YS + (size_t)(r - MP) * D;
        const float rstd = __builtin_amdgcn_rsqf(ss[r] * (1.0f / D) + EPS);
#pragma unroll
        for (int j = 0; j < 4; ++j) { const f32x4 v = ((const f32x4*)(X + (size_t)r * D))[F.lane + 64 * j]; __builtin_nontemporal_store(v * rstd * gv[j], (f32x4*)dst + F.lane + 64 * j); }
    }
}

constexpr int LDS_WR = 0, LDS_WI = 16384, LDS_CBT = 32768, LDS_GRP = LDS_CBT + 4 * 64 * 68 * 4, LDS_RED = 0;

__device__ __forceinline__ float reduce_scatter32(float (&v)[32], int lane) {
#define RS_STEP(H, M) { const bool up = (lane & (M)) != 0; _Pragma("unroll") for (int i = 0; i < (H); ++i) { const float snd = up ? v[i] : v[i + (H)], kp = up ? v[i + (H)] : v[i]; v[i] = kp + __shfl_xor(snd, (M)); } }
    RS_STEP(16, 32) RS_STEP(8, 16) RS_STEP(4, 8) RS_STEP(2, 4) RS_STEP(1, 2)
#undef RS_STEP
    return v[0] + __shfl_xor(v[0], 1);
}

__device__ __forceinline__ void mix_job_a(Frame& F, int l, int sp, int gi) {
    const int tid = F.tid, c = 128 * gi + (tid & 127), sub = tid >> 7;
    const bf16_t* U = (const bf16_t*)(F.ws + WS_U); bf16_t* YAB = (bf16_t*)(F.ws + WS_YAB);
    const float* cw = F.in[I_CAW] + (size_t)l * 31 * DA;
    float w[31];
#pragma unroll
    for (int k = 0; k < 31; ++k) w[k] = cw[k * DA + c];
    const float cbias = F.in[I_CAB][l * DA + c], lg = F.in[I_LNG][l * DA + c], lb = F.in[I_LNB][l * DA + c];
    float acc[32];
#pragma unroll
    for (int t = 0; t < 32; ++t) acc[t] = cbias;
    int rowbase, nval;
    if (sp < 136) {
        const int b = sp / 17, k2 = sp - b * 17, nvalid = (k2 == 16) ? 16 : 128, seqrow0 = b * TP, tb = 128 * k2 + 32 * sub;
        nval = nvalid - 32 * sub; rowbase = seqrow0 + tb;
        if (nval > 0) {
#pragma unroll
            for (int tt = 0; tt < 62; ++tt) {
                const int ti = tb - 30 + tt;
                const float v = ti >= 0 ? bf2f(U[(size_t)(seqrow0 + ti) * 512 + c]) : 0.f;
#pragma unroll
                for (int t = 0; t < 32; ++t) { const int kk = tt - t; if (kk >= 0 && kk <= 30) acc[t] += w[kk] * v; }
            }
        }
    } else {
        nval = 32; const int s0 = 16 * (sp - 136) + 4 * sub; rowbase = MP + 8 * s0;
        const float* st = F.in[I_SCA] + (size_t)l * NB_S * 30 * DA;
#pragma unroll
        for (int hs = 0; hs < 4; ++hs) {
            const int s = s0 + hs, rowS = MP + 8 * s;
#pragma unroll
            for (int tt = 0; tt < 38; ++tt) {
                const float v = tt < 30 ? st[((size_t)s * 30 + tt) * DA + c] : bf2f(U[(size_t)(rowS + tt - 30) * 512 + c]);
#pragma unroll
                for (int t = 0; t < 8; ++t) { const int kk = tt - t; if (kk >= 0 && kk <= 30) acc[8 * hs + t] += w[kk] * v; }
            }
        }
    }
    LAS f32x2* red = (LAS f32x2*)(F.lds + LDS_RED);
    float s1[32], s2[32];
#pragma unroll
    for (int t = 0; t < 32; ++t) { s1[t] = acc[t]; s2[t] = acc[t] * acc[t]; }
    const float r1 = reduce_scatter32(s1, F.lane), r2 = reduce_scatter32(s2, F.lane);
    __syncthreads();
    if ((F.lane & 1) == 0) red[F.wave * 32 + (F.lane >> 1)] = (f32x2){r1, r2};
    __syncthreads();
    if (nval > 0) {
#pragma unroll
        for (int t = 0; t < 32; ++t) {
            const f32x2 a = red[F.wave * 32 + t], o = red[(F.wave ^ 1) * 32 + t];
            const float mean = (a.x + o.x) * (1.0f / 128.0f), var = (a.y + o.y) * (1.0f / 128.0f) - mean * mean;
            const float rstd = __builtin_amdgcn_rsqf(fmaxf(var, 0.f) + EPS);
            const float y = (acc[t] - mean) * rstd * lg + lb;
            if (t < nval) YAB[(size_t)(rowbase + t) * D + c] = (bf16_t)f2bf(silu_f(y));
        }
    }
}

constexpr int WJ_TILE = 9728;
constexpr int LDS_WT = 8 * WJ_TILE;
typedef short bf16x8_t __attribute__((ext_vector_type(8)));

__device__ __forceinline__ void mix_b_wave_jobs(Frame& F, int l) {
    const int lane = F.lane, wave = F.wave, fr = lane & 15, fq = lane >> 4, h = blockIdx.x & 7;
    const bf16_t* BX = (const bf16_t*)(F.ws + WS_BX);
    bf16_t* YAB = (bf16_t*)(F.ws + WS_YAB); bf16_t* PCG = (bf16_t*)(F.ws + WS_XB);
    LAS bf16_t* WT = (LAS bf16_t*)(F.lds + LDS_WT);
    LAS bf16_t* tile = (LAS bf16_t*)(F.lds + wave * WJ_TILE);
    __syncthreads();
    {
        const f32x4* gr = (const f32x4*)(F.in[I_WRG] + (size_t)(l * 8 + h) * 4096); const f32x4* gx = (const f32x4*)(F.in[I_WIG] + (size_t)(l * 8 + h) * 4096);
#pragma unroll
        for (int e = 0; e < 2; ++e) {
            const int idx = F.tid + e * 512, i = idx >> 4, j4 = (idx & 15) * 4;
            const f32x4 a = gr[idx], b = gx[idx];
#pragma unroll
            for (int d = 0; d < 4; ++d) { WT[(j4 + d) * 72 + i] = (bf16_t)f2bf(a[d]); WT[(64 + j4 + d) * 72 + i] = (bf16_t)f2bf(b[d]); }
        }
    }
    float bra[4], bix[4], sp[4];
#pragma unroll
    for (int nt = 0; nt < 4; ++nt) {
        const int c = 64 * h + 16 * nt + fr;
        bra[nt] = F.in[I_BRG][l * DB + c]; bix[nt] = F.in[I_BIG][l * DB + c];
        sp[nt] = log1pf(expf(-F.in[I_LAM][l * DB + c]));
    }
    __syncthreads();
    for (int q = (int)(blockIdx.x >> 3) * 8 + wave; q < NQ; q += 256) {
        const bool prompt = q < NQ_P;
        int row0, t0, nvalid;
        if (prompt) { const int b_ = q / NCH_P, k = q - b_ * NCH_P; row0 = b_ * TP + 64 * k; t0 = 64 * k; nvalid = (k == NCH_P - 1) ? 16 : 64; }
        else { row0 = MP + 64 * (q - NQ_P); t0 = 0; nvalid = 64; }
        int ln = lane; asm volatile("" : "+v"(ln));
#pragma unroll
        for (int i = 0; i < 9; ++i) {
            const int p = ln + 64 * i;
            if (p < 536) {
                const int rr = p >> 3, pc = p & 7, row = rr - 3;
                const bool okr = prompt ? (t0 + row >= 0) : (row >= 0);
                u32x4 v = *(const u32x4*)(BX + (size_t)(row0 + (okr ? row : 0)) * 512 + 64 * h + 8 * pc);
                if (!okr) v = (u32x4){0u, 0u, 0u, 0u};
                *(LAS u32x4*)(tile + rr * 72 + 8 * pc) = v;
            }
        }
        float wb[4][4], bb[4];
        { int fr_l = fr; asm volatile("" : "+v"(fr_l));
#pragma unroll
        for (int nt = 0; nt < 4; ++nt) {
            const int c = 64 * h + 16 * nt + fr_l;
#pragma unroll
            for (int k = 0; k < 4; ++k) wb[k][nt] = F.in[I_CBW][((size_t)l * 4 + k) * DB + c];
            bb[nt] = F.in[I_CBB][l * DB + c];
        } }
        float cbv[4][4][4];
#pragma unroll
        for (int mt = 0; mt < 4; ++mt)
#pragma unroll
            for (int nt = 0; nt < 4; ++nt) {
                const int tb = 16 * mt + 4 * fq; float x[7];
#pragma unroll
                for (int i = 0; i < 7; ++i) x[i] = bf2f(tile[(tb + i) * 72 + 16 * nt + fr]);
                if (!prompt && !(fq & 1)) {
                    const int s = 8 * (q - NQ_P) + 2 * mt + (fq >> 1);
                    const float* st = F.in[I_SCB] + ((size_t)l * NB_S + s) * 3 * DB + 64 * h + 16 * nt + fr;
                    x[0] = st[0]; x[1] = st[DB]; x[2] = st[2 * DB];
                }
#pragma unroll
                for (int e = 0; e < 4; ++e) cbv[mt][nt][e] = bb[nt] + wb[0][nt] * x[e] + wb[1][nt] * x[e + 1] + wb[2][nt] * x[e + 2] + wb[3][nt] * x[e + 3];
            }
        asm volatile("s_waitcnt lgkmcnt(0)" ::: "memory");
#pragma unroll
        for (int mt = 0; mt < 4; ++mt)
#pragma unroll
            for (int nt = 0; nt < 4; ++nt)
#pragma unroll
                for (int e = 0; e < 4; ++e) tile[(16 * mt + 4 * fq + e) * 72 + 16 * nt + fr] = (bf16_t)f2bf(cbv[mt][nt][e]);
        asm volatile("s_waitcnt lgkmcnt(0)" ::: "memory");
        float Pc[4] = {1.f, 1.f, 1.f, 1.f}, Hc[4] = {0.f, 0.f, 0.f, 0.f};
#pragma unroll
        for (int mt = 0; mt < 4; ++mt) {
            const bf16x8_t a0 = *(const LAS bf16x8_t*)(tile + (16 * mt + fr) * 72 + 8 * fq), a1 = *(const LAS bf16x8_t*)(tile + (16 * mt + fr) * 72 + 32 + 8 * fq);
#pragma unroll
            for (int nt = 0; nt < 4; ++nt) {
                const int c = 64 * h + 16 * nt + fr;
                const bf16x8_t br0 = *(const LAS bf16x8_t*)(WT + (16 * nt + fr) * 72 + 8 * fq), br1 = *(const LAS bf16x8_t*)(WT + (16 * nt + fr) * 72 + 32 + 8 * fq);
                const bf16x8_t bi0 = *(const LAS bf16x8_t*)(WT + (64 + 16 * nt + fr) * 72 + 8 * fq), bi1 = *(const LAS bf16x8_t*)(WT + (64 + 16 * nt + fr) * 72 + 32 + 8 * fq);
                f32x4 accR = {0.f, 0.f, 0.f, 0.f}, accI = {0.f, 0.f, 0.f, 0.f};
                accR = __builtin_amdgcn_mfma_f32_16x16x32_bf16(a0, br0, accR, 0, 0, 0); accR = __builtin_amdgcn_mfma_f32_16x16x32_bf16(a1, br1, accR, 0, 0, 0);
                accI = __builtin_amdgcn_mfma_f32_16x16x32_bf16(a0, bi0, accI, 0, 0, 0); accI = __builtin_amdgcn_mfma_f32_16x16x32_bf16(a1, bi1, accI, 0, 0, 0);
                float P4[4], H4[4]; float hp = 0.f, pp = 1.f;
#pragma unroll
                for (int e = 0; e < 4; ++e) {
                    const float r = sigmoid_f(accR[e] + bra[nt]), ig = sigmoid_f(accI[e] + bix[nt]);
                    const float la = -8.0f * r * sp[nt], a = __expf(la), bt = __builtin_amdgcn_sqrtf(neg_expm1_f(2.0f * la)) * (ig * bf2f(tile[(16 * mt + 4 * fq + e) * 72 + 16 * nt + fr]));
                    hp = a * hp + bt; pp = pp * a; H4[e] = hp; P4[e] = pp;
                }
                float pex = 1.f, hex = 0.f;
#pragma unroll
                for (int d = 3; d >= 1; --d) {
                    const float ps = __shfl(pp, lane - 16 * d), hs = __shfl(hp, lane - 16 * d);
                    const bool use = prompt ? (fq >= d) : (d == 1 && (fq & 1));
                    if (use) { hex = ps * hex + hs; pex = pex * ps; }
                }
                const float pin = prompt ? Pc[nt] * pex : pex, hin = prompt ? pex * Hc[nt] + hex : hex;
                float Pf[4], Hf[4];
#pragma unroll
                for (int e = 0; e < 4; ++e) { Hf[e] = H4[e] + P4[e] * hin; Pf[e] = P4[e] * pin; }
                Pc[nt] = __shfl(Pf[3], fr + 48); Hc[nt] = __shfl(Hf[3], fr + 48);
#pragma unroll
                for (int e = 0; e < 4; ++e) {
                    const int tl = 16 * mt + 4 * fq + e;
                    if (tl < nvalid) { const size_t row = (size_t)(row0 + tl); YAB[row * D + 512 + c] = (bf16_t)f2bf(Hf[e]); PCG[row * 512 + c] = (bf16_t)f2bf(Pf[e]); }
                }
                if (prompt) { if (16 * (mt + 1) == nvalid && fq == 3) ((f32x2*)(F.ws + WS_SUMM))[(size_t)q * 512 + c] = (f32x2){Pf[3], Hf[3]}; }
                else if (fq & 1) { const int s = 8 * (q - NQ_P) + 2 * mt + (fq >> 1); ((f32x2*)(F.ws + WS_LAST))[(size_t)s * 512 + c] = (f32x2){Pf[3], Hf[3]}; }
            }
        }
    }
}

constexpr int LDS_ARED = 98304;
__device__ __forceinline__ float reduce_scatter16(float (&v)[16], int lane) {
#define RS_STEP(H, M) { const bool up = (lane & (M)) != 0; _Pragma("unroll") for (int i = 0; i < (H); ++i) { const float snd = up ? v[i] : v[i + (H)], kp = up ? v[i + (H)] : v[i]; v[i] = kp + __shfl_xor(snd, (M)); } }
    RS_STEP(8, 32) RS_STEP(4, 16) RS_STEP(2, 8) RS_STEP(1, 4)
#undef RS_STEP
    float r = v[0]; r += __shfl_xor(r, 2); r += __shfl_xor(r, 1); return r;
}
__device__ __forceinline__ void mix_a_wave_jobs(Frame& F, int l) {
    const int lane = F.lane, wave = F.wave, gi = wave & 3, c0 = 128 * gi + 2 * lane;
    const bf16_t* U = (const bf16_t*)(F.ws + WS_U); bf16_t* YAB = (bf16_t*)(F.ws + WS_YAB);
    const float* cw = F.in[I_CAW] + (size_t)l * 31 * DA;
    f32x2 w[31];
#pragma unroll
    for (int k = 0; k < 31; ++k) w[k] = *(const f32x2*)(cw + k * DA + c0);
    const f32x2 cbv = *(const f32x2*)(F.in[I_CAB] + l * DA + c0), lgv = *(const f32x2*)(F.in[I_LNG] + l * DA + c0), lbv = *(const f32x2*)(F.in[I_LNB] + l * DA + c0);
    LAS f32x2* red = (LAS f32x2*)(F.lds + LDS_ARED + wave * 128);
    for (int tb = 511 - ((int)blockIdx.x * 2 + (wave >> 2)); tb < 1096; tb += 512) {
        f32x2 a[16];
#pragma unroll
        for (int t = 0; t < 16; ++t) a[t] = cbv;
        int rowbase;
        if (tb < 1032) {
            const int b = tb / 129, kb = tb - b * 129, t0 = 16 * kb, seqrow0 = b * TP; rowbase = seqrow0 + t0;
            unsigned raw[46];
#pragma unroll
            for (int tt = 0; tt < 46; ++tt) { const int ti = t0 - 30 + tt; raw[tt] = *(const unsigned*)(U + (size_t)(seqrow0 + (ti < 0 ? 0 : ti)) * 512 + c0); }
#pragma unroll
            for (int tt = 0; tt < 46; ++tt) {
                const unsigned rw = ((t0 - 30 + tt) >= 0) ? raw[tt] : 0u;
                const f32x2 v = {__uint_as_float(rw << 16), __uint_as_float(rw & 0xffff0000u)};
#pragma unroll
                for (int t = 0; t < 16; ++t) { const int kk = tt - t; if (kk >= 0 && kk <= 30) a[t] += w[kk] * v; }
            }
        } else {
            const int s0 = 2 * (tb - 1032); rowbase = MP + 8 * s0;
            const float* st = F.in[I_SCA] + (size_t)l * NB_S * 30 * DA;
#pragma unroll
            for (int hs = 0; hs < 2; ++hs) {
                const int s = s0 + hs, rowS = MP + 8 * s;
#pragma unroll
                for (int tt = 0; tt < 38; ++tt) {
                    f32x2 v;
                    if (tt < 30) v = __builtin_nontemporal_load((const f32x2*)(st + ((size_t)s * 30 + tt) * DA + c0));
                    else { const unsigned rw = *(const unsigned*)(U + (size_t)(rowS + tt - 30) * 512 + c0); v = (f32x2){__uint_as_float(rw << 16), __uint_as_float(rw & 0xffff0000u)}; }
#pragma unroll
                    for (int t = 0; t < 8; ++t) { const int kk = tt - t; if (kk >= 0 && kk <= 30) a[8 * hs + t] += w[kk] * v; }
                }
            }
        }
        float s1[16], s2[16];
#pragma unroll
        for (int t = 0; t < 16; ++t) { s1[t] = a[t].x + a[t].y; s2[t] = a[t].x * a[t].x + a[t].y * a[t].y; }
        const float r1 = reduce_scatter16(s1, lane), r2 = reduce_scatter16(s2, lane);
        if ((lane & 3) == 0) red[lane >> 2] = (f32x2){r1, r2};
        asm volatile("s_waitcnt lgkmcnt(0)" ::: "memory");
#pragma unroll
        for (int t = 0; t < 16; ++t) {
            const f32x2 st_ = red[t];
            const float mean = st_.x * (1.0f / 128.0f), var = st_.y * (1.0f / 128.0f) - mean * mean;
            const float rstd = __builtin_amdgcn_rsqf(fmaxf(var, 0.f) + EPS);
            const f32x2 y = (a[t] - mean) * rstd * lgv + lbv;
            *(unsigned*)(YAB + (size_t)(rowbase + t) * D + c0) = pk2(silu_f(y.x), silu_f(y.y));
        }
        asm volatile("s_waitcnt lgkmcnt(0)" ::: "memory");
    }
}

__device__ __forceinline__ void mix_job_state(Frame& F, int l, int s) {
    const int c = F.tid;
    const bf16_t* U = (const bf16_t*)(F.ws + WS_U); const bf16_t* BX = (const bf16_t*)(F.ws + WS_BX);
    if (s < NB_P) {
        const int b = s; float* oa = F.out + O_CAP + ((size_t)l * NB_P + b) * 30 * DA; float* ob = F.out + O_CBP + ((size_t)l * NB_P + b) * 3 * DB;
#pragma unroll 10
        for (int i = 0; i < 30; ++i) __builtin_nontemporal_store(bf2f(U[(size_t)(b * TP + TP - 30 + i) * 512 + c]), oa + i * DA + c);
#pragma unroll
        for (int i = 0; i < 3; ++i) __builtin_nontemporal_store(bf2f(BX[(size_t)(b * TP + TP - 3 + i) * 512 + c]), ob + i * DB + c);
    } else {
        const int b = s - NB_P, rowS = MP + 8 * b; float* oa = F.out + O_CAS + ((size_t)l * NB_S + b) * 30 * DA; float* ob = F.out + O_CBS + ((size_t)l * NB_S + b) * 3 * DB;
        const float* st = F.in[I_SCA] + ((size_t)l * NB_S + b) * 30 * DA;
#pragma unroll 11
        for (int i = 0; i < 22; ++i) __builtin_nontemporal_store(__builtin_nontemporal_load(st + (8 + i) * DA + c), oa + i * DA + c);
#pragma unroll
        for (int i = 22; i < 30; ++i) __builtin_nontemporal_store(bf2f(U[(size_t)(rowS + i - 22) * 512 + c]), oa + i * DA + c);
#pragma unroll
        for (int i = 0; i < 3; ++i) __builtin_nontemporal_store(bf2f(BX[(size_t)(rowS + 5 + i) * 512 + c]), ob + i * DB + c);
    }
}

__device__ __forceinline__ void mix_a_phase(Frame& F, int l, int sel) {
    if (sel & 1) mix_b_wave_jobs(F, l);
    if (!(sel & 2)) return;
    { int t_ = F.tid; asm volatile("" : "+v"(t_)); F.tid = t_; F.lane = t_ & 63; }
    mix_a_wave_jobs(F, l);
    { int t_ = F.tid; asm volatile("" : "+v"(t_)); F.tid = t_; F.lane = t_ & 63; }
    const int b = blockIdx.x;
    if (b >= 64 && b - 64 < NB_P + NB_S) mix_job_state(F, l, b - 64);
}

__device__ __forceinline__ void mix_c_phase(Frame& F, int l, int rep) {
    const int c = F.tid;
    bf16_t* YAB = (bf16_t*)(F.ws + WS_YAB); const bf16_t* PCG = (const bf16_t*)(F.ws + WS_XB); const bf16_t* GGp = (const bf16_t*)(F.ws + WS_GG);
    const f32x2* SUMM = (const f32x2*)(F.ws + WS_SUMM); const f32x2* LAST = (const f32x2*)(F.ws + WS_LAST);
    for (int job = blockIdx.x; job < NQ * 2; job += F.G) {
        const int q = job >> 1, hh = job & 1;
        if (q < NQ_P) {
            const int b = q / NCH_P, k = q - b * NCH_P, nvalid = (k == NCH_P - 1) ? 16 : 64, row0 = b * TP + 64 * k;
            if (32 * hh >= nvalid) continue;
            float carry = 0.f;
            {
                f32x2 ph[32];
#pragma unroll
                for (int e = 0; e < 32; ++e) { const int kk = e < k ? e : 0; ph[e] = SUMM[(size_t)(b * NCH_P + kk) * 512 + c]; }
#pragma unroll
                for (int e = 0; e < 32; ++e) { const float px = e < k ? ph[e].x : 1.f, py = e < k ? ph[e].y : 0.f; carry = px * carry + py; }
            }
            const int r1 = (32 * hh + 32 < nvalid) ? 32 * hh + 32 : nvalid;
            for (int r = 32 * hh; r < r1; ++r) {
                const size_t row = row0 + r;
                const float y = (bf2f(YAB[row * D + 512 + c]) + bf2f(PCG[row * 512 + c]) * carry) * bf2f(GGp[row * 512 + c]);
                if (rep) ((bf16_t*)(F.ws + WS_U))[row * 512 + c] = (bf16_t)f2bf(y); else
                YAB[row * D + 512 + c] = (bf16_t)f2bf(y);
            }
            if (k == NCH_P - 1 && hh == 0) { const f32x2 ph = SUMM[(size_t)q * 512 + c]; F.out[O_HP + ((size_t)l * NB_P + b) * DB + c] = ph.y + ph.x * carry; }
        } else {
            const int row0 = MP + 64 * (q - NQ_P);
            for (int r = 32 * hh; r < 32 * hh + 32; ++r) {
                const int s = 8 * (q - NQ_P) + (r >> 3); const size_t row = row0 + r;
                const float carry = F.in[I_SH][((size_t)l * NB_S + s) * DB + c];
                const float y = (bf2f(YAB[row * D + 512 + c]) + bf2f(PCG[row * 512 + c]) * carry) * bf2f(GGp[row * 512 + c]);
                if (rep) ((bf16_t*)(F.ws + WS_U))[row * 512 + c] = (bf16_t)f2bf(y); else
                YAB[row * D + 512 + c] = (bf16_t)f2bf(y);
                if ((r & 7) == 7) { const f32x2 ph = LAST[(size_t)s * 512 + c]; F.out[O_HS + ((size_t)l * NB_S + s) * DB + c] = ph.y + ph.x * carry; }
            }
        }
    }
}

constexpr int NPH = 18;
#ifndef PHMASK
#define PHMASK 127
#endif
#define DUPMASK 0
#define MIXSEL 1
__global__ void __launch_bounds__(NWAVES * 64, 2) mega_fwd(Args args) {
    extern __shared__ __attribute__((aligned(16))) unsigned char lds[];
    Frame F;
    F.lds = (LAS unsigned char*)lds; F.G = gridDim.x;
    if (threadIdx.x < 2) ((volatile LAS unsigned*)(F.lds + LDS_BARST))[threadIdx.x] = 0u;
    __syncthreads();
    if (args.ph_hi - args.ph_lo > 1) (void)xcd_barrier_post((unsigned*)(args.ws + WS_BAR), (volatile LAS unsigned*)(F.lds + LDS_BARST));
    const int ph_lo = args.ph_lo, ph_hi = args.ph_hi;
    const int wave_s = __builtin_amdgcn_readfirstlane(threadIdx.x >> 6);
    for (int st = 2 * ph_lo; st < 2 * ph_hi; ++st) {
        const int ph = st >> 1, rep = st & 1;
        bool run = true;
        if (rep == 1) { const int ty = (ph == 0) ? 1 : (ph == NPH - 1) ? 2 : (int)((0x0804084020100804ull >> (8 * ((ph - 1) & 7))) & 255ull);
            run = (DUPMASK & ty) != 0; }
        if (run) {
        const __attribute__((address_space(4))) unsigned char* kp = (const __attribute__((address_space(4))) unsigned char*)__builtin_amdgcn_kernarg_segment_ptr();
        asm volatile("" : "+s"(kp));
        const __attribute__((address_space(4))) Args* ap = (const __attribute__((address_space(4))) Args*)kp;
        F.in = ap->in; F.out = ap->out; F.ws = ap->ws;
        { int t_ = wave_s * 64 + hw_lane_id(); asm volatile("" : "+v"(t_)); F.tid = t_; F.lane = t_ & 63; F.wave = wave_s; }
        unsigned char* ws = F.ws;
        float* SS = (float*)(ws + WS_SS);
        if ((PHMASK & 1) && ph == 0) p0_prologue(F);
        else if ((PHMASK & 2) && ph == NPH - 1) final_phase(F);
        else {
            const int l = (ph - 1) >> 3, s = (ph - 1) & 7;
            if ((PHMASK & 4) && (s == 0 || s == 6)) {
                pg8::Gemm g{(const bf16_t*)(ws + WS_XB), (const bf16_t*)(ws + (s == 0 ? WS_WGU1 : WS_WGU2)), MPAD, 2 * FF, D};
                pg8::StaticOrder S; S.init(MPAD, 2 * FF, D, F.G, (int)blockIdx.x);
                EpiGU E{(bf16_t*)(ws + WS_ACT), SS + (size_t)(s == 0 ? 3 * l : 3 * l + 2) * MPAD};
                pg8::gemm_phase<EpiGU, pg8::StaticOrder, true, true>(F.lds, g, S, E, wave_s);
            } else if ((PHMASK & 8) && (s == 1 || s == 7 || s == 5)) {
                const bool down = (s != 5);
                pg8::Gemm g{(const bf16_t*)(ws + (down ? WS_ACT : WS_YAB)), (const bf16_t*)(ws + (s == 1 ? WS_WD1 : (s == 7 ? WS_WD2 : WS_WOUT))), MPAD, D, down ? FF : D};
                pg8::DpSplit S; S.init(MPAD, D, down ? FF : D, F.G, (int)blockIdx.x, F.out);
                EpiRes E{(float*)(ws + WS_X), (bf16_t*)(ws + WS_XB), (rep ? (float*)(ws + 0x300000) : SS + (size_t)(s == 1 ? 3 * l + 1 : (s == 5 ? 3 * l + 2 : 3 * l + 3)) * MPAD), rep ? 0.0f : (down ? 0.5f : 1.0f)};
                pg8::gemm_phase<EpiRes, pg8::DpSplit, true, true>(F.lds, g, S, E, wave_s);
                if (blockIdx.x >= 80 && rep == 0) {
                    const int gw = ((int)blockIdx.x - 80) * NWAVES + F.wave, NGW = (F.G - 80) * NWAVES;
                    if (l == 0 && s == 1) convert_mats(F, 1, 0, 1, gw, NGW);
                    else if (l == 0 && s == 7) convert_mats(F, 1, 1, 3, gw, NGW);
                    else if (l == 1 && s == 1) convert_mats(F, 1, 3, 5, gw, NGW);
                    else if (l == 1 && s == 5) convert_mats(F, 1, 5, 6, gw, NGW);
                }
                { XcdBarrier xb; xb.bar = (unsigned*)(ws + WS_BAR); xb.x = xb_xcc_id(); xb.st = (volatile LAS unsigned*)(F.lds + LDS_BARST); xcd_barrier(xb, wave_s == 0 && hw_lane_id() == 0); }
                res_fixup(F, E, S);
            } else if ((PHMASK & 16) && s == 2) {
                pg8::Gemm g{(const bf16_t*)(ws + WS_XB), (const bf16_t*)(ws + WS_WIN), MPAD, 2048, D};
                pg8::StaticOrder S; S.init(MPAD, 2048, D, F.G, (int)blockIdx.x);
                EpiWin E{(bf16_t*)(ws + WS_U), (bf16_t*)(ws + WS_BX), (bf16_t*)(ws + WS_GG), SS + (size_t)(3 * l + 1) * MPAD};
                pg8::gemm_phase<EpiWin, pg8::StaticOrder, true, true>(F.lds, g, S, E, wave_s);
            } else if ((PHMASK & 32) && s == 3) mix_a_phase(F, l, rep ? MIXSEL : 3);
            else if ((PHMASK & 64) && s == 4) mix_c_phase(F, l, rep);
        }
        }
        if (rep == 1 && ph + 1 < ph_hi) {
            const __attribute__((address_space(4))) Args* ap2 = (const __attribute__((address_space(4))) Args*)__builtin_amdgcn_kernarg_segment_ptr();
            unsigned* barw = (unsigned*)(ap2->ws + WS_BAR);
            if (ph_hi > 1000) cg::this_grid().sync();
            XcdBarrier xb; xb.bar = barw; xb.x = xb_xcc_id(); xb.st = (volatile LAS unsigned*)(F.lds + LDS_BARST);
            xcd_barrier(xb, wave_s == 0 && hw_lane_id() == 0);
        }
    }
}

#ifndef MK_FUSED
#define MK_FUSED 1
#endif
extern "C" void kernel_launch(void* const* d_in, const int* in_sizes, int n_in, void* d_out, int out_size, void* d_ws, size_t ws_size, hipStream_t stream) {
    static int grid = 0;
    if (grid == 0) {
        if (n_in != N_IN || (size_t)out_size != O_END || ws_size < WS_END) { fprintf(stderr, "kernel_launch: unexpected shapes: n_in %d out %d ws %zu (need %zu)\n", n_in, out_size, ws_size, (size_t)WS_END); grid = -1; return; }
        int dev = 0, cus = 0, per_cu = 0;
        hipGetDevice(&dev); hipDeviceGetAttribute(&cus, hipDeviceAttributeMultiprocessorCount, dev);
        if (hipFuncSetAttribute((const void*)mega_fwd, hipFuncAttributeMaxDynamicSharedMemorySize, LDS_BYTES) != hipSuccess) { fprintf(stderr, "kernel_launch: hipFuncSetAttribute failed\n"); grid = -1; return; }
        if (hipOccupancyMaxActiveBlocksPerMultiprocessor(&per_cu, (const void*)mega_fwd, NWAVES * 64, LDS_BYTES) != hipSuccess || per_cu < 1) { fprintf(stderr, "kernel_launch: occupancy query failed (%d)\n", per_cu); (void)hipGetLastError(); per_cu = 1; }
        grid = cus * 1;
        fprintf(stderr, "kernel_launch: cus %d per_cu %d grid %d ws %zu\n", cus, per_cu, grid, ws_size);
    }
    if (grid < 0) return;
    Args a{};
    for (int i = 0; i < N_IN; ++i) a.in[i] = (const float*)d_in[i];
    a.out = (float*)d_out; a.ws = (unsigned char*)d_ws;
#if MK_FUSED
    a.ph_lo = 0; a.ph_hi = NPH;
    if (hipMemsetAsync((unsigned char*)d_ws + WS_BAR, 0, 0x10000, stream) != hipSuccess) { fprintf(stderr, "kernel_launch: memset of the barrier words failed\n"); return; }
    void* kargs[] = {&a};
    hipError_t e = hipLaunchCooperativeKernel((const void*)mega_fwd, dim3(grid), dim3(NWAVES * 64), kargs, LDS_BYTES, stream);
    if (e != hipSuccess) fprintf(stderr, "cooperative launch failed: %s (grid %d)\n", hipGetErrorString(e), grid);
#else
    for (int ph = 0; ph < NPH; ++ph) { a.ph_lo = ph; a.ph_hi = ph + 1; hipLaunchKernelGGL(mega_fwd, dim3(grid), dim3(NWAVES * 64), LDS_BYTES, stream, a); }
#endif
}
```

```cpp
#include <hip/hip_runtime.h>
#include <hip/hip_cooperative_groups.h>
#include <cstdio>
#include <cstdint>
namespace cg = cooperative_groups;
__device__ __forceinline__ int hw_lane_id() { int l; asm volatile("v_mbcnt_lo_u32_b32 %0, -1, 0\n\tv_mbcnt_hi_u32_b32 %0, -1, %0" : "=v"(l)); return l; }
namespace pg8 {
#define PG8_LAS __attribute__((address_space(3)))
typedef unsigned short bf16_t;
typedef short bf16x8 __attribute__((ext_vector_type(8)));
typedef float f32x4 __attribute__((ext_vector_type(4)));
typedef unsigned u32x4 __attribute__((ext_vector_type(4)));
constexpr int BM = 256, BK = 64, HALF = 128, HTB = HALF * BK * 2  , STAGE_BYTES = 8 * HTB, NXCD = 8, WGM = 8;

__host__ __device__ __forceinline__ int lds_byte(int r, int c) { const int st = (r >> 4) * 2 + (c >> 5), rr = r & 15, cc = c & 31, ob = rr * 64 + cc * 2; return st * 1024 + (ob ^ (((ob >> 9) & 1) << 5)); }
__host__ __device__ __forceinline__ void stage_rc(int b, int& R, int& C) { const int st = b / 1024, sb = b % 1024, swz = sb ^ (((sb >> 9) & 1) << 5); R = (st >> 1) * 16 + swz / 64; C = (st & 1) * 32 + (swz % 64) / 2; }
__host__ __device__ __forceinline__ int perm32(int rho) { const int n = rho >> 4, i = rho & 15; return 8 * (i >> 2) + 4 * n + (i & 3); }

struct Unit { int pm, pn, k0, len, kind; };
struct Gemm { const bf16_t* A; const bf16_t* Bt; int M, N, K; };

struct StaticOrder {
    static constexpr bool STREAMK = false;
    int nM, nN, nwg, G, c, nt;
    __host__ __device__ void init(int M, int N, int K, int G_, int c_) { nM = M / BM; nN = N / BM; nwg = nM * nN; G = G_; c = c_; nt = K / BK; }
    __host__ __device__ bool next(int i, Unit& u) const {
        const long L = (long)i * G + c; if (L >= nwg) return false;
        int wgid = (int)L; { const int q = nwg / NXCD, r = nwg % NXCD, xcd = wgid % NXCD, off = wgid / NXCD; wgid = (xcd < r ? xcd * (q + 1) : r * (q + 1) + (xcd - r) * q) + off; }
        const int nig = WGM * nN, gid = wgid / nig, fm = gid * WGM, gsz = (nM - fm) < WGM ? (nM - fm) : WGM;
        u.pm = fm + ((wgid % nig) % gsz); u.pn = (wgid % nig) / gsz; u.k0 = 0; u.len = nt; u.kind = 0; return true;
    }
    __device__ __forceinline__ void a_ready(const Unit&) const {}
    __device__ __forceinline__ void done(const Unit&) const {}
    __device__ __forceinline__ void store_partial(const f32x4 (&)[2][2][4][2], int, int, int) const {}
    __device__ __forceinline__ void load_partial(f32x4 (&)[2][2][4][2], int, int, int) const {}
};
struct DpSplit {
    static constexpr bool STREAMK = true;
    int nM, nN, nwg, G, c, nt; float* slab;
    __device__ __forceinline__ void init(int M, int N, int K, int G_, int c_, float* slab_) { nM = M / BM; nN = N / BM; nwg = nM * nN; G = G_; c = c_; nt = K / BK; slab = slab_; }
    __device__ __forceinline__ void unit_of(int L, Unit& u) const {
        int wgid = L; { const int q = nwg / NXCD, r = nwg % NXCD, xcd = wgid % NXCD, off = wgid / NXCD; wgid = (xcd < r ? xcd * (q + 1) : r * (q + 1) + (xcd - r) * q) + off; }
        const int nig = WGM * nN, gid = wgid / nig, fm = gid * WGM, gsz = (nM - fm) < WGM ? (nM - fm) : WGM;
        u.pm = fm + ((wgid % nig) % gsz); u.pn = (wgid % nig) / gsz;
    }
    __device__ __forceinline__ bool next(int i, Unit& u) const {
        if (i == 0) { if (c >= nwg) return false; unit_of(c, u); u.k0 = 0; u.len = nt; u.kind = 0; return true; }
        if (i == 1 && c < 4 * (nwg - G)) {
            unit_of(G + (c >> 2), u);
            const int part = c & 3, lenp = (nt >> 2) & ~1, rem2 = (nt - 4 * lenp) >> 1;
            u.len = lenp + (part < rem2 ? 2 : 0); u.k0 = part * lenp + 2 * (part < rem2 ? part : rem2); u.kind = 1; return true;
        }
        return false;
    }
    __device__ __forceinline__ void a_ready(const Unit&) const {}
    __device__ __forceinline__ void done(const Unit&) const {}
    __device__ __forceinline__ void store_partial(const f32x4 (&acc)[2][2][4][2], int tid, int wid, int lane) const {
        typedef unsigned u32x4v __attribute__((ext_vector_type(4)));
        asm volatile("" : "+v"(tid));
        const __amdgpu_buffer_rsrc_t r = __builtin_amdgcn_make_buffer_rsrc((void*)(slab + (size_t)c * 65536), 0, 262144, 0x00020000);
        const int vo = tid * 16;
#pragma unroll
        for (int ai = 0; ai < 2; ++ai)
#pragma unroll
            for (int bj = 0; bj < 2; ++bj)
#pragma unroll
                for (int m = 0; m < 4; ++m)
#pragma unroll
                    for (int n = 0; n < 2; ++n) __builtin_amdgcn_raw_buffer_store_b128(__builtin_bit_cast(u32x4v, acc[ai][bj][m][n]), r, vo, (((ai * 2 + bj) * 4 + m) * 2 + n) * 8192, 16);
    }
    __device__ __forceinline__ void load_partial(f32x4 (&)[2][2][4][2], int, int, int) const {}
};

template <class Epi, class Sched, bool ALIGN_EPI = false, bool SP2 = false>
__device__ __forceinline__ void gemm_phase(PG8_LAS unsigned char* lds, const Gemm g, const Sched& S, const Epi& E, const int wave_s) {
    int tid_l = wave_s * 64 + hw_lane_id(); asm volatile("" : "+v"(tid_l));
    const int tid = tid_l, wid = __builtin_amdgcn_readfirstlane(tid >> 6), lane = tid & 63, wr = wid >> 2, wc = wid & 3, fr = lane & 15, fq = lane >> 4;
    const int K = g.K, nt = K / BK;
    unsigned voffA[2], voffB[2];
#pragma unroll
    for (int i = 0; i < 2; ++i) { int R, C; stage_rc(tid * 16 + i * 8192, R, C); const int Rb = Epi::PERM ? ((R & ~31) + perm32(R & 31)) : R;
        voffA[i] = (unsigned)(R * K + C) * 2u; voffB[i] = (unsigned)(Rb * K + C) * 2u; }
    const size_t kstep = (size_t)(BK * 2);
    const size_t hstep = (size_t)HALF * K * 2;
    const size_t tstep = 2 * hstep;
    const unsigned ldsw = (unsigned)wid * 1024u;
    const int aoff = lds_byte(wr * 64 + fr, fq * 8), boff = lds_byte(wc * 32 + fr, fq * 8);
#define PG8_SA(b, h) (((b) * 2 + (h)) * HTB)
#define PG8_SB(b, h) ((4 + (b) * 2 + (h)) * HTB)
#define PG8_STAGE(bufoff, gbase, voff) do { _Pragma("unroll") for (int _i = 0; _i < 2; ++_i) \
        __builtin_amdgcn_global_load_lds((const unsigned*)((const char*)(gbase) + (voff)[_i]), (PG8_LAS unsigned*)(lds + (bufoff) + ldsw + _i * 8192), 16, 0, 0); } while (0)
#define PG8_LDA(dst, b, h) do { _Pragma("unroll") for (int m = 0; m < 4; ++m) _Pragma("unroll") for (int k = 0; k < 2; ++k) dst[m][k] = *(const PG8_LAS bf16x8*)(lds + PG8_SA(b, h) + aoff + m * 2048 + k * 1024); } while (0)
#define PG8_LDB(dst, b, h) do { _Pragma("unroll") for (int n = 0; n < 2; ++n) _Pragma("unroll") for (int k = 0; k < 2; ++k) dst[n][k] = *(const PG8_LAS bf16x8*)(lds + PG8_SB(b, h) + boff + n * 2048 + k * 1024); } while (0)
#define PG8_MMA(ai, bj, At, Bt) do { __builtin_amdgcn_s_setprio(1); _Pragma("unroll") for (int m = 0; m < 4; ++m) _Pragma("unroll") for (int n = 0; n < 2; ++n) _Pragma("unroll") for (int k = 0; k < 2; ++k) \
        acc[ai][bj][m][n] = __builtin_amdgcn_mfma_f32_16x16x32_bf16(Bt[n][k], At[m][k], acc[ai][bj][m][n], 0, 0, 0); __builtin_amdgcn_s_setprio(0); } while (0)
#define PG8_WAIT_V(n) asm volatile("s_waitcnt vmcnt(" #n ")" ::: "memory")
#define PG8_WAIT_L(n) asm volatile("s_waitcnt lgkmcnt(" #n ")" ::: "memory")
#define PG8_BAR __builtin_amdgcn_s_barrier()
#define PG8_SCHED __builtin_amdgcn_sched_barrier(0)
    Unit cur, nxt; int ui = 0;
    if (!S.next(0, cur)) return;
    f32x4 acc[2][2][4][2];
#pragma unroll
    for (int a = 0; a < 2; ++a)
#pragma unroll
        for (int b = 0; b < 2; ++b)
#pragma unroll
            for (int m = 0; m < 4; ++m)
#pragma unroll
                for (int n = 0; n < 2; ++n) acc[a][b][m][n] = (f32x4){0.f, 0.f, 0.f, 0.f};
    if (Sched::STREAMK && cur.kind == 2) S.load_partial(acc, tid, wid, lane);
    if constexpr (Epi::INIT_ACC) { if (cur.kind == 0) E.init(acc, cur, wr, wc, fr, fq); }
    bf16x8 At[4][2], B0[2][2], B1[2][2];
    const char* cA = (const char*)g.A + (size_t)cur.pm * tstep + (size_t)cur.k0 * kstep; const char* cB = (const char*)g.Bt + (size_t)cur.pn * tstep + (size_t)cur.k0 * kstep;
    S.a_ready(cur);
    if constexpr (SP2) {
        PG8_STAGE(PG8_SB(0, 0), cB, voffB); PG8_STAGE(PG8_SB(0, 1), cB + hstep, voffB); PG8_STAGE(PG8_SA(0, 0), cA, voffA); PG8_STAGE(PG8_SA(0, 1), cA + hstep, voffA);
        if (wr == 1) PG8_BAR;
        PG8_WAIT_V(2); PG8_BAR;
        PG8_STAGE(PG8_SB(1, 0), cB + kstep, voffB); PG8_STAGE(PG8_SA(1, 0), cA + kstep, voffA); PG8_STAGE(PG8_SB(1, 1), cB + hstep + kstep, voffB);
        PG8_WAIT_V(6); PG8_BAR;
    } else {
        PG8_STAGE(PG8_SB(0, 0), cB, voffB); PG8_STAGE(PG8_SA(0, 0), cA, voffA); PG8_STAGE(PG8_SB(0, 1), cB + hstep, voffB); PG8_STAGE(PG8_SA(0, 1), cA + hstep, voffA);
        if (wr == 1) PG8_BAR;
        PG8_WAIT_V(4); PG8_BAR;
        PG8_STAGE(PG8_SB(1, 0), cB + kstep, voffB); PG8_STAGE(PG8_SA(1, 0), cA + kstep, voffA); PG8_STAGE(PG8_SB(1, 1), cB + hstep + kstep, voffB);
        PG8_WAIT_V(6); PG8_BAR;
    }
    for (;;) {
        const bool has_next = S.next(ui + 1, nxt);
        const char* nA = has_next ? (const char*)g.A + (size_t)nxt.pm * tstep + (size_t)nxt.k0 * kstep : cA; const char* nB = has_next ? (const char*)g.Bt + (size_t)nxt.pn * tstep + (size_t)nxt.k0 * kstep : cB;
        const int clen = cur.len;
        for (int t = 0; t < clen; t += 2) {
            const bool last = (t == clen - 2);
            const char* a1 = cA + (size_t)(t + 1) * kstep;
            const char* a2 = last ? nA : cA + (size_t)(t + 2) * kstep; const char* b2 = last ? nB : cB + (size_t)(t + 2) * kstep;
            const char* a3 = a2 + kstep; const char* b3 = b2 + kstep;
            if (last && has_next) S.a_ready(nxt);
            if constexpr (SP2) {
            PG8_LDB(B0, 0, 0); PG8_LDB(B1, 0, 1); PG8_SCHED; PG8_LDA(At, 0, 0); PG8_STAGE(PG8_SA(1, 1), a1 + hstep, voffA);
            PG8_WAIT_V(8); PG8_WAIT_L(0); PG8_BAR; PG8_MMA(0, 0, At, B0); PG8_MMA(0, 1, At, B1); PG8_BAR; PG8_SCHED;
            PG8_LDA(At, 0, 1); PG8_STAGE(PG8_SB(0, 0), b2, voffB); PG8_STAGE(PG8_SB(0, 1), b2 + hstep, voffB); PG8_STAGE(PG8_SA(0, 0), a2, voffA);
            PG8_WAIT_V(8); PG8_WAIT_L(0); PG8_BAR; PG8_MMA(1, 0, At, B0); PG8_MMA(1, 1, At, B1); PG8_BAR; PG8_SCHED;
            PG8_LDB(B0, 1, 0); PG8_LDB(B1, 1, 1); PG8_SCHED; PG8_LDA(At, 1, 0); PG8_STAGE(PG8_SA(0, 1), a2 + hstep, voffA);
            PG8_WAIT_V(8); PG8_WAIT_L(0); PG8_BAR; PG8_MMA(0, 0, At, B0); PG8_MMA(0, 1, At, B1); PG8_BAR; PG8_SCHED;
            PG8_LDA(At, 1, 1); PG8_STAGE(PG8_SB(1, 0), b3, voffB); PG8_STAGE(PG8_SB(1, 1), b3 + hstep, voffB); PG8_STAGE(PG8_SA(1, 0), a3, voffA);
            PG8_WAIT_V(8); PG8_WAIT_L(0); PG8_BAR; PG8_MMA(1, 0, At, B0); PG8_MMA(1, 1, At, B1); PG8_BAR; PG8_SCHED;
            } else {
            PG8_LDB(B0, 0, 0); PG8_SCHED; PG8_LDA(At, 0, 0); PG8_STAGE(PG8_SA(1, 1), a1 + hstep, voffA);
            PG8_WAIT_L(8); PG8_BAR; PG8_WAIT_L(0); PG8_MMA(0, 0, At, B0); PG8_BAR; PG8_SCHED;
            PG8_LDB(B1, 0, 1); PG8_STAGE(PG8_SB(0, 0), b2, voffB);
            PG8_BAR; PG8_WAIT_L(0); PG8_MMA(0, 1, At, B1); PG8_BAR;
            PG8_LDA(At, 0, 1); PG8_STAGE(PG8_SA(0, 0), a2, voffA);
            PG8_BAR; PG8_WAIT_L(0); PG8_MMA(1, 0, At, B0); PG8_BAR; PG8_SCHED;
            PG8_STAGE(PG8_SB(0, 1), b2 + hstep, voffB);
            PG8_WAIT_V(6); PG8_BAR; PG8_MMA(1, 1, At, B1); PG8_BAR;
            PG8_LDB(B0, 1, 0); PG8_SCHED; PG8_LDA(At, 1, 0); PG8_STAGE(PG8_SA(0, 1), a2 + hstep, voffA);
            PG8_WAIT_L(8); PG8_BAR; PG8_WAIT_L(0); PG8_MMA(0, 0, At, B0); PG8_BAR; PG8_SCHED;
            PG8_LDB(B1, 1, 1); PG8_STAGE(PG8_SB(1, 0), b3, voffB);
            PG8_BAR; PG8_WAIT_L(0); PG8_MMA(0, 1, At, B1); PG8_BAR;
            PG8_LDA(At, 1, 1); PG8_STAGE(PG8_SA(1, 0), a3, voffA);
            PG8_BAR; PG8_WAIT_L(0); PG8_MMA(1, 0, At, B0); PG8_BAR; PG8_SCHED;
            PG8_STAGE(PG8_SB(1, 1), b3 + hstep, voffB);
            PG8_WAIT_V(6); PG8_BAR; PG8_MMA(1, 1, At, B1); PG8_BAR;
            }
        }
        if constexpr (ALIGN_EPI) { if (wr == 0) PG8_BAR; }
        if constexpr (!Epi::AFTER_DRAIN) {
            int fr_l = fr, fq_l = fq; asm volatile("" : "+v"(fr_l), "+v"(fq_l));
            if constexpr (Sched::STREAMK) {
                if (cur.kind == 1) S.store_partial(acc, tid, wid, lane);
                else E(acc, cur, wr, wc, fr_l, fq_l);
            } else E(acc, cur, wr, wc, fr_l, fq_l);
            S.done(cur); }
        if (!has_next) break;
#define PG8_ZERO_ACC() do { _Pragma("unroll") for (int a = 0; a < 2; ++a) _Pragma("unroll") for (int b = 0; b < 2; ++b) _Pragma("unroll") for (int m = 0; m < 4; ++m) _Pragma("unroll") for (int n = 0; n < 2; ++n) acc[a][b][m][n] = (f32x4){0.f, 0.f, 0.f, 0.f}; } while (0)
        if constexpr (Epi::INIT_ACC) {
            if (Sched::STREAMK && nxt.kind == 2) S.load_partial(acc, tid, wid, lane);
            else if (nxt.kind == 0) { int fr_i = fr, fq_i = fq; asm volatile("" : "+v"(fr_i), "+v"(fq_i)); E.init(acc, nxt, wr, wc, fr_i, fq_i); }
            else PG8_ZERO_ACC();
        } else {
            if (Sched::STREAMK && nxt.kind == 2) S.load_partial(acc, tid, wid, lane);
            else PG8_ZERO_ACC();
        }
#undef PG8_ZERO_ACC
        cur = nxt; cA = nA; cB = nB; ++ui;
        if constexpr (ALIGN_EPI) { if (wr == 1) PG8_BAR; }
    }
    PG8_WAIT_V(0);
    if constexpr (!ALIGN_EPI) { if (wr == 0) PG8_BAR; }
    PG8_BAR;
    if constexpr (Epi::AFTER_DRAIN) { E.fused(acc, cur, wr, wc, fr, fq, lds, wid, lane); S.done(cur); }
#undef PG8_SA
#undef PG8_SB
#undef PG8_STAGE
#undef PG8_LDA
#undef PG8_LDB
#undef PG8_MMA
#undef PG8_WAIT_V
#undef PG8_WAIT_L
#undef PG8_BAR
#undef PG8_SCHED
}
}

#define LAS __attribute__((address_space(3)))
typedef unsigned short bf16_t;
typedef float f32x4 __attribute__((ext_vector_type(4)));
typedef float f32x2 __attribute__((ext_vector_type(2)));
typedef unsigned u32x4 __attribute__((ext_vector_type(4)));
typedef unsigned u32x2 __attribute__((ext_vector_type(2)));

constexpr int D = 1024, FF = 2816, DA = 512, DB = 512;
constexpr int NB_P = 8, TP = 2064, NB_S = 128, TS = 8, NMETA = 16, SEQ = 2048;
constexpr int MP = NB_P * TP;
constexpr int MR = MP + NB_S * TS;
constexpr int MPAD = 17664;
constexpr int NCH_P = 33;
constexpr int NQ_P = NB_P * NCH_P;
constexpr int NQ_S = (NB_S * TS) / 64;
constexpr int NQ = NQ_P + NQ_S;
constexpr float EPS = 1e-6f;
constexpr int NWAVES = 8;

enum { I_XP = 0, I_XS, I_SCA, I_SCB, I_SH, I_META, I_GF1, I_W1G, I_W1U, I_W1D, I_GMIX, I_WIN, I_CAW, I_CAB, I_LNG, I_LNB, I_CBW, I_CBB,
       I_WRG, I_BRG, I_WIG, I_BIG, I_LAM, I_WOUT, I_GF2, I_W2G, I_W2U, I_W2D, I_GFIN, N_IN };
constexpr size_t O_YP = 0, O_YS = O_YP + (size_t)NB_P * SEQ * D, O_CAP = O_YS + (size_t)NB_S * TS * D, O_CBP = O_CAP + (size_t)2 * NB_P * 30 * DA,
                 O_HP = O_CBP + (size_t)2 * NB_P * 3 * DB, O_CAS = O_HP + (size_t)2 * NB_P * DB, O_CBS = O_CAS + (size_t)2 * NB_S * 30 * DA,
                 O_HS = O_CBS + (size_t)2 * NB_S * 3 * DB, O_END = O_HS + (size_t)2 * NB_S * DB;

constexpr size_t WS_SS = 0;
constexpr size_t WS_SUMM = 0x80000;
constexpr size_t WS_LAST = 0x1A0000;
constexpr size_t WS_W = 0x400000;
constexpr size_t SZ_WGU = (size_t)2 * FF * D * 2, SZ_WD = (size_t)D * FF * 2, SZ_WIN = (size_t)2048 * D * 2, SZ_WOUT = (size_t)D * D * 2;
constexpr size_t WS_WGU1 = WS_W, WS_WD1 = WS_WGU1 + SZ_WGU, WS_WIN = WS_WD1 + SZ_WD, WS_WOUT = WS_WIN + SZ_WIN, WS_WGU2 = WS_WOUT + SZ_WOUT, WS_WD2 = WS_WGU2 + SZ_WGU;
constexpr size_t WS_X = WS_WD2 + SZ_WD;
constexpr size_t WS_XB = WS_X + (size_t)MPAD * D * 4;
constexpr size_t WS_ACT = WS_XB + (size_t)MPAD * D * 2;
constexpr size_t WS_U = WS_ACT, WS_BX = WS_U + (size_t)MPAD * 512 * 2, WS_GG = WS_BX + (size_t)MPAD * 512 * 2, WS_YAB = WS_GG + (size_t)MPAD * 512 * 2;
constexpr size_t WS_END = WS_ACT + (size_t)MPAD * FF * 2;
static_assert(WS_YAB + (size_t)MPAD * D * 2 <= WS_END, "mixer overlay fits");
static_assert(WS_END <= 268435456, "ws map fits 256 MiB");
static_assert(WS_SS + 7 * (size_t)MPAD * 4 <= WS_SUMM && WS_SUMM + (size_t)NQ * 512 * 8 <= WS_LAST && WS_LAST + (size_t)128 * 512 * 8 <= WS_W, "small buffers");

constexpr int LDS_BYTES = 147456;

__device__ __forceinline__ float bf2f(bf16_t b) { return __uint_as_float(((unsigned)b) << 16); }
__device__ __forceinline__ unsigned pk2(float lo, float hi) { unsigned r; asm("v_cvt_pk_bf16_f32 %0, %1, %2" : "=v"(r) : "v"(lo), "v"(hi)); return r; }
__device__ __forceinline__ unsigned f2bf(float f) { return pk2(f, f) & 0xffffu; }
__device__ __forceinline__ float fast_rcp(float x) { return __builtin_amdgcn_rcpf(x); }
__device__ __forceinline__ float sigmoid_f(float x) { return fast_rcp(1.0f + __expf(-x)); }
__device__ __forceinline__ float silu_f(float x) { return x * sigmoid_f(x); }
__device__ __forceinline__ float gelu_tanh_f(float x) {
    const float u = 0.7978845608028654f * (x + 0.044715f * x * x * x);
    return x * sigmoid_f(2.0f * u);
}
__device__ __forceinline__ float neg_expm1_f(float x) {
    const float p = -x * (1.0f + x * (0.5f + x * (0.16666667f + x * (0.041666668f + x * (0.0083333338f + x * (0.0013888889f + x * 0.0001984127f))))));
    const float q = 1.0f - __expf(x);
    return x > -0.35f ? p : q;
}
__device__ __forceinline__ float wave_sum(float v) {
#pragma unroll
    for (int o = 1; o < 64; o <<= 1) v += __shfl_xor(v, o);
    return v;
}

#define XB_TMO      128
#define XB_XCNT(j)  (256  + 64 * (j))
#define XB_XSUB(j)  (1280 + 64 * (j))
#define XB_XGEN(j)  (2304 + 64 * (j))
#define XB_TOP      3328
#define XB_TOPGEN   3392
#define XCD_BAR_WORDS 3456
#define XB_SPIN_CAP (1u << 18)

__device__ __forceinline__ unsigned xb_ld(unsigned* p)              { return __hip_atomic_load(p, __ATOMIC_RELAXED, __HIP_MEMORY_SCOPE_AGENT); }
__device__ __forceinline__ unsigned xb_add(unsigned* p, unsigned v) { return __hip_atomic_fetch_add(p, v, __ATOMIC_RELAXED, __HIP_MEMORY_SCOPE_AGENT); }
__device__ __forceinline__ unsigned xb_xcc_id() { return (unsigned)__builtin_amdgcn_s_getreg((3 << 11) | 20) & 0xFu; }
#define XB_SPIN(cond, bar) do { unsigned _sp = 0; while (cond) { __builtin_amdgcn_s_sleep(1); \
    if ((++_sp & 255u) == 0u) { if (xb_ld(&(bar)[XB_TMO])) break; if (_sp > XB_SPIN_CAP) { atomicAdd(&(bar)[XB_TMO], 1u); break; } } } } while (0)

struct XcdBarrier {
    unsigned* bar; unsigned x;
    volatile LAS unsigned* st;
};

__device__ __forceinline__ XcdBarrier xcd_barrier_post(unsigned* bar, volatile LAS unsigned* st) {
    XcdBarrier b; b.bar = bar; b.x = xb_xcc_id(); b.st = st;
    if (threadIdx.x == 0) (void)xb_add(&bar[XB_XCNT(b.x)], 1u);
    return b;
}
__device__ __forceinline__ void xcd_barrier_complete(unsigned* bar, unsigned x, unsigned& nloc, unsigned& nx) {
    const unsigned G = gridDim.x * gridDim.y * gridDim.z;
    unsigned sum, cnt, mine, sp = 0u;
    for (;;) {
        sum = 0u; cnt = 0u; mine = 0u;
#pragma unroll
        for (unsigned j = 0; j < 16; ++j) { const unsigned c = xb_ld(&bar[XB_XCNT(j)]); sum += c; cnt += (c > 0u) ? 1u : 0u; mine = (j == x) ? c : mine; }
        if (sum == G) break;
        __builtin_amdgcn_s_sleep(1);
        if ((++sp & 255u) == 0u) { if (xb_ld(&bar[XB_TMO])) break; if (sp > XB_SPIN_CAP) { atomicAdd(&bar[XB_TMO], 1u); break; } }
    }
    nloc = mine > 0u ? mine : 1u; nx = cnt > 0u ? cnt : 1u;
}

__device__ __forceinline__ void xcd_barrier(const XcdBarrier& b, const bool is_t0) {
    asm volatile("s_waitcnt vmcnt(0)" ::: "memory");
    __syncthreads();
    if (is_t0) {
        unsigned* bar = b.bar;
        __builtin_amdgcn_s_waitcnt(0);
        unsigned nloc = b.st[0], nx = b.st[1];
        if (nloc == 0u) { xcd_barrier_complete(bar, b.x, nloc, nx); b.st[0] = nloc; b.st[1] = nx; }
        const unsigned old = xb_add(&bar[XB_XSUB(b.x)], 1u);
        const unsigned gen = old / nloc;
        if (old + 1u == (gen + 1u) * nloc) {
            __builtin_amdgcn_fence(__ATOMIC_RELEASE, "agent");
            asm volatile("s_waitcnt vmcnt(0)" ::: "memory");
            const unsigned og = xb_add(&bar[XB_TOP], 1u);
            const unsigned tg = og / nx;
            if (og + 1u == (tg + 1u) * nx) xb_add(&bar[XB_TOPGEN], 1u);
            else XB_SPIN(xb_ld(&bar[XB_TOPGEN]) == tg, bar);
            __builtin_amdgcn_fence(__ATOMIC_ACQUIRE, "agent");
            xb_add(&bar[XB_XGEN(b.x)], 1u);
            asm volatile("s_waitcnt vmcnt(0)" ::: "memory");
        } else {
            XB_SPIN(xb_ld(&bar[XB_XGEN(b.x)]) == gen, bar);
            __builtin_amdgcn_fence(__ATOMIC_ACQUIRE, "agent");
            asm volatile("s_waitcnt vmcnt(0)" ::: "memory");
        }
    }
    __syncthreads();
}

constexpr size_t WS_BAR = 0x380000;
constexpr int LDS_BARST = 139264;
constexpr size_t WS_SKF = 0x390000;

struct EpiGU {
    static constexpr bool PERM = true, AFTER_DRAIN = false, INIT_ACC = false;
    bf16_t* ACT; const float* ss;
    __device__ __forceinline__ void operator()(const f32x4 (&acc)[2][2][4][2], const pg8::Unit& u, int wr, int wc, int fr, int fq) const {
        const int row0 = u.pm * 256 + wr * 64 + fr, col0 = u.pn * 128 + wc * 32 + 8 * fq;
        float rs[2][4];
#pragma unroll
        for (int ai = 0; ai < 2; ++ai)
#pragma unroll
            for (int m = 0; m < 4; ++m) rs[ai][m] = ss[row0 + ai * 128 + m * 16];
#pragma unroll
        for (int ai = 0; ai < 2; ++ai)
#pragma unroll
            for (int m = 0; m < 4; ++m) {
                const int r = row0 + ai * 128 + m * 16;
                const float rstd = __builtin_amdgcn_rsqf(rs[ai][m] * (1.0f / D) + EPS);
                float o[8];
#pragma unroll
                for (int n = 0; n < 2; ++n)
#pragma unroll
                    for (int e = 0; e < 4; ++e) { const float g = acc[ai][0][m][n][e] * rstd, up = acc[ai][1][m][n][e] * rstd; o[4 * n + e] = silu_f(g) * up; }
                u32x4 w; w.x = pk2(o[0], o[1]); w.y = pk2(o[2], o[3]); w.z = pk2(o[4], o[5]); w.w = pk2(o[6], o[7]);
                *(u32x4*)(ACT + (size_t)r * FF + col0) = w;
            }
    }
};
struct EpiRes {
    static constexpr bool PERM = true, AFTER_DRAIN = false, INIT_ACC = true;
    float* X; bf16_t* XB; float* ssn; float scale;
    __device__ __forceinline__ void init(f32x4 (&acc)[2][2][4][2], const pg8::Unit& u, int wr, int wc, int fr, int fq) const {
        const int row0 = u.pm * 256 + wr * 64 + fr, col0 = u.pn * 256 + wc * 32 + 8 * fq; const float inv = 1.0f / scale;
#pragma unroll
        for (int ai = 0; ai < 2; ++ai)
#pragma unroll
            for (int m = 0; m < 4; ++m)
#pragma unroll
                for (int bj = 0; bj < 2; ++bj) { const float* xp = X + (size_t)(row0 + ai * 128 + m * 16) * D + col0 + bj * 128; acc[ai][bj][m][0] = *(const f32x4*)xp * inv; acc[ai][bj][m][1] = *(const f32x4*)(xp + 4) * inv; }
    }
    __device__ __forceinline__ void operator()(const f32x4 (&acc)[2][2][4][2], const pg8::Unit& u, int wr, int wc, int fr, int fq) const {
        const int row0 = u.pm * 256 + wr * 64 + fr, col0 = u.pn * 256 + wc * 32 + 8 * fq;
#pragma unroll
        for (int ai = 0; ai < 2; ++ai)
#pragma unroll
            for (int m = 0; m < 4; ++m) {
                const int r = row0 + ai * 128 + m * 16; float q = 0.f;
#pragma unroll
                for (int bj = 0; bj < 2; ++bj) {
                    float* xp = X + (size_t)r * D + col0 + bj * 128;
                    const f32x4 v0 = acc[ai][bj][m][0] * scale, v1 = acc[ai][bj][m][1] * scale;
                    *(f32x4*)xp = v0; *(f32x4*)(xp + 4) = v1;
                    u32x4 w; w.x = pk2(v0[0], v0[1]); w.y = pk2(v0[2], v0[3]); w.z = pk2(v1[0], v1[1]); w.w = pk2(v1[2], v1[3]);
                    *(u32x4*)(XB + (size_t)r * D + col0 + bj * 128) = w;
                    q += (v0[0] * v0[0] + v0[1] * v0[1]) + (v0[2] * v0[2] + v0[3] * v0[3]) + (v1[0] * v1[0] + v1[1] * v1[1]) + (v1[2] * v1[2] + v1[3] * v1[3]);
                }
                q += __shfl_xor(q, 16); q += __shfl_xor(q, 32);
                if (fq == 0) atomicAdd(ssn + r, q);
            }
    }
};
struct EpiWin {
    static constexpr bool PERM = true, AFTER_DRAIN = false, INIT_ACC = false;
    bf16_t *U, *BX, *GG; const float* ss;
    __device__ __forceinline__ void operator()(const f32x4 (&acc)[2][2][4][2], const pg8::Unit& u, int wr, int wc, int fr, int fq) const {
        const int row0 = u.pm * 256 + wr * 64 + fr, col0 = (u.pn & 3) * 128 + wc * 32 + 8 * fq;
        const bool isA = u.pn < 4;
        float rs[2][4];
#pragma unroll
        for (int ai = 0; ai < 2; ++ai)
#pragma unroll
            for (int m = 0; m < 4; ++m) rs[ai][m] = ss[row0 + ai * 128 + m * 16];
#pragma unroll
        for (int ai = 0; ai < 2; ++ai)
#pragma unroll
            for (int m = 0; m < 4; ++m) {
                const int r = row0 + ai * 128 + m * 16;
                const float rstd = __builtin_amdgcn_rsqf(rs[ai][m] * (1.0f / D) + EPS);
                float a0[8], a1[8];
#pragma unroll
                for (int n = 0; n < 2; ++n)
#pragma unroll
                    for (int e = 0; e < 4; ++e) { a0[4 * n + e] = acc[ai][0][m][n][e] * rstd; a1[4 * n + e] = acc[ai][1][m][n][e] * rstd; }
                if (isA) {
                    float o[8];
#pragma unroll
                    for (int e = 0; e < 8; ++e) o[e] = a0[e] * sigmoid_f(a1[e]);
                    u32x4 w; w.x = pk2(o[0], o[1]); w.y = pk2(o[2], o[3]); w.z = pk2(o[4], o[5]); w.w = pk2(o[6], o[7]);
                    *(u32x4*)(U + (size_t)r * 512 + col0) = w;
                } else {
                    float o[8];
#pragma unroll
                    for (int e = 0; e < 8; ++e) o[e] = gelu_tanh_f(a1[e]);
                    u32x4 w; w.x = pk2(a0[0], a0[1]); w.y = pk2(a0[2], a0[3]); w.z = pk2(a0[4], a0[5]); w.w = pk2(a0[6], a0[7]);
                    *(u32x4*)(BX + (size_t)r * 512 + col0) = w;
                    u32x4 g; g.x = pk2(o[0], o[1]); g.y = pk2(o[2], o[3]); g.z = pk2(o[4], o[5]); g.w = pk2(o[6], o[7]);
                    *(u32x4*)(GG + (size_t)r * 512 + col0) = g;
                }
            }
    }
};

struct Args { const float* in[N_IN]; float* out; unsigned char* ws; int ph_lo, ph_hi; };
struct Frame {
    LAS unsigned char* lds;
    int tid, lane, wave, G;
    const float* const __attribute__((address_space(4)))* in; float* out; unsigned char* ws;
};
#define LDS_WAIT() asm volatile("s_waitcnt lgkmcnt(0)" ::: "memory")

template <class FrameT>
__device__ __forceinline__ void res_fixup(FrameT& F, const EpiRes& E, const pg8::DpSplit& S) {
    const int nleft = S.nwg - S.G, tid = F.tid, wid = tid >> 6, lane = tid & 63, wr = wid >> 2, wc = wid & 3, fr = lane & 15, fq = lane >> 4;
    for (int item = blockIdx.x; item < nleft * 8; item += F.G) {
        const int j = item >> 3, ai = (item >> 2) & 1, m = item & 3;
        pg8::Unit u; S.unit_of(S.G + j, u);
        const int r = u.pm * 256 + wr * 64 + fr + ai * 128 + m * 16, col0 = u.pn * 256 + wc * 32 + 8 * fq;
        float q = 0.f;
#pragma unroll
        for (int bj = 0; bj < 2; ++bj) {
            f32x4 a0 = {0.f, 0.f, 0.f, 0.f}, a1 = {0.f, 0.f, 0.f, 0.f};
#pragma unroll
            for (int p = 0; p < 4; ++p) {
                const float* sp = S.slab + (size_t)(4 * j + p) * 65536 + (size_t)((((ai * 2 + bj) * 4 + m) * 2) * 2048) + tid * 4;
                a0 += __builtin_nontemporal_load((const f32x4*)sp); a1 += __builtin_nontemporal_load((const f32x4*)(sp + 2048));
            }
            float* xp = E.X + (size_t)r * D + col0 + bj * 128;
            f32x4 v0 = *(f32x4*)xp, v1 = *(f32x4*)(xp + 4);
            v0 = v0 + a0 * E.scale; v1 = v1 + a1 * E.scale;
            *(f32x4*)xp = v0; *(f32x4*)(xp + 4) = v1;
            u32x4 w; w.x = pk2(v0[0], v0[1]); w.y = pk2(v0[2], v0[3]); w.z = pk2(v1[0], v1[1]); w.w = pk2(v1[2], v1[3]);
            *(u32x4*)(E.XB + (size_t)r * D + col0 + bj * 128) = w;
            q += (v0[0] * v0[0] + v0[1] * v0[1]) + (v0[2] * v0[2] + v0[3] * v0[3]) + (v1[0] * v1[0] + v1[1] * v1[1]) + (v1[2] * v1[2] + v1[3] * v1[3]);
        }
        q += __shfl_xor(q, 16); q += __shfl_xor(q, 32);
        if (fq == 0) atomicAdd(E.ssn + r, q);
    }
}


__device__ __forceinline__ void transpose_item(const float* W, int K, int N, bf16_t* WT, const float* g, int mode, LAS float* scr, int item, int lane) {
    const int nblk = N / 32, kb = item / nblk, nb = item % nblk, k0 = 64 * kb, n0 = 32 * nb;
    float tv[32];
#pragma unroll
    for (int i = 0; i < 32; ++i) { const int kk = 2 * i + (lane >> 5); tv[i] = __builtin_nontemporal_load(W + (size_t)(k0 + kk) * N + n0 + (lane & 31)); }
    if (g) {
#pragma unroll
        for (int i = 0; i < 32; ++i) tv[i] *= g[k0 + 2 * i + (lane >> 5)];
    }
#pragma unroll
    for (int i = 0; i < 32; ++i) scr[(2 * i + (lane >> 5)) * 33 + (lane & 31)] = tv[i];
    LDS_WAIT(); asm volatile("" ::: "memory");
    int d0;
    if (mode == 0) d0 = n0;
    else if (mode == 1) d0 = 256 * (n0 >> 7) + (n0 & 127);
    else if (mode == 2) d0 = 256 * (n0 >> 7) + 128 + (n0 & 127);
    else { const int seg = n0 >> 9, cc = n0 & 511; d0 = 256 * ((seg >> 1) * 4 + (cc >> 7)) + 128 * (seg & 1) + (cc & 127); }
    const int c = lane & 7;
#pragma unroll
    for (int j = 0; j < 4; ++j) { const int n = (lane >> 3) + 8 * j; const LAS float* s = scr + (8 * c) * 33 + n;
        u32x4 o; o.x = pk2(s[0 * 33], s[1 * 33]); o.y = pk2(s[2 * 33], s[3 * 33]); o.z = pk2(s[4 * 33], s[5 * 33]); o.w = pk2(s[6 * 33], s[7 * 33]);
        *(u32x4*)(WT + (size_t)(d0 + n) * K + k0 + 8 * c) = o; }
    LDS_WAIT(); asm volatile("" ::: "memory");
}
constexpr int IT_G = (D / 64) * (FF / 32), IT_D = (FF / 64) * (D / 32), IT_WIN = (D / 64) * (2048 / 32), IT_WOUT = (D / 64) * (D / 32);
__device__ __forceinline__ void convert_mats(Frame& F, int l, int id_lo, int id_hi, int gw, int NGW) {
    LAS float* scr = (LAS float*)(F.lds + F.wave * 16384);
    unsigned char* ws = F.ws;
    for (int id = id_lo; id < id_hi; ++id) {
        const int nit = (id == 0 || id == 4) ? 2 * IT_G : (id == 1 || id == 5) ? IT_D : (id == 2 ? IT_WIN : IT_WOUT);
        for (int it = gw; it < nit; it += NGW) {
            if (id == 0) { const bool up = it >= IT_G; transpose_item(F.in[up ? I_W1U : I_W1G] + (size_t)l * D * FF, D, FF, (bf16_t*)(ws + WS_WGU1), F.in[I_GF1] + l * D, up ? 2 : 1, scr, up ? it - IT_G : it, F.lane); }
            else if (id == 4) { const bool up = it >= IT_G; transpose_item(F.in[up ? I_W2U : I_W2G] + (size_t)l * D * FF, D, FF, (bf16_t*)(ws + WS_WGU2), F.in[I_GF2] + l * D, up ? 2 : 1, scr, up ? it - IT_G : it, F.lane); }
            else if (id == 1) transpose_item(F.in[I_W1D] + (size_t)l * D * FF, FF, D, (bf16_t*)(ws + WS_WD1), nullptr, 0, scr, it, F.lane);
            else if (id == 5) transpose_item(F.in[I_W2D] + (size_t)l * D * FF, FF, D, (bf16_t*)(ws + WS_WD2), nullptr, 0, scr, it, F.lane);
            else if (id == 2) transpose_item(F.in[I_WIN] + (size_t)l * D * 2048, D, 2048, (bf16_t*)(ws + WS_WIN), F.in[I_GMIX] + l * D, 3, scr, it, F.lane);
            else transpose_item(F.in[I_WOUT] + (size_t)l * D * D, D, D, (bf16_t*)(ws + WS_WOUT), nullptr, 0, scr, it, F.lane);
        }
    }
}

__device__ __forceinline__ void p0_prologue(Frame& F) {
    convert_mats(F, 0, 0, 3, blockIdx.x * NWAVES + F.wave, F.G * NWAVES);
    const int gw = blockIdx.x * NWAVES + F.wave, NGW = F.G * NWAVES;
    float* X = (float*)(F.ws + WS_X); bf16_t* XB = (bf16_t*)(F.ws + WS_XB); float* ss = (float*)(F.ws + WS_SS);
    for (int r = gw; r < MPAD; r += NGW) {
        const float* src = nullptr;
        if (r < MP) { const int b = r / TP, tt = r - b * TP; src = tt < NMETA ? F.in[I_META] + (size_t)tt * D : F.in[I_XP] + ((size_t)b * SEQ + (tt - NMETA)) * D; }
        else if (r < MR) src = F.in[I_XS] + (size_t)(r - MP) * D;
        f32x4 v[4]; float s = 0.f;
#pragma unroll
        for (int j = 0; j < 4; ++j) { v[j] = src ? __builtin_nontemporal_load((const f32x4*)src + F.lane + 64 * j) : (f32x4){0.f, 0.f, 0.f, 0.f}; s += (v[j][0] * v[j][0] + v[j][1] * v[j][1]) + (v[j][2] * v[j][2] + v[j][3] * v[j][3]); }
        s = wave_sum(s);
#pragma unroll
        for (int j = 0; j < 4; ++j) { ((f32x4*)(X + (size_t)r * D))[F.lane + 64 * j] = v[j];
            u32x2 w; w.x = pk2(v[j][0], v[j][1]); w.y = pk2(v[j][2], v[j][3]); ((u32x2*)(XB + (size_t)r * D))[F.lane + 64 * j] = w; }
        if (F.lane == 0) ss[r] = s;
    }
    { const int i = blockIdx.x * 512 + F.tid; if (i < 6 * MPAD) ss[MPAD + i] = 0.f; }
}

__device__ __forceinline__ void final_phase(Frame& F) {
    const int gw = blockIdx.x * NWAVES + F.wave, NGW = F.G * NWAVES;
    const float* X = (const float*)(F.ws + WS_X); const float* ss = (const float*)(F.ws + WS_SS) + 6 * MPAD; const float* g = F.in[I_GFIN];
    f32x4 gv[4];
#pragma unroll
    for (int j = 0; j < 4; ++j) gv[j] = ((const f32x4*)g)[F.lane + 64 * j];
    for (int r = gw; r < MR; r += NGW) {
        float* dst;
        if (r < MP) { const int b = r / TP, tt = r - b * TP; if (tt < NMETA) continue; dst = F.out + O_YP + ((size_t)b * SEQ + (tt - NMETA)) * D; }
        else dst = F.out + O_YS + (size_t)(r - MP) * D;
        const float rstd = __builtin_amdgcn_rsqf(ss[r] * (1.0f / D) + EPS);
#pragma unroll
        for (int j = 0; j < 4; ++j) { const f32x4 v = ((const f32x4*)(X + (size_t)r * D))[F.lane + 64 * j]; __builtin_nontemporal_store(v * rstd * gv[j], (f32x4*)dst + F.lane + 64 * j); }
    }
}

constexpr int LDS_WR = 0, LDS_WI = 16384, LDS_CBT = 32768, LDS_GRP = LDS_CBT + 4 * 64 * 68 * 4, LDS_RED = 0;

__device__ __forceinline__ float reduce_scatter32(float (&v)[32], int lane) {
#define RS_STEP(H, M) { const bool up = (lane & (M)) != 0; _Pragma("unroll") for (int i = 0; i < (H); ++i) { const float snd = up ? v[i] : v[i + (H)], kp = up ? v[i + (H)] : v[i]; v[i] = kp + __shfl_xor(snd, (M)); } }
    RS_STEP(16, 32) RS_STEP(8, 16) RS_STEP(4, 8) RS_STEP(2, 4) RS_STEP(1, 2)
#undef RS_STEP
    return v[0] + __shfl_xor(v[0], 1);
}

__device__ __forceinline__ void mix_job_a(Frame& F, int l, int sp, int gi) {
    const int tid = F.tid, c = 128 * gi + (tid & 127), sub = tid >> 7;
    const bf16_t* U = (const bf16_t*)(F.ws + WS_U); bf16_t* YAB = (bf16_t*)(F.ws + WS_YAB);
    const float* cw = F.in[I_CAW] + (size_t)l * 31 * DA;
    float w[31];
#pragma unroll
    for (int k = 0; k < 31; ++k) w[k] = cw[k * DA + c];
    const float cbias = F.in[I_CAB][l * DA + c], lg = F.in[I_LNG][l * DA + c], lb = F.in[I_LNB][l * DA + c];
    float acc[32];
#pragma unroll
    for (int t = 0; t < 32; ++t) acc[t] = cbias;
    int rowbase, nval;
    if (sp < 136) {
        const int b = sp / 17, k2 = sp - b * 17, nvalid = (k2 == 16) ? 16 : 128, seqrow0 = b * TP, tb = 128 * k2 + 32 * sub;
        nval = nvalid - 32 * sub; rowbase = seqrow0 + tb;
        if (nval > 0) {
#pragma unroll
            for (int tt = 0; tt < 62; ++tt) {
                const int ti = tb - 30 + tt;
                const float v = ti >= 0 ? bf2f(U[(size_t)(seqrow0 + ti) * 512 + c]) : 0.f;
#pragma unroll
                for (int t = 0; t < 32; ++t) { const int kk = tt - t; if (kk >= 0 && kk <= 30) acc[t] += w[kk] * v; }
            }
        }
    } else {
        nval = 32; const int s0 = 16 * (sp - 136) + 4 * sub; rowbase = MP + 8 * s0;
        const float* st = F.in[I_SCA] + (size_t)l * NB_S * 30 * DA;
#pragma unroll
        for (int hs = 0; hs < 4; ++hs) {
            const int s = s0 + hs, rowS = MP + 8 * s;
#pragma unroll
            for (int tt = 0; tt < 38; ++tt) {
                const float v = tt < 30 ? st[((size_t)s * 30 + tt) * DA + c] : bf2f(U[(size_t)(rowS + tt - 30) * 512 + c]);
#pragma unroll
                for (int t = 0; t < 8; ++t) { const int kk = tt - t; if (kk >= 0 && kk <= 30) acc[8 * hs + t] += w[kk] * v; }
            }
        }
    }
    LAS f32x2* red = (LAS f32x2*)(F.lds + LDS_RED);
    float s1[32], s2[32];
#pragma unroll
    for (int t = 0; t < 32; ++t) { s1[t] = acc[t]; s2[t] = acc[t] * acc[t]; }
    const float r1 = reduce_scatter32(s1, F.lane), r2 = reduce_scatter32(s2, F.lane);
    __syncthreads();
    if ((F.lane & 1) == 0) red[F.wave * 32 + (F.lane >> 1)] = (f32x2){r1, r2};
    __syncthreads();
    if (nval > 0) {
#pragma unroll
        for (int t = 0; t < 32; ++t) {
            const f32x2 a = red[F.wave * 32 + t], o = red[(F.wave ^ 1) * 32 + t];
            const float mean = (a.x + o.x) * (1.0f / 128.0f), var = (a.y + o.y) * (1.0f / 128.0f) - mean * mean;
            const float rstd = __builtin_amdgcn_rsqf(fmaxf(var, 0.f) + EPS);
            const float y = (acc[t] - mean) * rstd * lg + lb;
            if (t < nval) YAB[(size_t)(rowbase + t) * D + c] = (bf16_t)f2bf(silu_f(y));
        }
    }
}

constexpr int WJ_TILE = 9728;
constexpr int LDS_WT = 8 * WJ_TILE;
typedef short bf16x8_t __attribute__((ext_vector_type(8)));

__device__ __forceinline__ void mix_b_wave_jobs(Frame& F, int l) {
    const int lane = F.lane, wave = F.wave, fr = lane & 15, fq = lane >> 4, h = blockIdx.x & 7;
    const bf16_t* BX = (const bf16_t*)(F.ws + WS_BX);
    bf16_t* YAB = (bf16_t*)(F.ws + WS_YAB); bf16_t* PCG = (bf16_t*)(F.ws + WS_XB);
    LAS bf16_t* WT = (LAS bf16_t*)(F.lds + LDS_WT);
    LAS bf16_t* tile = (LAS bf16_t*)(F.lds + wave * WJ_TILE);
    __syncthreads();
    {
        const f32x4* gr = (const f32x4*)(F.in[I_WRG] + (size_t)(l * 8 + h) * 4096); const f32x4* gx = (const f32x4*)(F.in[I_WIG] + (size_t)(l * 8 + h) * 4096);
#pragma unroll
        for (int e = 0; e < 2; ++e) {
            const int idx = F.tid + e * 512, i = idx >> 4, j4 = (idx & 15) * 4;
            const f32x4 a = gr[idx], b = gx[idx];
#pragma unroll
            for (int d = 0; d < 4; ++d) { WT[(j4 + d) * 72 + i] = (bf16_t)f2bf(a[d]); WT[(64 + j4 + d) * 72 + i] = (bf16_t)f2bf(b[d]); }
        }
    }
    float bra[4], bix[4], sp[4];
#pragma unroll
    for (int nt = 0; nt < 4; ++nt) {
        const int c = 64 * h + 16 * nt + fr;
        bra[nt] = F.in[I_BRG][l * DB + c]; bix[nt] = F.in[I_BIG][l * DB + c];
        sp[nt] = log1pf(expf(-F.in[I_LAM][l * DB + c]));
    }
    __syncthreads();
    for (int q = (int)(blockIdx.x >> 3) * 8 + wave; q < NQ; q += 256) {
        const bool prompt = q < NQ_P;
        int row0, t0, nvalid;
        if (prompt) { const int b_ = q / NCH_P, k = q - b_ * NCH_P; row0 = b_ * TP + 64 * k; t0 = 64 * k; nvalid = (k == NCH_P - 1) ? 16 : 64; }
        else { row0 = MP + 64 * (q - NQ_P); t0 = 0; nvalid = 64; }
        int ln = lane; asm volatile("" : "+v"(ln));
#pragma unroll
        for (int i = 0; i < 9; ++i) {
            const int p = ln + 64 * i;
            if (p < 536) {
                const int rr = p >> 3, pc = p & 7, row = rr - 3;
                const bool okr = prompt ? (t0 + row >= 0) : (row >= 0);
                u32x4 v = *(const u32x4*)(BX + (size_t)(row0 + (okr ? row : 0)) * 512 + 64 * h + 8 * pc);
                if (!okr) v = (u32x4){0u, 0u, 0u, 0u};
                *(LAS u32x4*)(tile + rr * 72 + 8 * pc) = v;
            }
        }
        float wb[4][4], bb[4];
        { int fr_l = fr; asm volatile("" : "+v"(fr_l));
#pragma unroll
        for (int nt = 0; nt < 4; ++nt) {
            const int c = 64 * h + 16 * nt + fr_l;
#pragma unroll
            for (int k = 0; k < 4; ++k) wb[k][nt] = F.in[I_CBW][((size_t)l * 4 + k) * DB + c];
            bb[nt] = F.in[I_CBB][l * DB + c];
        } }
        float cbv[4][4][4];
#pragma unroll
        for (int mt = 0; mt < 4; ++mt)
#pragma unroll
            for (int nt = 0; nt < 4; ++nt) {
                const int tb = 16 * mt + 4 * fq; float x[7];
#pragma unroll
                for (int i = 0; i < 7; ++i) x[i] = bf2f(tile[(tb + i) * 72 + 16 * nt + fr]);
                if (!prompt && !(fq & 1)) {
                    const int s = 8 * (q - NQ_P) + 2 * mt + (fq >> 1);
                    const float* st = F.in[I_SCB] + ((size_t)l * NB_S + s) * 3 * DB + 64 * h + 16 * nt + fr;
                    x[0] = st[0]; x[1] = st[DB]; x[2] = st[2 * DB];
                }
#pragma unroll
                for (int e = 0; e < 4; ++e) cbv[mt][nt][e] = bb[nt] + wb[0][nt] * x[e] + wb[1][nt] * x[e + 1] + wb[2][nt] * x[e + 2] + wb[3][nt] * x[e + 3];
            }
        asm volatile("s_waitcnt lgkmcnt(0)" ::: "memory");
#pragma unroll
        for (int mt = 0; mt < 4; ++mt)
#pragma unroll
            for (int nt = 0; nt < 4; ++nt)
#pragma unroll
                for (int e = 0; e < 4; ++e) tile[(16 * mt + 4 * fq + e) * 72 + 16 * nt + fr] = (bf16_t)f2bf(cbv[mt][nt][e]);
        asm volatile("s_waitcnt lgkmcnt(0)" ::: "memory");
        float Pc[4] = {1.f, 1.f, 1.f, 1.f}, Hc[4] = {0.f, 0.f, 0.f, 0.f};
#pragma unroll
        for (int mt = 0; mt < 4; ++mt) {
            const bf16x8_t a0 = *(const LAS bf16x8_t*)(tile + (16 * mt + fr) * 72 + 8 * fq), a1 = *(const LAS bf16x8_t*)(tile + (16 * mt + fr) * 72 + 32 + 8 * fq);
#pragma unroll
            for (int nt = 0; nt < 4; ++nt) {
                const int c = 64 * h + 16 * nt + fr;
                const bf16x8_t br0 = *(const LAS bf16x8_t*)(WT + (16 * nt + fr) * 72 + 8 * fq), br1 = *(const LAS bf16x8_t*)(WT + (16 * nt + fr) * 72 + 32 + 8 * fq);
                const bf16x8_t bi0 = *(const LAS bf16x8_t*)(WT + (64 + 16 * nt + fr) * 72 + 8 * fq), bi1 = *(const LAS bf16x8_t*)(WT + (64 + 16 * nt + fr) * 72 + 32 + 8 * fq);
                f32x4 accR = {0.f, 0.f, 0.f, 0.f}, accI = {0.f, 0.f, 0.f, 0.f};
                accR = __builtin_amdgcn_mfma_f32_16x16x32_bf16(a0, br0, accR, 0, 0, 0); accR = __builtin_amdgcn_mfma_f32_16x16x32_bf16(a1, br1, accR, 0, 0, 0);
                accI = __builtin_amdgcn_mfma_f32_16x16x32_bf16(a0, bi0, accI, 0, 0, 0); accI = __builtin_amdgcn_mfma_f32_16x16x32_bf16(a1, bi1, accI, 0, 0, 0);
                float P4[4], H4[4]; float hp = 0.f, pp = 1.f;
#pragma unroll
                for (int e = 0; e < 4; ++e) {
                    const float r = sigmoid_f(accR[e] + bra[nt]), ig = sigmoid_f(accI[e] + bix[nt]);
                    const float la = -8.0f * r * sp[nt], a = __expf(la), bt = __builtin_amdgcn_sqrtf(neg_expm1_f(2.0f * la)) * (ig * bf2f(tile[(16 * mt + 4 * fq + e) * 72 + 16 * nt + fr]));
                    hp = a * hp + bt; pp = pp * a; H4[e] = hp; P4[e] = pp;
                }
                float pex = 1.f, hex = 0.f;
#pragma unroll
                for (int d = 3; d >= 1; --d) {
                    const float ps = __shfl(pp, lane - 16 * d), hs = __shfl(hp, lane - 16 * d);
                    const bool use = prompt ? (fq >= d) : (d == 1 && (fq & 1));
                    if (use) { hex = ps * hex + hs; pex = pex * ps; }
                }
                const float pin = prompt ? Pc[nt] * pex : pex, hin = prompt ? pex * Hc[nt] + hex : hex;
                float Pf[4], Hf[4];
#pragma unroll
                for (int e = 0; e < 4; ++e) { Hf[e] = H4[e] + P4[e] * hin; Pf[e] = P4[e] * pin; }
                Pc[nt] = __shfl(Pf[3], fr + 48); Hc[nt] = __shfl(Hf[3], fr + 48);
#pragma unroll
                for (int e = 0; e < 4; ++e) {
                    const int tl = 16 * mt + 4 * fq + e;
                    if (tl < nvalid) { const size_t row = (size_t)(row0 + tl); YAB[row * D + 512 + c] = (bf16_t)f2bf(Hf[e]); PCG[row * 512 + c] = (bf16_t)f2bf(Pf[e]); }
                }
                if (prompt) { if (16 * (mt + 1) == nvalid && fq == 3) ((f32x2*)(F.ws + WS_SUMM))[(size_t)q * 512 + c] = (f32x2){Pf[3], Hf[3]}; }
                else if (fq & 1) { const int s = 8 * (q - NQ_P) + 2 * mt + (fq >> 1); ((f32x2*)(F.ws + WS_LAST))[(size_t)s * 512 + c] = (f32x2){Pf[3], Hf[3]}; }
            }
        }
    }
}

constexpr int LDS_ARED = 98304;
__device__ __forceinline__ float reduce_scatter16(float (&v)[16], int lane) {
#define RS_STEP(H, M) { const bool up = (lane & (M)) != 0; _Pragma("unroll") for (int i = 0; i < (H); ++i) { const float snd = up ? v[i] : v[i + (H)], kp = up ? v[i + (H)] : v[i]; v[i] = kp + __shfl_xor(snd, (M)); } }
    RS_STEP(8, 32) RS_STEP(4, 16) RS_STEP(2, 8) RS_STEP(1, 4)
#undef RS_STEP
    float r = v[0]; r += __shfl_xor(r, 2); r += __shfl_xor(r, 1); return r;
}
__device__ __forceinline__ void mix_a_wave_jobs(Frame& F, int l) {
    const int lane = F.lane, wave = F.wave, gi = wave & 3, c0 = 128 * gi + 2 * lane;
    const bf16_t* U = (const bf16_t*)(F.ws + WS_U); bf16_t* YAB = (bf16_t*)(F.ws + WS_YAB);
    const float* cw = F.in[I_CAW] + (size_t)l * 31 * DA;
    f32x2 w[31];
#pragma unroll
    for (int k = 0; k < 31; ++k) w[k] = *(const f32x2*)(cw + k * DA + c0);
    const f32x2 cbv = *(const f32x2*)(F.in[I_CAB] + l * DA + c0), lgv = *(const f32x2*)(F.in[I_LNG] + l * DA + c0), lbv = *(const f32x2*)(F.in[I_LNB] + l * DA + c0);
    LAS f32x2* red = (LAS f32x2*)(F.lds + LDS_ARED + wave * 128);
    for (int tb = 511 - ((int)blockIdx.x * 2 + (wave >> 2)); tb < 1096; tb += 512) {
        f32x2 a[16];
#pragma unroll
        for (int t = 0; t < 16; ++t) a[t] = cbv;
        int rowbase;
        if (tb < 1032) {
            const int b = tb / 129, kb = tb - b * 129, t0 = 16 * kb, seqrow0 = b * TP; rowbase = seqrow0 + t0;
            unsigned raw[46];
#pragma unroll
            for (int tt = 0; tt < 46; ++tt) { const int ti = t0 - 30 + tt; raw[tt] = *(const unsigned*)(U + (size_t)(seqrow0 + (ti < 0 ? 0 : ti)) * 512 + c0); }
#pragma unroll
            for (int tt = 0; tt < 46; ++tt) {
                const unsigned rw = ((t0 - 30 + tt) >= 0) ? raw[tt] : 0u;
                const f32x2 v = {__uint_as_float(rw << 16), __uint_as_float(rw & 0xffff0000u)};
#pragma unroll
                for (int t = 0; t < 16; ++t) { const int kk = tt - t; if (kk >= 0 && kk <= 30) a[t] += w[kk] * v; }
            }
        } else {
            const int s0 = 2 * (tb - 1032); rowbase = MP + 8 * s0;
            const float* st = F.in[I_SCA] + (size_t)l * NB_S * 30 * DA;
#pragma unroll
            for (int hs = 0; hs < 2; ++hs) {
                const int s = s0 + hs, rowS = MP + 8 * s;
#pragma unroll
                for (int tt = 0; tt < 38; ++tt) {
                    f32x2 v;
                    if (tt < 30) v = __builtin_nontemporal_load((const f32x2*)(st + ((size_t)s * 30 + tt) * DA + c0));
                    else { const unsigned rw = *(const unsigned*)(U + (size_t)(rowS + tt - 30) * 512 + c0); v = (f32x2){__uint_as_float(rw << 16), __uint_as_float(rw & 0xffff0000u)}; }
#pragma unroll
                    for (int t = 0; t < 8; ++t) { const int kk = tt - t; if (kk >= 0 && kk <= 30) a[8 * hs + t] += w[kk] * v; }
                }
            }
        }
        float s1[16], s2[16];
#pragma unroll
        for (int t = 0; t < 16; ++t) { s1[t] = a[t].x + a[t].y; s2[t] = a[t].x * a[t].x + a[t].y * a[t].y; }
        const float r1 = reduce_scatter16(s1, lane), r2 = reduce_scatter16(s2, lane);
        if ((lane & 3) == 0) red[lane >> 2] = (f32x2){r1, r2};
        asm volatile("s_waitcnt lgkmcnt(0)" ::: "memory");
#pragma unroll
        for (int t = 0; t < 16; ++t) {
            const f32x2 st_ = red[t];
            const float mean = st_.x * (1.0f / 128.0f), var = st_.y * (1.0f / 128.0f) - mean * mean;
            const float rstd = __builtin_amdgcn_rsqf(fmaxf(var, 0.f) + EPS);
            const f32x2 y = (a[t] - mean) * rstd * lgv + lbv;
            *(unsigned*)(YAB + (size_t)(rowbase + t) * D + c0) = pk2(silu_f(y.x), silu_f(y.y));
        }
        asm volatile("s_waitcnt lgkmcnt(0)" ::: "memory");
    }
}

__device__ __forceinline__ void mix_job_state(Frame& F, int l, int s) {
    const int c = F.tid;
    const bf16_t* U = (const bf16_t*)(F.ws + WS_U); const bf16_t* BX = (const bf16_t*)(F.ws + WS_BX);
    if (s < NB_P) {
        const int b = s; float* oa = F.out + O_CAP + ((size_t)l * NB_P + b) * 30 * DA; float* ob = F.out + O_CBP + ((size_t)l * NB_P + b) * 3 * DB;
#pragma unroll 10
        for (int i = 0; i < 30; ++i) __builtin_nontemporal_store(bf2f(U[(size_t)(b * TP + TP - 30 + i) * 512 + c]), oa + i * DA + c);
#pragma unroll
        for (int i = 0; i < 3; ++i) __builtin_nontemporal_store(bf2f(BX[(size_t)(b * TP + TP - 3 + i) * 512 + c]), ob + i * DB + c);
    } else {
        const int b = s - NB_P, rowS = MP + 8 * b; float* oa = F.out + O_CAS + ((size_t)l * NB_S + b) * 30 * DA; float* ob = F.out + O_CBS + ((size_t)l * NB_S + b) * 3 * DB;
        const float* st = F.in[I_SCA] + ((size_t)l * NB_S + b) * 30 * DA;
#pragma unroll 11
        for (int i = 0; i < 22; ++i) __builtin_nontemporal_store(__builtin_nontemporal_load(st + (8 + i) * DA + c), oa + i * DA + c);
#pragma unroll
        for (int i = 22; i < 30; ++i) __builtin_nontemporal_store(bf2f(U[(size_t)(rowS + i - 22) * 512 + c]), oa + i * DA + c);
#pragma unroll
        for (int i = 0; i < 3; ++i) __builtin_nontemporal_store(bf2f(BX[(size_t)(rowS + 5 + i) * 512 + c]), ob + i * DB + c);
    }
}

__device__ __forceinline__ void mix_a_phase(Frame& F, int l, int sel) {
    if (sel & 1) mix_b_wave_jobs(F, l);
    if (!(sel & 2)) return;
    { int t_ = F.tid; asm volatile("" : "+v"(t_)); F.tid = t_; F.lane = t_ & 63; }
    mix_a_wave_jobs(F, l);
    { int t_ = F.tid; asm volatile("" : "+v"(t_)); F.tid = t_; F.lane = t_ & 63; }
    const int b = blockIdx.x;
    if (b >= 64 && b - 64 < NB_P + NB_S) mix_job_state(F, l, b - 64);
}

__device__ __forceinline__ void mix_c_phase(Frame& F, int l, int rep) {
    const int c = F.tid;
    bf16_t* YAB = (bf16_t*)(F.ws + WS_YAB); const bf16_t* PCG = (const bf16_t*)(F.ws + WS_XB); const bf16_t* GGp = (const bf16_t*)(F.ws + WS_GG);
    const f32x2* SUMM = (const f32x2*)(F.ws + WS_SUMM); const f32x2* LAST = (const f32x2*)(F.ws + WS_LAST);
    for (int job = blockIdx.x; job < NQ * 2; job += F.G) {
        const int q = job >> 1, hh = job & 1;
        if (q < NQ_P) {
            const int b = q / NCH_P, k = q - b * NCH_P, nvalid = (k == NCH_P - 1) ? 16 : 64, row0 = b * TP + 64 * k;
            if (32 * hh >= nvalid) continue;
            float carry = 0.f;
            {
                f32x2 ph[32];
#pragma unroll
                for (int e = 0; e < 32; ++e) { const int kk = e < k ? e : 0; ph[e] = SUMM[(size_t)(b * NCH_P + kk) * 512 + c]; }
#pragma unroll
                for (int e = 0; e < 32; ++e) { const float px = e < k ? ph[e].x : 1.f, py = e < k ? ph[e].y : 0.f; carry = px * carry + py; }
            }
            const int r1 = (32 * hh + 32 < nvalid) ? 32 * hh + 32 : nvalid;
            for (int r = 32 * hh; r < r1; ++r) {
                const size_t row = row0 + r;
                const float y = (bf2f(YAB[row * D + 512 + c]) + bf2f(PCG[row * 512 + c]) * carry) * bf2f(GGp[row * 512 + c]);
                if (rep) ((bf16_t*)(F.ws + WS_U))[row * 512 + c] = (bf16_t)f2bf(y); else
                YAB[row * D + 512 + c] = (bf16_t)f2bf(y);
            }
            if (k == NCH_P - 1 && hh == 0) { const f32x2 ph = SUMM[(size_t)q * 512 + c]; F.out[O_HP + ((size_t)l * NB_P + b) * DB + c] = ph.y + ph.x * carry; }
        } else {
            const int row0 = MP + 64 * (q - NQ_P);
            for (int r = 32 * hh; r < 32 * hh + 32; ++r) {
                const int s = 8 * (q - NQ_P) + (r >> 3); const size_t row = row0 + r;
                const float carry = F.in[I_SH][((size_t)l * NB_S + s) * DB + c];
                const float y = (bf2f(YAB[row * D + 512 + c]) + bf2f(PCG[row * 512 + c]) * carry) * bf2f(GGp[row * 512 + c]);
                if (rep) ((bf16_t*)(F.ws + WS_U))[row * 512 + c] = (bf16_t)f2bf(y); else
                YAB[row * D + 512 + c] = (bf16_t)f2bf(y);
                if ((r & 7) == 7) { const f32x2 ph = LAST[(size_t)s * 512 + c]; F.out[O_HS + ((size_t)l * NB_S + s) * DB + c] = ph.y + ph.x * carry; }
            }
        }
    }
}

constexpr int NPH = 18;
#ifndef PHMASK
#define PHMASK 127
#endif
#define DUPMASK 0
#define MIXSEL 1
__global__ void __launch_bounds__(NWAVES * 64, 2) mega_fwd(Args args) {
    extern __shared__ __attribute__((aligned(16))) unsigned char lds[];
    Frame F;
    F.lds = (LAS unsigned char*)lds; F.G = gridDim.x;
    if (threadIdx.x < 2) ((volatile LAS unsigned*)(F.lds + LDS_BARST))[threadIdx.x] = 0u;
    __syncthreads();
    if (args.ph_hi - args.ph_lo > 1) (void)xcd_barrier_post((unsigned*)(args.ws + WS_BAR), (volatile LAS unsigned*)(F.lds + LDS_BARST));
    const int ph_lo = args.ph_lo, ph_hi = args.ph_hi;
    const int wave_s = __builtin_amdgcn_readfirstlane(threadIdx.x >> 6);
    for (int st = 2 * ph_lo; st < 2 * ph_hi; ++st) {
        const int ph = st >> 1, rep = st & 1;
        bool run = true;
        if (rep == 1) { const int ty = (ph == 0) ? 1 : (ph == NPH - 1) ? 2 : (int)((0x0804084020100804ull >> (8 * ((ph - 1) & 7))) & 255ull);
            run = (DUPMASK & ty) != 0; }
        if (run) {
        const __attribute__((address_space(4))) unsigned char* kp = (const __attribute__((address_space(4))) unsigned char*)__builtin_amdgcn_kernarg_segment_ptr();
        asm volatile("" : "+s"(kp));
        const __attribute__((address_space(4))) Args* ap = (const __attribute__((address_space(4))) Args*)kp;
        F.in = ap->in; F.out = ap->out; F.ws = ap->ws;
        { int t_ = wave_s * 64 + hw_lane_id(); asm volatile("" : "+v"(t_)); F.tid = t_; F.lane = t_ & 63; F.wave = wave_s; }
        unsigned char* ws = F.ws;
        float* SS = (float*)(ws + WS_SS);
        if ((PHMASK & 1) && ph == 0) p0_prologue(F);
        else if ((PHMASK & 2) && ph == NPH - 1) final_phase(F);
        else {
            const int l = (ph - 1) >> 3, s = (ph - 1) & 7;
            if ((PHMASK & 4) && (s == 0 || s == 6)) {
                pg8::Gemm g{(const bf16_t*)(ws + WS_XB), (const bf16_t*)(ws + (s == 0 ? WS_WGU1 : WS_WGU2)), MPAD, 2 * FF, D};
                pg8::StaticOrder S; S.init(MPAD, 2 * FF, D, F.G, (int)blockIdx.x);
                EpiGU E{(bf16_t*)(ws + WS_ACT), SS + (size_t)(s == 0 ? 3 * l : 3 * l + 2) * MPAD};
                pg8::gemm_phase<EpiGU, pg8::StaticOrder, true, true>(F.lds, g, S, E, wave_s);
            } else if ((PHMASK & 8) && (s == 1 || s == 7 || s == 5)) {
                const bool down = (s != 5);
                pg8::Gemm g{(const bf16_t*)(ws + (down ? WS_ACT : WS_YAB)), (const bf16_t*)(ws + (s == 1 ? WS_WD1 : (s == 7 ? WS_WD2 : WS_WOUT))), MPAD, D, down ? FF : D};
                pg8::DpSplit S; S.init(MPAD, D, down ? FF : D, F.G, (int)blockIdx.x, F.out);
                EpiRes E{(float*)(ws + WS_X), (bf16_t*)(ws + WS_XB), (rep ? (float*)(ws + 0x300000) : SS + (size_t)(s == 1 ? 3 * l + 1 : (s == 5 ? 3 * l + 2 : 3 * l + 3)) * MPAD), rep ? 0.0f : (down ? 0.5f : 1.0f)};
                pg8::gemm_phase<EpiRes, pg8::DpSplit, true, true>(F.lds, g, S, E, wave_s);
                if (blockIdx.x >= 80 && rep == 0) {
                    const int gw = ((int)blockIdx.x - 80) * NWAVES + F.wave, NGW = (F.G - 80) * NWAVES;
                    if (l == 0 && s == 1) { convert_mats(F, 0, 3, 5, gw, NGW); convert_mats(F, 1, 0, 1, gw, NGW); }
                    else if (l == 0 && s == 5) convert_mats(F, 0, 5, 6, gw, NGW);
                    else if (l == 0 && s == 7) convert_mats(F, 1, 1, 3, gw, NGW);
                    else if (l == 1 && s == 1) convert_mats(F, 1, 3, 5, gw, NGW);
                    else if (l == 1 && s == 5) convert_mats(F, 1, 5, 6, gw, NGW);
                }
                { XcdBarrier xb; xb.bar = (unsigned*)(ws + WS_BAR); xb.x = xb_xcc_id(); xb.st = (volatile LAS unsigned*)(F.lds + LDS_BARST); xcd_barrier(xb, wave_s == 0 && hw_lane_id() == 0); }
                res_fixup(F, E, S);
            } else if ((PHMASK & 16) && s == 2) {
                pg8::Gemm g{(const bf16_t*)(ws + WS_XB), (const bf16_t*)(ws + WS_WIN), MPAD, 2048, D};
                pg8::StaticOrder S; S.init(MPAD, 2048, D, F.G, (int)blockIdx.x);
                EpiWin E{(bf16_t*)(ws + WS_U), (bf16_t*)(ws + WS_BX), (bf16_t*)(ws + WS_GG), SS + (size_t)(3 * l + 1) * MPAD};
                pg8::gemm_phase<EpiWin, pg8::StaticOrder, true, true>(F.lds, g, S, E, wave_s);
            } else if ((PHMASK & 32) && s == 3) mix_a_phase(F, l, rep ? MIXSEL : 3);
            else if ((PHMASK & 64) && s == 4) mix_c_phase(F, l, rep);
        }
        }
        if (rep == 1 && ph + 1 < ph_hi) {
            const __attribute__((address_space(4))) Args* ap2 = (const __attribute__((address_space(4))) Args*)__builtin_amdgcn_kernarg_segment_ptr();
            unsigned* barw = (unsigned*)(ap2->ws + WS_BAR);
            if (ph_hi > 1000) cg::this_grid().sync();
            XcdBarrier xb; xb.bar = barw; xb.x = xb_xcc_id(); xb.st = (volatile LAS unsigned*)(F.lds + LDS_BARST);
            xcd_barrier(xb, wave_s == 0 && hw_lane_id() == 0);
        }
    }
}

#ifndef MK_FUSED
#define MK_FUSED 1
#endif
extern "C" void kernel_launch(void* const* d_in, const int* in_sizes, int n_in, void* d_out, int out_size, void* d_ws, size_t ws_size, hipStream_t stream) {
    static int grid = 0;
    if (grid == 0) {
        if (n_in != N_IN || (size_t)out_size != O_END || ws_size < WS_END) { fprintf(stderr, "kernel_launch: unexpected shapes: n_in %d out %d ws %zu (need %zu)\n", n_in, out_size, ws_size, (size_t)WS_END); grid = -1; return; }
        int dev = 0, cus = 0, per_cu = 0;
        hipGetDevice(&dev); hipDeviceGetAttribute(&cus, hipDeviceAttributeMultiprocessorCount, dev);
        if (hipFuncSetAttribute((const void*)mega_fwd, hipFuncAttributeMaxDynamicSharedMemorySize, LDS_BYTES) != hipSuccess) { fprintf(stderr, "kernel_launch: hipFuncSetAttribute failed\n"); grid = -1; return; }
        if (hipOccupancyMaxActiveBlocksPerMultiprocessor(&per_cu, (const void*)mega_fwd, NWAVES * 64, LDS_BYTES) != hipSuccess || per_cu < 1) { fprintf(stderr, "kernel_launch: occupancy query failed (%d)\n", per_cu); (void)hipGetLastError(); per_cu = 1; }
        grid = cus * 1;
        fprintf(stderr, "kernel_launch: cus %d per_cu %d grid %d ws %zu\n", cus, per_cu, grid, ws_size);
    }
    if (grid < 0) return;
    Args a{};
    for (int i = 0; i < N_IN; ++i) a.in[i] = (const float*)d_in[i];
    a.out = (float*)d_out; a.ws = (unsigned char*)d_ws;
#if MK_FUSED
    a.ph_lo = 0; a.ph_hi = NPH;
    if (hipMemsetAsync((unsigned char*)d_ws + WS_BAR, 0, 0x10000, stream) != hipSuccess) { fprintf(stderr, "kernel_launch: memset of the barrier words failed\n"); return; }
    void* kargs[] = {&a};
    hipError_t e = hipLaunchCooperativeKernel((const void*)mega_fwd, dim3(grid), dim3(NWAVES * 64), kargs, LDS_BYTES, stream);
    if (e != hipSuccess) fprintf(stderr, "cooperative launch failed: %s (grid %d)\n", hipGetErrorString(e), grid);
#else
    for (int ph = 0; ph < NPH; ++ph) { a.ph_lo = ph; a.ph_hi = ph + 1; hipLaunchKernelGGL(mega_fwd, dim3(grid), dim3(NWAVES * 64), LDS_BYTES, stream, a); }
#endif
}
```

```cpp
#include <hip/hip_runtime.h>
#include <hip/hip_cooperative_groups.h>
#include <cstdio>
#include <cstdint>
namespace cg = cooperative_groups;
__device__ __forceinline__ int hw_lane_id() { int l; asm volatile("v_mbcnt_lo_u32_b32 %0, -1, 0\n\tv_mbcnt_hi_u32_b32 %0, -1, %0" : "=v"(l)); return l; }
namespace pg8 {
#define PG8_LAS __attribute__((address_space(3)))
typedef unsigned short bf16_t;
typedef short bf16x8 __attribute__((ext_vector_type(8)));
typedef float f32x4 __attribute__((ext_vector_type(4)));
typedef unsigned u32x4 __attribute__((ext_vector_type(4)));
constexpr int BM = 256, BK = 64, HALF = 128, HTB = HALF * BK * 2  , STAGE_BYTES = 8 * HTB, NXCD = 8, WGM = 8;

__host__ __device__ __forceinline__ int lds_byte(int r, int c) { const int st = (r >> 4) * 2 + (c >> 5), rr = r & 15, cc = c & 31, ob = rr * 64 + cc * 2; return st * 1024 + (ob ^ (((ob >> 9) & 1) << 5)); }
__host__ __device__ __forceinline__ void stage_rc(int b, int& R, int& C) { const int st = b / 1024, sb = b % 1024, swz = sb ^ (((sb >> 9) & 1) << 5); R = (st >> 1) * 16 + swz / 64; C = (st & 1) * 32 + (swz % 64) / 2; }
__host__ __device__ __forceinline__ int perm32(int rho) { const int n = rho >> 4, i = rho & 15; return 8 * (i >> 2) + 4 * n + (i & 3); }

struct Unit { int pm, pn, k0, len, kind; };
struct Gemm { const bf16_t* A; const bf16_t* Bt; int M, N, K; };

struct StaticOrder {
    static constexpr bool STREAMK = false;
    int nM, nN, nwg, G, c, nt;
    __host__ __device__ void init(int M, int N, int K, int G_, int c_) { nM = M / BM; nN = N / BM; nwg = nM * nN; G = G_; c = c_; nt = K / BK; }
    __host__ __device__ bool next(int i, Unit& u) const {
        const long L = (long)i * G + c; if (L >= nwg) return false;
        int wgid = (int)L; { const int q = nwg / NXCD, r = nwg % NXCD, xcd = wgid % NXCD, off = wgid / NXCD; wgid = (xcd < r ? xcd * (q + 1) : r * (q + 1) + (xcd - r) * q) + off; }
        const int nig = WGM * nN, gid = wgid / nig, fm = gid * WGM, gsz = (nM - fm) < WGM ? (nM - fm) : WGM;
        u.pm = fm + ((wgid % nig) % gsz); u.pn = (wgid % nig) / gsz; u.k0 = 0; u.len = nt; u.kind = 0; return true;
    }
    __device__ __forceinline__ void a_ready(const Unit&) const {}
    __device__ __forceinline__ void done(const Unit&) const {}
    __device__ __forceinline__ void store_partial(const f32x4 (&)[2][2][4][2], int, int, int) const {}
    __device__ __forceinline__ void load_partial(f32x4 (&)[2][2][4][2], int, int, int) const {}
};
struct DpSplit {
    static constexpr bool STREAMK = true;
    int nM, nN, nwg, G, c, nt; float* slab;
    __device__ __forceinline__ void init(int M, int N, int K, int G_, int c_, float* slab_) { nM = M / BM; nN = N / BM; nwg = nM * nN; G = G_; c = c_; nt = K / BK; slab = slab_; }
    __device__ __forceinline__ void unit_of(int L, Unit& u) const {
        int wgid = L; { const int q = nwg / NXCD, r = nwg % NXCD, xcd = wgid % NXCD, off = wgid / NXCD; wgid = (xcd < r ? xcd * (q + 1) : r * (q + 1) + (xcd - r) * q) + off; }
        const int nig = WGM * nN, gid = wgid / nig, fm = gid * WGM, gsz = (nM - fm) < WGM ? (nM - fm) : WGM;
        u.pm = fm + ((wgid % nig) % gsz); u.pn = (wgid % nig) / gsz;
    }
    __device__ __forceinline__ bool next(int i, Unit& u) const {
        if (i == 0) { if (c >= nwg) return false; unit_of(c, u); u.k0 = 0; u.len = nt; u.kind = 0; return true; }
        if (i == 1 && c < 4 * (nwg - G)) {
            unit_of(G + (c >> 2), u);
            const int part = c & 3, lenp = (nt >> 2) & ~1, rem2 = (nt - 4 * lenp) >> 1;
            u.len = lenp + (part < rem2 ? 2 : 0); u.k0 = part * lenp + 2 * (part < rem2 ? part : rem2); u.kind = 1; return true;
        }
        return false;
    }
    __device__ __forceinline__ void a_ready(const Unit&) const {}
    __device__ __forceinline__ void done(const Unit&) const {}
    __device__ __forceinline__ void store_partial(const f32x4 (&acc)[2][2][4][2], int tid, int wid, int lane) const {
        typedef unsigned u32x4v __attribute__((ext_vector_type(4)));
        asm volatile("" : "+v"(tid));
        const __amdgpu_buffer_rsrc_t r = __builtin_amdgcn_make_buffer_rsrc((void*)(slab + (size_t)c * 65536), 0, 262144, 0x00020000);
        const int vo = tid * 16;
#pragma unroll
        for (int ai = 0; ai < 2; ++ai)
#pragma unroll
            for (int bj = 0; bj < 2; ++bj)
#pragma unroll
                for (int m = 0; m < 4; ++m)
#pragma unroll
                    for (int n = 0; n < 2; ++n) __builtin_amdgcn_raw_buffer_store_b128(__builtin_bit_cast(u32x4v, acc[ai][bj][m][n]), r, vo, (((ai * 2 + bj) * 4 + m) * 2 + n) * 8192, 16);
    }
    __device__ __forceinline__ void load_partial(f32x4 (&)[2][2][4][2], int, int, int) const {}
};

template <class Epi, class Sched, bool ALIGN_EPI = false, bool SP2 = false>
__device__ __forceinline__ void gemm_phase(PG8_LAS unsigned char* lds, const Gemm g, const Sched& S, const Epi& E, const int wave_s) {
    int tid_l = wave_s * 64 + hw_lane_id(); asm volatile("" : "+v"(tid_l));
    const int tid = tid_l, wid = __builtin_amdgcn_readfirstlane(tid >> 6), lane = tid & 63, wr = wid >> 2, wc = wid & 3, fr = lane & 15, fq = lane >> 4;
    const int K = g.K, nt = K / BK;
    unsigned voffA[2], voffB[2];
#pragma unroll
    for (int i = 0; i < 2; ++i) { int R, C; stage_rc(tid * 16 + i * 8192, R, C); const int Rb = Epi::PERM ? ((R & ~31) + perm32(R & 31)) : R;
        voffA[i] = (unsigned)(R * K + C) * 2u; voffB[i] = (unsigned)(Rb * K + C) * 2u; }
    const size_t kstep = (size_t)(BK * 2);
    const size_t hstep = (size_t)HALF * K * 2;
    const size_t tstep = 2 * hstep;
    const unsigned ldsw = (unsigned)wid * 1024u;
    const int aoff = lds_byte(wr * 64 + fr, fq * 8), boff = lds_byte(wc * 32 + fr, fq * 8);
#define PG8_SA(b, h) (((b) * 2 + (h)) * HTB)
#define PG8_SB(b, h) ((4 + (b) * 2 + (h)) * HTB)
#define PG8_STAGE(bufoff, gbase, voff) do { _Pragma("unroll") for (int _i = 0; _i < 2; ++_i) \
        __builtin_amdgcn_global_load_lds((const unsigned*)((const char*)(gbase) + (voff)[_i]), (PG8_LAS unsigned*)(lds + (bufoff) + ldsw + _i * 8192), 16, 0, 0); } while (0)
#define PG8_LDA(dst, b, h) do { _Pragma("unroll") for (int m = 0; m < 4; ++m) _Pragma("unroll") for (int k = 0; k < 2; ++k) dst[m][k] = *(const PG8_LAS bf16x8*)(lds + PG8_SA(b, h) + aoff + m * 2048 + k * 1024); } while (0)
#define PG8_LDB(dst, b, h) do { _Pragma("unroll") for (int n = 0; n < 2; ++n) _Pragma("unroll") for (int k = 0; k < 2; ++k) dst[n][k] = *(const PG8_LAS bf16x8*)(lds + PG8_SB(b, h) + boff + n * 2048 + k * 1024); } while (0)
#define PG8_MMA(ai, bj, At, Bt) do { __builtin_amdgcn_s_setprio(1); _Pragma("unroll") for (int m = 0; m < 4; ++m) _Pragma("unroll") for (int n = 0; n < 2; ++n) _Pragma("unroll") for (int k = 0; k < 2; ++k) \
        acc[ai][bj][m][n] = __builtin_amdgcn_mfma_f32_16x16x32_bf16(Bt[n][k], At[m][k], acc[ai][bj][m][n], 0, 0, 0); __builtin_amdgcn_s_setprio(0); } while (0)
#define PG8_WAIT_V(n) asm volatile("s_waitcnt vmcnt(" #n ")" ::: "memory")
#define PG8_WAIT_L(n) asm volatile("s_waitcnt lgkmcnt(" #n ")" ::: "memory")
#define PG8_BAR __builtin_amdgcn_s_barrier()
#define PG8_SCHED __builtin_amdgcn_sched_barrier(0)
    Unit cur, nxt; int ui = 0;
    if (!S.next(0, cur)) return;
    f32x4 acc[2][2][4][2];
#pragma unroll
    for (int a = 0; a < 2; ++a)
#pragma unroll
        for (int b = 0; b < 2; ++b)
#pragma unroll
            for (int m = 0; m < 4; ++m)
#pragma unroll
                for (int n = 0; n < 2; ++n) acc[a][b][m][n] = (f32x4){0.f, 0.f, 0.f, 0.f};
    if (Sched::STREAMK && cur.kind == 2) S.load_partial(acc, tid, wid, lane);
    if constexpr (Epi::INIT_ACC) { if (cur.kind == 0) E.init(acc, cur, wr, wc, fr, fq); }
    bf16x8 At[4][2], B0[2][2], B1[2][2];
    const char* cA = (const char*)g.A + (size_t)cur.pm * tstep + (size_t)cur.k0 * kstep; const char* cB = (const char*)g.Bt + (size_t)cur.pn * tstep + (size_t)cur.k0 * kstep;
    S.a_ready(cur);
    if constexpr (SP2) {
        PG8_STAGE(PG8_SB(0, 0), cB, voffB); PG8_STAGE(PG8_SB(0, 1), cB + hstep, voffB); PG8_STAGE(PG8_SA(0, 0), cA, voffA); PG8_STAGE(PG8_SA(0, 1), cA + hstep, voffA);
        if (wr == 1) PG8_BAR;
        PG8_WAIT_V(2); PG8_BAR;
        PG8_STAGE(PG8_SB(1, 0), cB + kstep, voffB); PG8_STAGE(PG8_SA(1, 0), cA + kstep, voffA); PG8_STAGE(PG8_SB(1, 1), cB + hstep + kstep, voffB);
        PG8_WAIT_V(6); PG8_BAR;
    } else {
        PG8_STAGE(PG8_SB(0, 0), cB, voffB); PG8_STAGE(PG8_SA(0, 0), cA, voffA); PG8_STAGE(PG8_SB(0, 1), cB + hstep, voffB); PG8_STAGE(PG8_SA(0, 1), cA + hstep, voffA);
        if (wr == 1) PG8_BAR;
        PG8_WAIT_V(4); PG8_BAR;
        PG8_STAGE(PG8_SB(1, 0), cB + kstep, voffB); PG8_STAGE(PG8_SA(1, 0), cA + kstep, voffA); PG8_STAGE(PG8_SB(1, 1), cB + hstep + kstep, voffB);
        PG8_WAIT_V(6); PG8_BAR;
    }
    for (;;) {
        const bool has_next = S.next(ui + 1, nxt);
        const char* nA = has_next ? (const char*)g.A + (size_t)nxt.pm * tstep + (size_t)nxt.k0 * kstep : cA; const char* nB = has_next ? (const char*)g.Bt + (size_t)nxt.pn * tstep + (size_t)nxt.k0 * kstep : cB;
        const int clen = cur.len;
        for (int t = 0; t < clen; t += 2) {
            const bool last = (t == clen - 2);
            const char* a1 = cA + (size_t)(t + 1) * kstep;
            const char* a2 = last ? nA : cA + (size_t)(t + 2) * kstep; const char* b2 = last ? nB : cB + (size_t)(t + 2) * kstep;
            const char* a3 = a2 + kstep; const char* b3 = b2 + kstep;
            if (last && has_next) S.a_ready(nxt);
            if constexpr (SP2) {
            PG8_LDB(B0, 0, 0); PG8_LDB(B1, 0, 1); PG8_SCHED; PG8_LDA(At, 0, 0); PG8_STAGE(PG8_SA(1, 1), a1 + hstep, voffA);
            PG8_WAIT_V(8); PG8_WAIT_L(0); PG8_BAR; PG8_MMA(0, 0, At, B0); PG8_MMA(0, 1, At, B1); PG8_BAR; PG8_SCHED;
            PG8_LDA(At, 0, 1); PG8_STAGE(PG8_SB(0, 0), b2, voffB); PG8_STAGE(PG8_SB(0, 1), b2 + hstep, voffB); PG8_STAGE(PG8_SA(0, 0), a2, voffA);
            PG8_WAIT_V(8); PG8_WAIT_L(0); PG8_BAR; PG8_MMA(1, 0, At, B0); PG8_MMA(1, 1, At, B1); PG8_BAR; PG8_SCHED;
            PG8_LDB(B0, 1, 0); PG8_LDB(B1, 1, 1); PG8_SCHED; PG8_LDA(At, 1, 0); PG8_STAGE(PG8_SA(0, 1), a2 + hstep, voffA);
            PG8_WAIT_V(8); PG8_WAIT_L(0); PG8_BAR; PG8_MMA(0, 0, At, B0); PG8_MMA(0, 1, At, B1); PG8_BAR; PG8_SCHED;
            PG8_LDA(At, 1, 1); PG8_STAGE(PG8_SB(1, 0), b3, voffB); PG8_STAGE(PG8_SB(1, 1), b3 + hstep, voffB); PG8_STAGE(PG8_SA(1, 0), a3, voffA);
            PG8_WAIT_V(8); PG8_WAIT_L(0); PG8_BAR; PG8_MMA(1, 0, At, B0); PG8_MMA(1, 1, At, B1); PG8_BAR; PG8_SCHED;
            } else {
            PG8_LDB(B0, 0, 0); PG8_SCHED; PG8_LDA(At, 0, 0); PG8_STAGE(PG8_SA(1, 1), a1 + hstep, voffA);
            PG8_WAIT_L(8); PG8_BAR; PG8_WAIT_L(0); PG8_MMA(0, 0, At, B0); PG8_BAR; PG8_SCHED;
            PG8_LDB(B1, 0, 1); PG8_STAGE(PG8_SB(0, 0), b2, voffB);
            PG8_BAR; PG8_WAIT_L(0); PG8_MMA(0, 1, At, B1); PG8_BAR;
            PG8_LDA(At, 0, 1); PG8_STAGE(PG8_SA(0, 0), a2, voffA);
            PG8_BAR; PG8_WAIT_L(0); PG8_MMA(1, 0, At, B0); PG8_BAR; PG8_SCHED;
            PG8_STAGE(PG8_SB(0, 1), b2 + hstep, voffB);
            PG8_WAIT_V(6); PG8_BAR; PG8_MMA(1, 1, At, B1); PG8_BAR;
            PG8_LDB(B0, 1, 0); PG8_SCHED; PG8_LDA(At, 1, 0); PG8_STAGE(PG8_SA(0, 1), a2 + hstep, voffA);
            PG8_WAIT_L(8); PG8_BAR; PG8_WAIT_L(0); PG8_MMA(0, 0, At, B0); PG8_BAR; PG8_SCHED;
            PG8_LDB(B1, 1, 1); PG8_STAGE(PG8_SB(1, 0), b3, voffB);
            PG8_BAR; PG8_WAIT_L(0); PG8_MMA(0, 1, At, B1); PG8_BAR;
            PG8_LDA(At, 1, 1); PG8_STAGE(PG8_SA(1, 0), a3, voffA);
            PG8_BAR; PG8_WAIT_L(0); PG8_MMA(1, 0, At, B0); PG8_BAR; PG8_SCHED;
            PG8_STAGE(PG8_SB(1, 1), b3 + hstep, voffB);
            PG8_WAIT_V(6); PG8_BAR; PG8_MMA(1, 1, At, B1); PG8_BAR;
            }
        }
        if constexpr (ALIGN_EPI) { if (wr == 0) PG8_BAR; }
        if constexpr (!Epi::AFTER_DRAIN) {
            int fr_l = fr, fq_l = fq; asm volatile("" : "+v"(fr_l), "+v"(fq_l));
            if constexpr (Sched::STREAMK) {
                if (cur.kind == 1) S.store_partial(acc, tid, wid, lane);
                else E(acc, cur, wr, wc, fr_l, fq_l);
            } else E(acc, cur, wr, wc, fr_l, fq_l);
            S.done(cur); }
        if (!has_next) break;
#define PG8_ZERO_ACC() do { _Pragma("unroll") for (int a = 0; a < 2; ++a) _Pragma("unroll") for (int b = 0; b < 2; ++b) _Pragma("unroll") for (int m = 0; m < 4; ++m) _Pragma("unroll") for (int n = 0; n < 2; ++n) acc[a][b][m][n] = (f32x4){0.f, 0.f, 0.f, 0.f}; } while (0)
        if constexpr (Epi::INIT_ACC) {
            if (Sched::STREAMK && nxt.kind == 2) S.load_partial(acc, tid, wid, lane);
            else if (nxt.kind == 0) { int fr_i = fr, fq_i = fq; asm volatile("" : "+v"(fr_i), "+v"(fq_i)); E.init(acc, nxt, wr, wc, fr_i, fq_i); }
            else PG8_ZERO_ACC();
        } else {
            if (Sched::STREAMK && nxt.kind == 2) S.load_partial(acc, tid, wid, lane);
            else PG8_ZERO_ACC();
        }
#undef PG8_ZERO_ACC
        cur = nxt; cA = nA; cB = nB; ++ui;
        if constexpr (ALIGN_EPI) { if (wr == 1) PG8_BAR; }
    }
    PG8_WAIT_V(0);
    if constexpr (!ALIGN_EPI) { if (wr == 0) PG8_BAR; }
    PG8_BAR;
    if constexpr (Epi::AFTER_DRAIN) { E.fused(acc, cur, wr, wc, fr, fq, lds, wid, lane); S.done(cur); }
#undef PG8_SA
#undef PG8_SB
#undef PG8_STAGE
#undef PG8_LDA
#undef PG8_LDB
#undef PG8_MMA
#undef PG8_WAIT_V
#undef PG8_WAIT_L
#undef PG8_BAR
#undef PG8_SCHED
}
}

#define LAS __attribute__((address_space(3)))
typedef unsigned short bf16_t;
typedef float f32x4 __attribute__((ext_vector_type(4)));
typedef float f32x2 __attribute__((ext_vector_type(2)));
typedef unsigned u32x4 __attribute__((ext_vector_type(4)));
typedef unsigned u32x2 __attribute__((ext_vector_type(2)));

constexpr int D = 1024, FF = 2816, DA = 512, DB = 512;
constexpr int NB_P = 8, TP = 2064, NB_S = 128, TS = 8, NMETA = 16, SEQ = 2048;
constexpr int MP = NB_P * TP;
constexpr int MR = MP + NB_S * TS;
constexpr int MPAD = 17664;
constexpr int NCH_P = 33;
constexpr int NQ_P = NB_P * NCH_P;
constexpr int NQ_S = (NB_S * TS) / 64;
constexpr int NQ = NQ_P + NQ_S;
constexpr float EPS = 1e-6f;
constexpr int NWAVES = 8;

enum { I_XP = 0, I_XS, I_SCA, I_SCB, I_SH, I_META, I_GF1, I_W1G, I_W1U, I_W1D, I_GMIX, I_WIN, I_CAW, I_CAB, I_LNG, I_LNB, I_CBW, I_CBB,
       I_WRG, I_BRG, I_WIG, I_BIG, I_LAM, I_WOUT, I_GF2, I_W2G, I_W2U, I_W2D, I_GFIN, N_IN };
constexpr size_t O_YP = 0, O_YS = O_YP + (size_t)NB_P * SEQ * D, O_CAP = O_YS + (size_t)NB_S * TS * D, O_CBP = O_CAP + (size_t)2 * NB_P * 30 * DA,
                 O_HP = O_CBP + (size_t)2 * NB_P * 3 * DB, O_CAS = O_HP + (size_t)2 * NB_P * DB, O_CBS = O_CAS + (size_t)2 * NB_S * 30 * DA,
                 O_HS = O_CBS + (size_t)2 * NB_S * 3 * DB, O_END = O_HS + (size_t)2 * NB_S * DB;

constexpr size_t WS_SS = 0;
constexpr size_t WS_SUMM = 0x80000;
constexpr size_t WS_LAST = 0x1A0000;
constexpr size_t WS_W = 0x400000;
constexpr size_t SZ_WGU = (size_t)2 * FF * D * 2, SZ_WD = (size_t)D * FF * 2, SZ_WIN = (size_t)2048 * D * 2, SZ_WOUT = (size_t)D * D * 2;
constexpr size_t WS_WGU1 = WS_W, WS_WD1 = WS_WGU1 + SZ_WGU, WS_WIN = WS_WD1 + SZ_WD, WS_WOUT = WS_WIN + SZ_WIN, WS_WGU2 = WS_WOUT + SZ_WOUT, WS_WD2 = WS_WGU2 + SZ_WGU;
constexpr size_t WS_X = WS_WD2 + SZ_WD;
constexpr size_t WS_XB = WS_X + (size_t)MPAD * D * 4;
constexpr size_t WS_ACT = WS_XB + (size_t)MPAD * D * 2;
constexpr size_t WS_U = WS_ACT, WS_BX = WS_U + (size_t)MPAD * 512 * 2, WS_GG = WS_BX + (size_t)MPAD * 512 * 2, WS_YAB = WS_GG + (size_t)MPAD * 512 * 2;
constexpr size_t WS_END = WS_ACT + (size_t)MPAD * FF * 2;
static_assert(WS_YAB + (size_t)MPAD * D * 2 <= WS_END, "mixer overlay fits");
static_assert(WS_END <= 268435456, "ws map fits 256 MiB");
static_assert(WS_SS + 7 * (size_t)MPAD * 4 <= WS_SUMM && WS_SUMM + (size_t)NQ * 512 * 8 <= WS_LAST && WS_LAST + (size_t)128 * 512 * 8 <= WS_W, "small buffers");

constexpr int LDS_BYTES = 147456;

__device__ __forceinline__ float bf2f(bf16_t b) { return __uint_as_float(((unsigned)b) << 16); }
__device__ __forceinline__ unsigned pk2(float lo, float hi) { unsigned r; asm("v_cvt_pk_bf16_f32 %0, %1, %2" : "=v"(r) : "v"(lo), "v"(hi)); return r; }
__device__ __forceinline__ unsigned f2bf(float f) { return pk2(f, f) & 0xffffu; }
__device__ __forceinline__ float fast_rcp(float x) { return __builtin_amdgcn_rcpf(x); }
__device__ __forceinline__ float sigmoid_f(float x) { return fast_rcp(1.0f + __expf(-x)); }
__device__ __forceinline__ float silu_f(float x) { return x * sigmoid_f(x); }
__device__ __forceinline__ float gelu_tanh_f(float x) {
    const float u = 0.7978845608028654f * (x + 0.044715f * x * x * x);
    return x * sigmoid_f(2.0f * u);
}
__device__ __forceinline__ float neg_expm1_f(float x) {
    const float p = -x * (1.0f + x * (0.5f + x * (0.16666667f + x * (0.041666668f + x * (0.0083333338f + x * (0.0013888889f + x * 0.0001984127f))))));
    const float q = 1.0f - __expf(x);
    return x > -0.35f ? p : q;
}
__device__ __forceinline__ float wave_sum(float v) {
#pragma unroll
    for (int o = 1; o < 64; o <<= 1) v += __shfl_xor(v, o);
    return v;
}

#define XB_TMO      128
#define XB_XCNT(j)  (256  + 64 * (j))
#define XB_XSUB(j)  (1280 + 64 * (j))
#define XB_XGEN(j)  (2304 + 64 * (j))
#define XB_TOP      3328
#define XB_TOPGEN   3392
#define XCD_BAR_WORDS 3456
#define XB_SPIN_CAP (1u << 18)

__device__ __forceinline__ unsigned xb_ld(unsigned* p)              { return __hip_atomic_load(p, __ATOMIC_RELAXED, __HIP_MEMORY_SCOPE_AGENT); }
__device__ __forceinline__ unsigned xb_add(unsigned* p, unsigned v) { return __hip_atomic_fetch_add(p, v, __ATOMIC_RELAXED, __HIP_MEMORY_SCOPE_AGENT); }
__device__ __forceinline__ unsigned xb_xcc_id() { return (unsigned)__builtin_amdgcn_s_getreg((3 << 11) | 20) & 0xFu; }
#define XB_SPIN(cond, bar) do { unsigned _sp = 0; while (cond) { __builtin_amdgcn_s_sleep(1); \
    if ((++_sp & 255u) == 0u) { if (xb_ld(&(bar)[XB_TMO])) break; if (_sp > XB_SPIN_CAP) { atomicAdd(&(bar)[XB_TMO], 1u); break; } } } } while (0)

struct XcdBarrier {
    unsigned* bar; unsigned x;
    volatile LAS unsigned* st;
};

__device__ __forceinline__ XcdBarrier xcd_barrier_post(unsigned* bar, volatile LAS unsigned* st) {
    XcdBarrier b; b.bar = bar; b.x = xb_xcc_id(); b.st = st;
    if (threadIdx.x == 0) (void)xb_add(&bar[XB_XCNT(b.x)], 1u);
    return b;
}
__device__ __forceinline__ void xcd_barrier_complete(unsigned* bar, unsigned x, unsigned& nloc, unsigned& nx) {
    const unsigned G = gridDim.x * gridDim.y * gridDim.z;
    unsigned sum, cnt, mine, sp = 0u;
    for (;;) {
        sum = 0u; cnt = 0u; mine = 0u;
#pragma unroll
        for (unsigned j = 0; j < 16; ++j) { const unsigned c = xb_ld(&bar[XB_XCNT(j)]); sum += c; cnt += (c > 0u) ? 1u : 0u; mine = (j == x) ? c : mine; }
        if (sum == G) break;
        __builtin_amdgcn_s_sleep(1);
        if ((++sp & 255u) == 0u) { if (xb_ld(&bar[XB_TMO])) break; if (sp > XB_SPIN_CAP) { atomicAdd(&bar[XB_TMO], 1u); break; } }
    }
    nloc = mine > 0u ? mine : 1u; nx = cnt > 0u ? cnt : 1u;
}

__device__ __forceinline__ void xcd_barrier(const XcdBarrier& b, const bool is_t0) {
    asm volatile("s_waitcnt vmcnt(0)" ::: "memory");
    __syncthreads();
    if (is_t0) {
        unsigned* bar = b.bar;
        __builtin_amdgcn_s_waitcnt(0);
        unsigned nloc = b.st[0], nx = b.st[1];
        if (nloc == 0u) { xcd_barrier_complete(bar, b.x, nloc, nx); b.st[0] = nloc; b.st[1] = nx; }
        const unsigned old = xb_add(&bar[XB_XSUB(b.x)], 1u);
        const unsigned gen = old / nloc;
        if (old + 1u == (gen + 1u) * nloc) {
            __builtin_amdgcn_fence(__ATOMIC_RELEASE, "agent");
            asm volatile("s_waitcnt vmcnt(0)" ::: "memory");
            const unsigned og = xb_add(&bar[XB_TOP], 1u);
            const unsigned tg = og / nx;
            if (og + 1u == (tg + 1u) * nx) xb_add(&bar[XB_TOPGEN], 1u);
            else XB_SPIN(xb_ld(&bar[XB_TOPGEN]) == tg, bar);
            __builtin_amdgcn_fence(__ATOMIC_ACQUIRE, "agent");
            xb_add(&bar[XB_XGEN(b.x)], 1u);
            asm volatile("s_waitcnt vmcnt(0)" ::: "memory");
        } else {
            XB_SPIN(xb_ld(&bar[XB_XGEN(b.x)]) == gen, bar);
            __builtin_amdgcn_fence(__ATOMIC_ACQUIRE, "agent");
            asm volatile("s_waitcnt vmcnt(0)" ::: "memory");
        }
    }
    __syncthreads();
}

constexpr size_t WS_BAR = 0x380000;
constexpr int LDS_BARST = 139264;
constexpr size_t WS_SKF = 0x390000;

struct EpiGU {
    static constexpr bool PERM = true, AFTER_DRAIN = false, INIT_ACC = false;
    bf16_t* ACT; const float* ss;
    __device__ __forceinline__ void operator()(const f32x4 (&acc)[2][2][4][2], const pg8::Unit& u, int wr, int wc, int fr, int fq) const {
        const int row0 = u.pm * 256 + wr * 64 + fr, col0 = u.pn * 128 + wc * 32 + 8 * fq;
        float rs[2][4];
#pragma unroll
        for (int ai = 0; ai < 2; ++ai)
#pragma unroll
            for (int m = 0; m < 4; ++m) rs[ai][m] = ss[row0 + ai * 128 + m * 16];
#pragma unroll
        for (int ai = 0; ai < 2; ++ai)
#pragma unroll
            for (int m = 0; m < 4; ++m) {
                const int r = row0 + ai * 128 + m * 16;
                const float rstd = __builtin_amdgcn_rsqf(rs[ai][m] * (1.0f / D) + EPS);
                float o[8];
#pragma unroll
                for (int n = 0; n < 2; ++n)
#pragma unroll
                    for (int e = 0; e < 4; ++e) { const float g = acc[ai][0][m][n][e] * rstd, up = acc[ai][1][m][n][e] * rstd; o[4 * n + e] = silu_f(g) * up; }
                u32x4 w; w.x = pk2(o[0], o[1]); w.y = pk2(o[2], o[3]); w.z = pk2(o[4], o[5]); w.w = pk2(o[6], o[7]);
                *(u32x4*)(ACT + (size_t)r * FF + col0) = w;
            }
    }
};
struct EpiRes {
    static constexpr bool PERM = true, AFTER_DRAIN = false, INIT_ACC = true;
    float* X; bf16_t* XB; float* ssn; float scale;
    __device__ __forceinline__ void init(f32x4 (&acc)[2][2][4][2], const pg8::Unit& u, int wr, int wc, int fr, int fq) const {
        const int row0 = u.pm * 256 + wr * 64 + fr, col0 = u.pn * 256 + wc * 32 + 8 * fq; const float inv = 1.0f / scale;
#pragma unroll
        for (int ai = 0; ai < 2; ++ai)
#pragma unroll
            for (int m = 0; m < 4; ++m)
#pragma unroll
                for (int bj = 0; bj < 2; ++bj) { const float* xp = X + (size_t)(row0 + ai * 128 + m * 16) * D + col0 + bj * 128; acc[ai][bj][m][0] = *(const f32x4*)xp * inv; acc[ai][bj][m][1] = *(const f32x4*)(xp + 4) * inv; }
    }
    __device__ __forceinline__ void operator()(const f32x4 (&acc)[2][2][4][2], const pg8::Unit& u, int wr, int wc, int fr, int fq) const {
        const int row0 = u.pm * 256 + wr * 64 + fr, col0 = u.pn * 256 + wc * 32 + 8 * fq;
#pragma unroll
        for (int ai = 0; ai < 2; ++ai)
#pragma unroll
            for (int m = 0; m < 4; ++m) {
                const int r = row0 + ai * 128 + m * 16; float q = 0.f;
#pragma unroll
                for (int bj = 0; bj < 2; ++bj) {
                    float* xp = X + (size_t)r * D + col0 + bj * 128;
                    const f32x4 v0 = acc[ai][bj][m][0] * scale, v1 = acc[ai][bj][m][1] * scale;
                    *(f32x4*)xp = v0; *(f32x4*)(xp + 4) = v1;
                    u32x4 w; w.x = pk2(v0[0], v0[1]); w.y = pk2(v0[2], v0[3]); w.z = pk2(v1[0], v1[1]); w.w = pk2(v1[2], v1[3]);
                    *(u32x4*)(XB + (size_t)r * D + col0 + bj * 128) = w;
                    q += (v0[0] * v0[0] + v0[1] * v0[1]) + (v0[2] * v0[2] + v0[3] * v0[3]) + (v1[0] * v1[0] + v1[1] * v1[1]) + (v1[2] * v1[2] + v1[3] * v1[3]);
                }
                q += __shfl_xor(q, 16); q += __shfl_xor(q, 32);
                if (fq == 0) atomicAdd(ssn + r, q);
            }
    }
};
struct EpiWin {
    static constexpr bool PERM = true, AFTER_DRAIN = false, INIT_ACC = false;
    bf16_t *U, *BX, *GG; const float* ss;
    __device__ __forceinline__ void operator()(const f32x4 (&acc)[2][2][4][2], const pg8::Unit& u, int wr, int wc, int fr, int fq) const {
        const int row0 = u.pm * 256 + wr * 64 + fr, col0 = (u.pn & 3) * 128 + wc * 32 + 8 * fq;
        const bool isA = u.pn < 4;
        float rs[2][4];
#pragma unroll
        for (int ai = 0; ai < 2; ++ai)
#pragma unroll
            for (int m = 0; m < 4; ++m) rs[ai][m] = ss[row0 + ai * 128 + m * 16];
#pragma unroll
        for (int ai = 0; ai < 2; ++ai)
#pragma unroll
            for (int m = 0; m < 4; ++m) {
                const int r = row0 + ai * 128 + m * 16;
                const float rstd = __builtin_amdgcn_rsqf(rs[ai][m] * (1.0f / D) + EPS);
                float a0[8], a1[8];
#pragma unroll
                for (int n = 0; n < 2; ++n)
#pragma unroll
                    for (int e = 0; e < 4; ++e) { a0[4 * n + e] = acc[ai][0][m][n][e] * rstd; a1[4 * n + e] = acc[ai][1][m][n][e] * rstd; }
                if (isA) {
                    float o[8];
#pragma unroll
                    for (int e = 0; e < 8; ++e) o[e] = a0[e] * sigmoid_f(a1[e]);
                    u32x4 w; w.x = pk2(o[0], o[1]); w.y = pk2(o[2], o[3]); w.z = pk2(o[4], o[5]); w.w = pk2(o[6], o[7]);
                    *(u32x4*)(U + (size_t)r * 512 + col0) = w;
                } else {
                    float o[8];
#pragma unroll
                    for (int e = 0; e < 8; ++e) o[e] = gelu_tanh_f(a1[e]);
                    u32x4 w; w.x = pk2(a0[0], a0[1]); w.y = pk2(a0[2], a0[3]); w.z = pk2(a0[4], a0[5]); w.w = pk2(a0[6], a0[7]);
                    *(u32x4*)(BX + (size_t)r * 512 + col0) = w;
                    u32x4 g; g.x = pk2(o[0], o[1]); g.y = pk2(o[2], o[3]); g.z = pk2(o[4], o[5]); g.w = pk2(o[6], o[7]);
                    *(u32x4*)(GG + (size_t)r * 512 + col0) = g;
                }
            }
    }
};

struct Args { const float* in[N_IN]; float* out; unsigned char* ws; int ph_lo, ph_hi; };
struct Frame {
    LAS unsigned char* lds;
    int tid, lane, wave, G;
    const float* const __attribute__((address_space(4)))* in; float* out; unsigned char* ws;
};
#define LDS_WAIT() asm volatile("s_waitcnt lgkmcnt(0)" ::: "memory")

template <class FrameT>
__device__ __forceinline__ void res_fixup(FrameT& F, const EpiRes& E, const pg8::DpSplit& S) {
    const int nleft = S.nwg - S.G, tid = F.tid, wid = tid >> 6, lane = tid & 63, wr = wid >> 2, wc = wid & 3, fr = lane & 15, fq = lane >> 4;
    for (int item = blockIdx.x; item < nleft * 8; item += F.G) {
        const int j = item >> 3, ai = (item >> 2) & 1, m = item & 3;
        pg8::Unit u; S.unit_of(S.G + j, u);
        const int r = u.pm * 256 + wr * 64 + fr + ai * 128 + m * 16, col0 = u.pn * 256 + wc * 32 + 8 * fq;
        float q = 0.f;
#pragma unroll
        for (int bj = 0; bj < 2; ++bj) {
            f32x4 a0 = {0.f, 0.f, 0.f, 0.f}, a1 = {0.f, 0.f, 0.f, 0.f};
#pragma unroll
            for (int p = 0; p < 4; ++p) {
                const float* sp = S.slab + (size_t)(4 * j + p) * 65536 + (size_t)((((ai * 2 + bj) * 4 + m) * 2) * 2048) + tid * 4;
                a0 += __builtin_nontemporal_load((const f32x4*)sp); a1 += __builtin_nontemporal_load((const f32x4*)(sp + 2048));
            }
            float* xp = E.X + (size_t)r * D + col0 + bj * 128;
            f32x4 v0 = *(f32x4*)xp, v1 = *(f32x4*)(xp + 4);
            v0 = v0 + a0 * E.scale; v1 = v1 + a1 * E.scale;
            *(f32x4*)xp = v0; *(f32x4*)(xp + 4) = v1;
            u32x4 w; w.x = pk2(v0[0], v0[1]); w.y = pk2(v0[2], v0[3]); w.z = pk2(v1[0], v1[1]); w.w = pk2(v1[2], v1[3]);
            *(u32x4*)(E.XB + (size_t)r * D + col0 + bj * 128) = w;
            q += (v0[0] * v0[0] + v0[1] * v0[1]) + (v0[2] * v0[2] + v0[3] * v0[3]) + (v1[0] * v1[0] + v1[1] * v1[1]) + (v1[2] * v1[2] + v1[3] * v1[3]);
        }
        q += __shfl_xor(q, 16); q += __shfl_xor(q, 32);
        if (fq == 0) atomicAdd(E.ssn + r, q);
    }
}


__device__ __forceinline__ void transpose_item(const float* W, int K, int N, bf16_t* WT, const float* g, int mode, LAS float* scr, int item, int lane) {
    const int nblk = N / 32, kb = item / nblk, nb = item % nblk, k0 = 64 * kb, n0 = 32 * nb;
    float tv[32];
#pragma unroll
    for (int i = 0; i < 32; ++i) { const int kk = 2 * i + (lane >> 5); tv[i] = __builtin_nontemporal_load(W + (size_t)(k0 + kk) * N + n0 + (lane & 31)); }
    if (g) {
#pragma unroll
        for (int i = 0; i < 32; ++i) tv[i] *= g[k0 + 2 * i + (lane >> 5)];
    }
#pragma unroll
    for (int i = 0; i < 32; ++i) scr[(2 * i + (lane >> 5)) * 33 + (lane & 31)] = tv[i];
    LDS_WAIT(); asm volatile("" ::: "memory");
    int d0;
    if (mode == 0) d0 = n0;
    else if (mode == 1) d0 = 256 * (n0 >> 7) + (n0 & 127);
    else if (mode == 2) d0 = 256 * (n0 >> 7) + 128 + (n0 & 127);
    else { const int seg = n0 >> 9, cc = n0 & 511; d0 = 256 * ((seg >> 1) * 4 + (cc >> 7)) + 128 * (seg & 1) + (cc & 127); }
    const int c = lane & 7;
#pragma unroll
    for (int j = 0; j < 4; ++j) { const int n = (lane >> 3) + 8 * j; const LAS float* s = scr + (8 * c) * 33 + n;
        u32x4 o; o.x = pk2(s[0 * 33], s[1 * 33]); o.y = pk2(s[2 * 33], s[3 * 33]); o.z = pk2(s[4 * 33], s[5 * 33]); o.w = pk2(s[6 * 33], s[7 * 33]);
        *(u32x4*)(WT + (size_t)(d0 + n) * K + k0 + 8 * c) = o; }
    LDS_WAIT(); asm volatile("" ::: "memory");
}
constexpr int IT_G = (D / 64) * (FF / 32), IT_D = (FF / 64) * (D / 32), IT_WIN = (D / 64) * (2048 / 32), IT_WOUT = (D / 64) * (D / 32);
__device__ __forceinline__ void convert_mats(Frame& F, int l, int id_lo, int id_hi, int gw, int NGW) {
    LAS float* scr = (LAS float*)(F.lds + F.wave * 16384);
    unsigned char* ws = F.ws;
    for (int id = id_lo; id < id_hi; ++id) {
        const int nit = (id == 0 || id == 4) ? 2 * IT_G : (id == 1 || id == 5) ? IT_D : (id == 2 ? IT_WIN : IT_WOUT);
        for (int it = gw; it < nit; it += NGW) {
            if (id == 0) { const bool up = it >= IT_G; transpose_item(F.in[up ? I_W1U : I_W1G] + (size_t)l * D * FF, D, FF, (bf16_t*)(ws + WS_WGU1), F.in[I_GF1] + l * D, up ? 2 : 1, scr, up ? it - IT_G : it, F.lane); }
            else if (id == 4) { const bool up = it >= IT_G; transpose_item(F.in[up ? I_W2U : I_W2G] + (size_t)l * D * FF, D, FF, (bf16_t*)(ws + WS_WGU2), F.in[I_GF2] + l * D, up ? 2 : 1, scr, up ? it - IT_G : it, F.lane); }
            else if (id == 1) transpose_item(F.in[I_W1D] + (size_t)l * D * FF, FF, D, (bf16_t*)(ws + WS_WD1), nullptr, 0, scr, it, F.lane);
            else if (id == 5) transpose_item(F.in[I_W2D] + (size_t)l * D * FF, FF, D, (bf16_t*)(ws + WS_WD2), nullptr, 0, scr, it, F.lane);
            else if (id == 2) transpose_item(F.in[I_WIN] + (size_t)l * D * 2048, D, 2048, (bf16_t*)(ws + WS_WIN), F.in[I_GMIX] + l * D, 3, scr, it, F.lane);
            else transpose_item(F.in[I_WOUT] + (size_t)l * D * D, D, D, (bf16_t*)(ws + WS_WOUT), nullptr, 0, scr, it, F.lane);
        }
    }
}

__device__ __forceinline__ void p0_prologue(Frame& F) {
    convert_mats(F, 0, 0, 3, blockIdx.x * NWAVES + F.wave, F.G * NWAVES);
    const int gw = blockIdx.x * NWAVES + F.wave, NGW = F.G * NWAVES;
    float* X = (float*)(F.ws + WS_X); bf16_t* XB = (bf16_t*)(F.ws + WS_XB); float* ss = (float*)(F.ws + WS_SS);
    for (int r = gw; r < MPAD; r += NGW) {
        const float* src = nullptr;
        if (r < MP) { const int b = r / TP, tt = r - b * TP; src = tt < NMETA ? F.in[I_META] + (size_t)tt * D : F.in[I_XP] + ((size_t)b * SEQ + (tt - NMETA)) * D; }
        else if (r < MR) src = F.in[I_XS] + (size_t)(r - MP) * D;
        f32x4 v[4]; float s = 0.f;
#pragma unroll
        for (int j = 0; j < 4; ++j) { v[j] = src ? __builtin_nontemporal_load((const f32x4*)src + F.lane + 64 * j) : (f32x4){0.f, 0.f, 0.f, 0.f}; s += (v[j][0] * v[j][0] + v[j][1] * v[j][1]) + (v[j][2] * v[j][2] + v[j][3] * v[j][3]); }
        s = wave_sum(s);
#pragma unroll
        for (int j = 0; j < 4; ++j) { ((f32x4*)(X + (size_t)r * D))[F.lane + 64 * j] = v[j];
            u32x2 w; w.x = pk2(v[j][0], v[j][1]); w.y = pk2(v[j][2], v[j][3]); ((u32x2*)(XB + (size_t)r * D))[F.lane + 64 * j] = w; }
        if (F.lane == 0) ss[r] = s;
    }
    { const int i = blockIdx.x * 512 + F.tid; if (i < 6 * MPAD) ss[MPAD + i] = 0.f; }
}

__device__ __forceinline__ void final_phase(Frame& F) {
    const int gw = blockIdx.x * NWAVES + F.wave, NGW = F.G * NWAVES;
    const float* X = (const float*)(F.ws + WS_X); const float* ss = (const float*)(F.ws + WS_SS) + 6 * MPAD; const float* g = F.in[I_GFIN];
    f32x4 gv[4];
#pragma unroll
    for (int j = 0; j < 4; ++j) gv[j] = ((const f32x4*)g)[F.lane + 64 * j];
    for (int r = gw; r < MR; r += NGW) {
        float* dst;
        if (r < MP) { const int b = r / TP, tt = r - b * TP; if (tt < NMETA) continue; dst = F.out + O_YP + ((size_t)b * SEQ + (tt - NMETA)) * D; }
        else dst = F.out + O_YS + (size_t)(r - MP) * D;
        const float rstd = __builtin_amdgcn_rsqf(ss[r] * (1.0f / D) + EPS);
#pragma unroll
        for (int j = 0; j < 4; ++j) { const f32x4 v = ((const f32x4*)(X + (size_t)r * D))[F.lane + 64 * j]; __builtin_nontemporal_store(v * rstd * gv[j], (f32x4*)dst + F.lane + 64 * j); }
    }
}

constexpr int LDS_WR = 0, LDS_WI = 16384, LDS_CBT = 32768, LDS_GRP = LDS_CBT + 4 * 64 * 68 * 4, LDS_RED = 0;

__device__ __forceinline__ float reduce_scatter32(float (&v)[32], int lane) {
#define RS_STEP(H, M) { const bool up = (lane & (M)) != 0; _Pragma("unroll") for (int i = 0; i < (H); ++i) { const float snd = up ? v[i] : v[i + (H)], kp = up ? v[i + (H)] : v[i]; v[i] = kp + __shfl_xor(snd, (M)); } }
    RS_STEP(16, 32) RS_STEP(8, 16) RS_STEP(4, 8) RS_STEP(2, 4) RS_STEP(1, 2)
#undef RS_STEP
    return v[0] + __shfl_xor(v[0], 1);
}

__device__ __forceinline__ void mix_job_a(Frame& F, int l, int sp, int gi) {
    const int tid = F.tid, c = 128 * gi + (tid & 127), sub = tid >> 7;
    const bf16_t* U = (const bf16_t*)(F.ws + WS_U); bf16_t* YAB = (bf16_t*)(F.ws + WS_YAB);
    const float* cw = F.in[I_CAW] + (size_t)l * 31 * DA;
    float w[31];
#pragma unroll
    for (int k = 0; k < 31; ++k) w[k] = cw[k * DA + c];
    const float cbias = F.in[I_CAB][l * DA + c], lg = F.in[I_LNG][l * DA + c], lb = F.in[I_LNB][l * DA + c];
    float acc[32];
#pragma unroll
    for (int t = 0; t < 32; ++t) acc[t] = cbias;
    int rowbase, nval;
    if (sp < 136) {
        const int b = sp / 17, k2 = sp - b * 17, nvalid = (k2 == 16) ? 16 : 128, seqrow0 = b * TP, tb = 128 * k2 + 32 * sub;
        nval = nvalid - 32 * sub; rowbase = seqrow0 + tb;
        if (nval > 0) {
#pragma unroll
            for (int tt = 0; tt < 62; ++tt) {
                const int ti = tb - 30 + tt;
                const float v = ti >= 0 ? bf2f(U[(size_t)(seqrow0 + ti) * 512 + c]) : 0.f;
#pragma unroll
                for (int t = 0; t < 32; ++t) { const int kk = tt - t; if (kk >= 0 && kk <= 30) acc[t] += w[kk] * v; }
            }
        }
    } else {
        nval = 32; const int s0 = 16 * (sp - 136) + 4 * sub; rowbase = MP + 8 * s0;
        const float* st = F.in[I_SCA] + (size_t)l * NB_S * 30 * DA;
#pragma unroll
        for (int hs = 0; hs < 4; ++hs) {
            const int s = s0 + hs, rowS = MP + 8 * s;
#pragma unroll
            for (int tt = 0; tt < 38; ++tt) {
                const float v = tt < 30 ? st[((size_t)s * 30 + tt) * DA + c] : bf2f(U[(size_t)(rowS + tt - 30) * 512 + c]);
#pragma unroll
                for (int t = 0; t < 8; ++t) { const int kk = tt - t; if (kk >= 0 && kk <= 30) acc[8 * hs + t] += w[kk] * v; }
            }
        }
    }
    LAS f32x2* red = (LAS f32x2*)(F.lds + LDS_RED);
    float s1[32], s2[32];
#pragma unroll
    for (int t = 0; t < 32; ++t) { s1[t] = acc[t]; s2[t] = acc[t] * acc[t]; }
    const float r1 = reduce_scatter32(s1, F.lane), r2 = reduce_scatter32(s2, F.lane);
    __syncthreads();
    if ((F.lane & 1) == 0) red[F.wave * 32 + (F.lane >> 1)] = (f32x2){r1, r2};
    __syncthreads();
    if (nval > 0) {
#pragma unroll
        for (int t = 0; t < 32; ++t) {
            const f32x2 a = red[F.wave * 32 + t], o = red[(F.wave ^ 1) * 32 + t];
            const float mean = (a.x + o.x) * (1.0f / 128.0f), var = (a.y + o.y) * (1.0f / 128.0f) - mean * mean;
            const float rstd = __builtin_amdgcn_rsqf(fmaxf(var, 0.f) + EPS);
            const float y = (acc[t] - mean) * rstd * lg + lb;
            if (t < nval) YAB[(size_t)(rowbase + t) * D + c] = (bf16_t)f2bf(silu_f(y));
        }
    }
}

constexpr int WJ_TILE = 9728;
constexpr int LDS_WT = 8 * WJ_TILE;
typedef short bf16x8_t __attribute__((ext_vector_type(8)));

__device__ __forceinline__ void mix_b_wave_jobs(Frame& F, int l) {
    const int lane = F.lane, wave = F.wave, fr = lane & 15, fq = lane >> 4, h = blockIdx.x & 7;
    const bf16_t* BX = (const bf16_t*)(F.ws + WS_BX);
    bf16_t* YAB = (bf16_t*)(F.ws + WS_YAB); bf16_t* PCG = (bf16_t*)(F.ws + WS_XB);
    LAS bf16_t* WT = (LAS bf16_t*)(F.lds + LDS_WT);
    LAS bf16_t* tile = (LAS bf16_t*)(F.lds + wave * WJ_TILE);
    __syncthreads();
    {
        const f32x4* gr = (const f32x4*)(F.in[I_WRG] + (size_t)(l * 8 + h) * 4096); const f32x4* gx = (const f32x4*)(F.in[I_WIG] + (size_t)(l * 8 + h) * 4096);
#pragma unroll
        for (int e = 0; e < 2; ++e) {
            const int idx = F.tid + e * 512, i = idx >> 4, j4 = (idx & 15) * 4;
            const f32x4 a = gr[idx], b = gx[idx];
#pragma unroll
            for (int d = 0; d < 4; ++d) { WT[(j4 + d) * 72 + i] = (bf16_t)f2bf(a[d]); WT[(64 + j4 + d) * 72 + i] = (bf16_t)f2bf(b[d]); }
        }
    }
    float bra[4], bix[4], sp[4];
#pragma unroll
    for (int nt = 0; nt < 4; ++nt) {
        const int c = 64 * h + 16 * nt + fr;
        bra[nt] = F.in[I_BRG][l * DB + c]; bix[nt] = F.in[I_BIG][l * DB + c];
        sp[nt] = log1pf(expf(-F.in[I_LAM][l * DB + c]));
    }
    __syncthreads();
    for (int q = (int)(blockIdx.x >> 3) * 8 + wave; q < NQ; q += 256) {
        const bool prompt = q < NQ_P;
        int row0, t0, nvalid;
        if (prompt) { const int b_ = q / NCH_P, k = q - b_ * NCH_P; row0 = b_ * TP + 64 * k; t0 = 64 * k; nvalid = (k == NCH_P - 1) ? 16 : 64; }
        else { row0 = MP + 64 * (q - NQ_P); t0 = 0; nvalid = 64; }
        int ln = lane; asm volatile("" : "+v"(ln));
#pragma unroll
        for (int i = 0; i < 9; ++i) {
            const int p = ln + 64 * i;
            if (p < 536) {
                const int rr = p >> 3, pc = p & 7, row = rr - 3;
                const bool okr = prompt ? (t0 + row >= 0) : (row >= 0);
                u32x4 v = *(const u32x4*)(BX + (size_t)(row0 + (okr ? row : 0)) * 512 + 64 * h + 8 * pc);
                if (!okr) v = (u32x4){0u, 0u, 0u, 0u};
                *(LAS u32x4*)(tile + rr * 72 + 8 * pc) = v;
            }
        }
        float wb[4][4], bb[4];
        { int fr_l = fr; asm volatile("" : "+v"(fr_l));
#pragma unroll
        for (int nt = 0; nt < 4; ++nt) {
            const int c = 64 * h + 16 * nt + fr_l;
#pragma unroll
            for (int k = 0; k < 4; ++k) wb[k][nt] = F.in[I_CBW][((size_t)l * 4 + k) * DB + c];
            bb[nt] = F.in[I_CBB][l * DB + c];
        } }
        float cbv[4][4][4];
#pragma unroll
        for (int mt = 0; mt < 4; ++mt)
#pragma unroll
            for (int nt = 0; nt < 4; ++nt) {
                const int tb = 16 * mt + 4 * fq; float x[7];
#pragma unroll
                for (int i = 0; i < 7; ++i) x[i] = bf2f(tile[(tb + i) * 72 + 16 * nt + fr]);
                if (!prompt && !(fq & 1)) {
                    const int s = 8 * (q - NQ_P) + 2 * mt + (fq >> 1);
                    const float* st = F.in[I_SCB] + ((size_t)l * NB_S + s) * 3 * DB + 64 * h + 16 * nt + fr;
                    x[0] = st[0]; x[1] = st[DB]; x[2] = st[2 * DB];
                }
#pragma unroll
                for (int e = 0; e < 4; ++e) cbv[mt][nt][e] = bb[nt] + wb[0][nt] * x[e] + wb[1][nt] * x[e + 1] + wb[2][nt] * x[e + 2] + wb[3][nt] * x[e + 3];
            }
        asm volatile("s_waitcnt lgkmcnt(0)" ::: "memory");
#pragma unroll
        for (int mt = 0; mt < 4; ++mt)
#pragma unroll
            for (int nt = 0; nt < 4; ++nt)
#pragma unroll
                for (int e = 0; e < 4; ++e) tile[(16 * mt + 4 * fq + e) * 72 + 16 * nt + fr] = (bf16_t)f2bf(cbv[mt][nt][e]);
        asm volatile("s_waitcnt lgkmcnt(0)" ::: "memory");
        float Pc[4] = {1.f, 1.f, 1.f, 1.f}, Hc[4] = {0.f, 0.f, 0.f, 0.f};
#pragma unroll
        for (int mt = 0; mt < 4; ++mt) {
            const bf16x8_t a0 = *(const LAS bf16x8_t*)(tile + (16 * mt + fr) * 72 + 8 * fq), a1 = *(const LAS bf16x8_t*)(tile + (16 * mt + fr) * 72 + 32 + 8 * fq);
#pragma unroll
            for (int nt = 0; nt < 4; ++nt) {
                const int c = 64 * h + 16 * nt + fr;
                const bf16x8_t br0 = *(const LAS bf16x8_t*)(WT + (16 * nt + fr) * 72 + 8 * fq), br1 = *(const LAS bf16x8_t*)(WT + (16 * nt + fr) * 72 + 32 + 8 * fq);
                const bf16x8_t bi0 = *(const LAS bf16x8_t*)(WT + (64 + 16 * nt + fr) * 72 + 8 * fq), bi1 = *(const LAS bf16x8_t*)(WT + (64 + 16 * nt + fr) * 72 + 32 + 8 * fq);
                f32x4 accR = {0.f, 0.f, 0.f, 0.f}, accI = {0.f, 0.f, 0.f, 0.f};
                accR = __builtin_amdgcn_mfma_f32_16x16x32_bf16(a0, br0, accR, 0, 0, 0); accR = __builtin_amdgcn_mfma_f32_16x16x32_bf16(a1, br1, accR, 0, 0, 0);
                accI = __builtin_amdgcn_mfma_f32_16x16x32_bf16(a0, bi0, accI, 0, 0, 0); accI = __builtin_amdgcn_mfma_f32_16x16x32_bf16(a1, bi1, accI, 0, 0, 0);
                float P4[4], H4[4]; float hp = 0.f, pp = 1.f;
#pragma unroll
                for (int e = 0; e < 4; ++e) {
                    const float r = sigmoid_f(accR[e] + bra[nt]), ig = sigmoid_f(accI[e] + bix[nt]);
                    const float la = -8.0f * r * sp[nt], a = __expf(la), bt = __builtin_amdgcn_sqrtf(neg_expm1_f(2.0f * la)) * (ig * bf2f(tile[(16 * mt + 4 * fq + e) * 72 + 16 * nt + fr]));
                    hp = a * hp + bt; pp = pp * a; H4[e] = hp; P4[e] = pp;
                }
                float pex = 1.f, hex = 0.f;
#pragma unroll
                for (int d = 3; d >= 1; --d) {
                    const float ps = __shfl(pp, lane - 16 * d), hs = __shfl(hp, lane - 16 * d);
                    const bool use = prompt ? (fq >= d) : (d == 1 && (fq & 1));
                    if (use) { hex = ps * hex + hs; pex = pex * ps; }
                }
                const float pin = prompt ? Pc[nt] * pex : pex, hin = prompt ? pex * Hc[nt] + hex : hex;
                float Pf[4], Hf[4];
#pragma unroll
                for (int e = 0; e < 4; ++e) { Hf[e] = H4[e] + P4[e] * hin; Pf[e] = P4[e] * pin; }
                Pc[nt] = __shfl(Pf[3], fr + 48); Hc[nt] = __shfl(Hf[3], fr + 48);
#pragma unroll
                for (int e = 0; e < 4; ++e) {
                    const int tl = 16 * mt + 4 * fq + e;
                    if (tl < nvalid) { const size_t row = (size_t)(row0 + tl); YAB[row * D + 512 + c] = (bf16_t)f2bf(Hf[e]); PCG[row * 512 + c] = (bf16_t)f2bf(Pf[e]); }
                }
                if (prompt) { if (16 * (mt + 1) == nvalid && fq == 3) ((f32x2*)(F.ws + WS_SUMM))[(size_t)q * 512 + c] = (f32x2){Pf[3], Hf[3]}; }
                else if (fq & 1) { const int s = 8 * (q - NQ_P) + 2 * mt + (fq >> 1); ((f32x2*)(F.ws + WS_LAST))[(size_t)s * 512 + c] = (f32x2){Pf[3], Hf[3]}; }
            }
        }
    }
}

constexpr int LDS_ARED = 98304;
__device__ __forceinline__ float reduce_scatter16(float (&v)[16], int lane) {
#define RS_STEP(H, M) { const bool up = (lane & (M)) != 0; _Pragma("unroll") for (int i = 0; i < (H); ++i) { const float snd = up ? v[i] : v[i + (H)], kp = up ? v[i + (H)] : v[i]; v[i] = kp + __shfl_xor(snd, (M)); } }
    RS_STEP(8, 32) RS_STEP(4, 16) RS_STEP(2, 8) RS_STEP(1, 4)
#undef RS_STEP
    float r = v[0]; r += __shfl_xor(r, 2); r += __shfl_xor(r, 1); return r;
}
__device__ __forceinline__ void mix_a_wave_jobs(Frame& F, int l) {
    const int lane = F.lane, wave = F.wave, gi = wave & 3, c0 = 128 * gi + 2 * lane;
    const bf16_t* U = (const bf16_t*)(F.ws + WS_U); bf16_t* YAB = (bf16_t*)(F.ws + WS_YAB);
    const float* cw = F.in[I_CAW] + (size_t)l * 31 * DA;
    f32x2 w[31];
#pragma unroll
    for (int k = 0; k < 31; ++k) w[k] = *(const f32x2*)(cw + k * DA + c0);
    const f32x2 cbv = *(const f32x2*)(F.in[I_CAB] + l * DA + c0), lgv = *(const f32x2*)(F.in[I_LNG] + l * DA + c0), lbv = *(const f32x2*)(F.in[I_LNB] + l * DA + c0);
    LAS f32x2* red = (LAS f32x2*)(F.lds + LDS_ARED + wave * 128);
    for (int tb = 511 - ((int)blockIdx.x * 2 + (wave >> 2)); tb < 1096; tb += 512) {
        f32x2 a[16];
#pragma unroll
        for (int t = 0; t < 16; ++t) a[t] = cbv;
        int rowbase;
        if (tb < 1032) {
            const int b = tb / 129, kb = tb - b * 129, t0 = 16 * kb, seqrow0 = b * TP; rowbase = seqrow0 + t0;
            unsigned raw[46];
#pragma unroll
            for (int tt = 0; tt < 46; ++tt) { const int ti = t0 - 30 + tt; raw[tt] = *(const unsigned*)(U + (size_t)(seqrow0 + (ti < 0 ? 0 : ti)) * 512 + c0); }
#pragma unroll
            for (int tt = 0; tt < 46; ++tt) {
                const unsigned rw = ((t0 - 30 + tt) >= 0) ? raw[tt] : 0u;
                const f32x2 v = {__uint_as_float(rw << 16), __uint_as_float(rw & 0xffff0000u)};
#pragma unroll
                for (int t = 0; t < 16; ++t) { const int kk = tt - t; if (kk >= 0 && kk <= 30) a[t] += w[kk] * v; }
            }
        } else {
            const int s0 = 2 * (tb - 1032); rowbase = MP + 8 * s0;
            const float* st = F.in[I_SCA] + (size_t)l * NB_S * 30 * DA;
#pragma unroll
            for (int hs = 0; hs < 2; ++hs) {
                const int s = s0 + hs, rowS = MP + 8 * s;
#pragma unroll
                for (int tt = 0; tt < 38; ++tt) {
                    f32x2 v;
                    if (tt < 30) v = __builtin_nontemporal_load((const f32x2*)(st + ((size_t)s * 30 + tt) * DA + c0));
                    else { const unsigned rw = *(const unsigned*)(U + (size_t)(rowS + tt - 30) * 512 + c0); v = (f32x2){__uint_as_float(rw << 16), __uint_as_float(rw & 0xffff0000u)}; }
#pragma unroll
                    for (int t = 0; t < 8; ++t) { const int kk = tt - t; if (kk >= 0 && kk <= 30) a[8 * hs + t] += w[kk] * v; }
                }
            }
        }
        float s1[16], s2[16];
#pragma unroll
        for (int t = 0; t < 16; ++t) { s1[t] = a[t].x + a[t].y; s2[t] = a[t].x * a[t].x + a[t].y * a[t].y; }
        const float r1 = reduce_scatter16(s1, lane), r2 = reduce_scatter16(s2, lane);
        if ((lane & 3) == 0) red[lane >> 2] = (f32x2){r1, r2};
        asm volatile("s_waitcnt lgkmcnt(0)" ::: "memory");
#pragma unroll
        for (int t = 0; t < 16; ++t) {
            const f32x2 st_ = red[t];
            const float mean = st_.x * (1.0f / 128.0f), var = st_.y * (1.0f / 128.0f) - mean * mean;
            const float rstd = __builtin_amdgcn_rsqf(fmaxf(var, 0.f) + EPS);
            const f32x2 y = (a[t] - mean) * rstd * lgv + lbv;
            *(unsigned*)(YAB + (size_t)(rowbase + t) * D + c0) = pk2(silu_f(y.x), silu_f(y.y));
        }
        asm volatile("s_waitcnt lgkmcnt(0)" ::: "memory");
    }
}

__device__ __forceinline__ void mix_job_state(Frame& F, int l, int s) {
    const int c = F.tid;
    const bf16_t* U = (const bf16_t*)(F.ws + WS_U); const bf16_t* BX = (const bf16_t*)(F.ws + WS_BX);
    if (s < NB_P) {
        const int b = s; float* oa = F.out + O_CAP + ((size_t)l * NB_P + b) * 30 * DA; float* ob = F.out + O_CBP + ((size_t)l * NB_P + b) * 3 * DB;
#pragma unroll 10
        for (int i = 0; i < 30; ++i) __builtin_nontemporal_store(bf2f(U[(size_t)(b * TP + TP - 30 + i) * 512 + c]), oa + i * DA + c);
#pragma unroll
        for (int i = 0; i < 3; ++i) __builtin_nontemporal_store(bf2f(BX[(size_t)(b * TP + TP - 3 + i) * 512 + c]), ob + i * DB + c);
    } else {
        const int b = s - NB_P, rowS = MP + 8 * b; float* oa = F.out + O_CAS + ((size_t)l * NB_S + b) * 30 * DA; float* ob = F.out + O_CBS + ((size_t)l * NB_S + b) * 3 * DB;
        const float* st = F.in[I_SCA] + ((size_t)l * NB_S + b) * 30 * DA;
#pragma unroll 11
        for (int i = 0; i < 22; ++i) __builtin_nontemporal_store(__builtin_nontemporal_load(st + (8 + i) * DA + c), oa + i * DA + c);
#pragma unroll
        for (int i = 22; i < 30; ++i) __builtin_nontemporal_store(bf2f(U[(size_t)(rowS + i - 22) * 512 + c]), oa + i * DA + c);
#pragma unroll
        for (int i = 0; i < 3; ++i) __builtin_nontemporal_store(bf2f(BX[(size_t)(rowS + 5 + i) * 512 + c]), ob + i * DB + c);
    }
}

__device__ __forceinline__ void mix_a_phase(Frame& F, int l, int sel) {
    if (sel & 1) mix_b_wave_jobs(F, l);
    if (!(sel & 2)) return;
    { int t_ = F.tid; asm volatile("" : "+v"(t_)); F.tid = t_; F.lane = t_ & 63; }
    mix_a_wave_jobs(F, l);
    { int t_ = F.tid; asm volatile("" : "+v"(t_)); F.tid = t_; F.lane = t_ & 63; }
    const int b = blockIdx.x;
    if (b >= 64 && b - 64 < NB_P + NB_S) mix_job_state(F, l, b - 64);
}

__device__ __forceinline__ void mix_c_phase(Frame& F, int l, int rep) {
    const int c = F.tid;
    bf16_t* YAB = (bf16_t*)(F.ws + WS_YAB); const bf16_t* PCG = (const bf16_t*)(F.ws + WS_XB); const bf16_t* GGp = (const bf16_t*)(F.ws + WS_GG);
    const f32x2* SUMM = (const f32x2*)(F.ws + WS_SUMM); const f32x2* LAST = (const f32x2*)(F.ws + WS_LAST);
    for (int job = blockIdx.x; job < NQ * 2; job += F.G) {
        const int q = job >> 1, hh = job & 1;
        if (q < NQ_P) {
            const int b = q / NCH_P, k = q - b * NCH_P, nvalid = (k == NCH_P - 1) ? 16 : 64, row0 = b * TP + 64 * k;
            if (32 * hh >= nvalid) continue;
            float carry = 0.f;
            {
                f32x2 ph[32];
#pragma unroll
                for (int e = 0; e < 32; ++e) { const int kk = e < k ? e : 0; ph[e] = SUMM[(size_t)(b * NCH_P + kk) * 512 + c]; }
#pragma unroll
                for (int e = 0; e < 32; ++e) { const float px = e < k ? ph[e].x : 1.f, py = e < k ? ph[e].y : 0.f; carry = px * carry + py; }
            }
            const int r1 = (32 * hh + 32 < nvalid) ? 32 * hh + 32 : nvalid;
            for (int r = 32 * hh; r < r1; ++r) {
                const size_t row = row0 + r;
                const float y = (bf2f(YAB[row * D + 512 + c]) + bf2f(PCG[row * 512 + c]) * carry) * bf2f(GGp[row * 512 + c]);
                if (rep) ((bf16_t*)(F.ws + WS_U))[row * 512 + c] = (bf16_t)f2bf(y); else
                YAB[row * D + 512 + c] = (bf16_t)f2bf(y);
            }
            if (k == NCH_P - 1 && hh == 0) { const f32x2 ph = SUMM[(size_t)q * 512 + c]; F.out[O_HP + ((size_t)l * NB_P + b) * DB + c] = ph.y + ph.x * carry; }
        } else {
            const int row0 = MP + 64 * (q - NQ_P);
            for (int r = 32 * hh; r < 32 * hh + 32; ++r) {
                const int s = 8 * (q - NQ_P) + (r >> 3); const size_t row = row0 + r;
                const float carry = F.in[I_SH][((size_t)l * NB_S + s) * DB + c];
                const float y = (bf2f(YAB[row * D + 512 + c]) + bf2f(PCG[row * 512 + c]) * carry) * bf2f(GGp[row * 512 + c]);
                if (rep) ((bf16_t*)(F.ws + WS_U))[row * 512 + c] = (bf16_t)f2bf(y); else
                YAB[row * D + 512 + c] = (bf16_t)f2bf(y);
                if ((r & 7) == 7) { const f32x2 ph = LAST[(size_t)s * 512 + c]; F.out[O_HS + ((size_t)l * NB_S + s) * DB + c] = ph.y + ph.x * carry; }
            }
        }
    }
}

constexpr int NPH = 18;
#ifndef PHMASK
#define PHMASK 127
#endif
#define DUPMASK 0
#define MIXSEL 1
__global__ void __launch_bounds__(NWAVES * 64, 2) mega_fwd(Args args) {
    extern __shared__ __attribute__((aligned(16))) unsigned char lds[];
    Frame F;
    F.lds = (LAS unsigned char*)lds; F.G = gridDim.x;
    if (threadIdx.x < 2) ((volatile LAS unsigned*)(F.lds + LDS_BARST))[threadIdx.x] = 0u;
    __syncthreads();
    if (args.ph_hi - args.ph_lo > 1) (void)xcd_barrier_post((unsigned*)(args.ws + WS_BAR), (volatile LAS unsigned*)(F.lds + LDS_BARST));
    const int ph_lo = args.ph_lo, ph_hi = args.ph_hi;
    const int wave_s = __builtin_amdgcn_readfirstlane(threadIdx.x >> 6);
    for (int st = 2 * ph_lo; st < 2 * ph_hi; ++st) {
        const int ph = st >> 1, rep = st & 1;
        bool run = true;
        if (rep == 1) { const int ty = (ph == 0) ? 1 : (ph == NPH - 1) ? 2 : (int)((0x0804084020100804ull >> (8 * ((ph - 1) & 7))) & 255ull);
            run = (DUPMASK & ty) != 0; }
        if (run) {
        const __attribute__((address_space(4))) unsigned char* kp = (const __attribute__((address_space(4))) unsigned char*)__builtin_amdgcn_kernarg_segment_ptr();
        asm volatile("" : "+s"(kp));
        const __attribute__((address_space(4))) Args* ap = (const __attribute__((address_space(4))) Args*)kp;
        F.in = ap->in; F.out = ap->out; F.ws = ap->ws;
        { int t_ = wave_s * 64 + hw_lane_id(); asm volatile("" : "+v"(t_)); F.tid = t_; F.lane = t_ & 63; F.wave = wave_s; }
        unsigned char* ws = F.ws;
        float* SS = (float*)(ws + WS_SS);
        if ((PHMASK & 1) && ph == 0) p0_prologue(F);
        else if ((PHMASK & 2) && ph == NPH - 1) final_phase(F);
        else {
            const int l = (ph - 1) >> 3, s = (ph - 1) & 7;
            if ((PHMASK & 4) && (s == 0 || s == 6)) {
                pg8::Gemm g{(const bf16_t*)(ws + WS_XB), (const bf16_t*)(ws + (s == 0 ? WS_WGU1 : WS_WGU2)), MPAD, 2 * FF, D};
                pg8::StaticOrder S; S.init(MPAD, 2 * FF, D, F.G, (int)blockIdx.x);
                EpiGU E{(bf16_t*)(ws + WS_ACT), SS + (size_t)(s == 0 ? 3 * l : 3 * l + 2) * MPAD};
                pg8::gemm_phase<EpiGU, pg8::StaticOrder, true, true>(F.lds, g, S, E, wave_s);
            } else if ((PHMASK & 8) && (s == 1 || s == 7 || s == 5)) {
                const bool down = (s != 5);
                pg8::Gemm g{(const bf16_t*)(ws + (down ? WS_ACT : WS_YAB)), (const bf16_t*)(ws + (s == 1 ? WS_WD1 : (s == 7 ? WS_WD2 : WS_WOUT))), MPAD, D, down ? FF : D};
                pg8::DpSplit S; S.init(MPAD, D, down ? FF : D, F.G, (int)blockIdx.x, F.out);
                EpiRes E{(float*)(ws + WS_X), (bf16_t*)(ws + WS_XB), (rep ? (float*)(ws + 0x300000) : SS + (size_t)(s == 1 ? 3 * l + 1 : (s == 5 ? 3 * l + 2 : 3 * l + 3)) * MPAD), rep ? 0.0f : (down ? 0.5f : 1.0f)};
                pg8::gemm_phase<EpiRes, pg8::DpSplit, true, true>(F.lds, g, S, E, wave_s);
                if (blockIdx.x >= 80 && rep == 0) {
                    const int gw = ((int)blockIdx.x - 80) * NWAVES + F.wave, NGW = (F.G - 80) * NWAVES;
                    if (l == 0 && s == 1) { convert_mats(F, 0, 3, 5, gw, NGW); }
                    else if (l == 0 && s == 5) convert_mats(F, 0, 5, 6, gw, NGW);
                    else if (l == 0 && s == 7) convert_mats(F, 1, 2, 3, gw, NGW);
                    else if (l == 1 && s == 1) convert_mats(F, 1, 3, 5, gw, NGW);
                    else if (l == 1 && s == 5) convert_mats(F, 1, 5, 6, gw, NGW);
                }
                { XcdBarrier xb; xb.bar = (unsigned*)(ws + WS_BAR); xb.x = xb_xcc_id(); xb.st = (volatile LAS unsigned*)(F.lds + LDS_BARST); xcd_barrier(xb, wave_s == 0 && hw_lane_id() == 0); }
                res_fixup(F, E, S);
            } else if ((PHMASK & 16) && s == 2) {
                pg8::Gemm g{(const bf16_t*)(ws + WS_XB), (const bf16_t*)(ws + WS_WIN), MPAD, 2048, D};
                pg8::StaticOrder S; S.init(MPAD, 2048, D, F.G, (int)blockIdx.x);
                EpiWin E{(bf16_t*)(ws + WS_U), (bf16_t*)(ws + WS_BX), (bf16_t*)(ws + WS_GG), SS + (size_t)(3 * l + 1) * MPAD};
                pg8::gemm_phase<EpiWin, pg8::StaticOrder, true, true>(F.lds, g, S, E, wave_s);
                if (l == 0 && rep == 0 && blockIdx.x >= 40) {
                    convert_mats(F, 1, 0, 2, ((int)blockIdx.x - 40) * NWAVES + F.wave, (F.G - 40) * NWAVES);
                }
            } else if ((PHMASK & 32) && s == 3) mix_a_phase(F, l, rep ? MIXSEL : 3);
            else if ((PHMASK & 64) && s == 4) mix_c_phase(F, l, rep);
        }
        }
        if (rep == 1 && ph + 1 < ph_hi) {
            const __attribute__((address_space(4))) Args* ap2 = (const __attribute__((address_space(4))) Args*)__builtin_amdgcn_kernarg_segment_ptr();
            unsigned* barw = (unsigned*)(ap2->ws + WS_BAR);
            if (ph_hi > 1000) cg::this_grid().sync();
            XcdBarrier xb; xb.bar = barw; xb.x = xb_xcc_id(); xb.st = (volatile LAS unsigned*)(F.lds + LDS_BARST);
            xcd_barrier(xb, wave_s == 0 && hw_lane_id() == 0);
        }
    }
}

#ifndef MK_FUSED
#define MK_FUSED 1
#endif
extern "C" void kernel_launch(void* const* d_in, const int* in_sizes, int n_in, void* d_out, int out_size, void* d_ws, size_t ws_size, hipStream_t stream) {
    static int grid = 0;
    if (grid == 0) {
        if (n_in != N_IN || (size_t)out_size != O_END || ws_size < WS_END) { fprintf(stderr, "kernel_launch: unexpected shapes: n_in %d out %d ws %zu (need %zu)\n", n_in, out_size, ws_size, (size_t)WS_END); grid = -1; return; }
        int dev = 0, cus = 0, per_cu = 0;
        hipGetDevice(&dev); hipDeviceGetAttribute(&cus, hipDeviceAttributeMultiprocessorCount, dev);
        if (hipFuncSetAttribute((const void*)mega_fwd, hipFuncAttributeMaxDynamicSharedMemorySize, LDS_BYTES) != hipSuccess) { fprintf(stderr, "kernel_launch: hipFuncSetAttribute failed\n"); grid = -1; return; }
        if (hipOccupancyMaxActiveBlocksPerMultiprocessor(&per_cu, (const void*)mega_fwd, NWAVES * 64, LDS_BYTES) != hipSuccess || per_cu < 1) { fprintf(stderr, "kernel_launch: occupancy query failed (%d)\n", per_cu); (void)hipGetLastError(); per_cu = 1; }
        grid = cus * 1;
        fprintf(stderr, "kernel_launch: cus %d per_cu %d grid %d ws %zu\n", cus, per_cu, grid, ws_size);
    }
    if (grid < 0) return;
    Args a{};
    for (int i = 0; i < N_IN; ++i) a.in[i] = (const float*)d_in[i];
    a.out = (float*)d_out; a.ws = (unsigned char*)d_ws;
#if MK_FUSED
    a.ph_lo = 0; a.ph_hi = NPH;
    if (hipMemsetAsync((unsigned char*)d_ws + WS_BAR, 0, 0x10000, stream) != hipSuccess) { fprintf(stderr, "kernel_launch: memset of the barrier words failed\n"); return; }
    void* kargs[] = {&a};
    hipError_t e = hipLaunchCooperativeKernel((const void*)mega_fwd, dim3(grid), dim3(NWAVES * 64), kargs, LDS_BYTES, stream);
    if (e != hipSuccess) fprintf(stderr, "cooperative launch failed: %s (grid %d)\n", hipGetErrorString(e), grid);
#else
    for (int ph = 0; ph < NPH; ++ph) { a.ph_lo = ph; a.ph_hi = ph + 1; hipLaunchKernelGGL(mega_fwd, dim3(grid), dim3(NWAVES * 64), LDS_BYTES, stream, a); }
#endif
}
```

```cpp
#include <hip/hip_runtime.h>
#include <hip/hip_cooperative_groups.h>
#include <cstdio>
#include <cstdint>
namespace cg = cooperative_groups;
__device__ __forceinline__ int hw_lane_id() { int l; asm volatile("v_mbcnt_lo_u32_b32 %0, -1, 0\n\tv_mbcnt_hi_u32_b32 %0, -1, %0" : "=v"(l)); return l; }
namespace pg8 {
#define PG8_LAS __attribute__((address_space(3)))
typedef unsigned short bf16_t;
typedef short bf16x8 __attribute__((ext_vector_type(8)));
typedef float f32x4 __attribute__((ext_vector_type(4)));
typedef unsigned u32x4 __attribute__((ext_vector_type(4)));
constexpr int BM = 256, BK = 64, HALF = 128, HTB = HALF * BK * 2  , STAGE_BYTES = 8 * HTB, NXCD = 8, WGM = 8;

__host__ __device__ __forceinline__ int lds_byte(int r, int c) { const int st = (r >> 4) * 2 + (c >> 5), rr = r & 15, cc = c & 31, ob = rr * 64 + cc * 2; return st * 1024 + (ob ^ (((ob >> 9) & 1) << 5)); }
__host__ __device__ __forceinline__ void stage_rc(int b, int& R, int& C) { const int st = b / 1024, sb = b % 1024, swz = sb ^ (((sb >> 9) & 1) << 5); R = (st >> 1) * 16 + swz / 64; C = (st & 1) * 32 + (swz % 64) / 2; }
__host__ __device__ __forceinline__ int perm32(int rho) { const int n = rho >> 4, i = rho & 15; return 8 * (i >> 2) + 4 * n + (i & 3); }

struct Unit { int pm, pn, k0, len, kind; };
struct Gemm { const bf16_t* A; const bf16_t* Bt; int M, N, K; };

struct StaticOrder {
    static constexpr bool STREAMK = false;
    int nM, nN, nwg, G, c, nt;
    __host__ __device__ void init(int M, int N, int K, int G_, int c_) { nM = M / BM; nN = N / BM; nwg = nM * nN; G = G_; c = c_; nt = K / BK; }
    __host__ __device__ bool next(int i, Unit& u) const {
        const long L = (long)i * G + c; if (L >= nwg) return false;
        int wgid = (int)L; { const int q = nwg / NXCD, r = nwg % NXCD, xcd = wgid % NXCD, off = wgid / NXCD; wgid = (xcd < r ? xcd * (q + 1) : r * (q + 1) + (xcd - r) * q) + off; }
        const int nig = WGM * nN, gid = wgid / nig, fm = gid * WGM, gsz = (nM - fm) < WGM ? (nM - fm) : WGM;
        u.pm = fm + ((wgid % nig) % gsz); u.pn = (wgid % nig) / gsz; u.k0 = 0; u.len = nt; u.kind = 0; return true;
    }
    __device__ __forceinline__ void a_ready(const Unit&) const {}
    __device__ __forceinline__ void done(const Unit&) const {}
    __device__ __forceinline__ void store_partial(const f32x4 (&)[2][2][4][2], int, int, int) const {}
    __device__ __forceinline__ void load_partial(f32x4 (&)[2][2][4][2], int, int, int) const {}
};
struct DpSplit {
    static constexpr bool STREAMK = true;
    int nM, nN, nwg, G, c, nt; float* slab;
    __device__ __forceinline__ void init(int M, int N, int K, int G_, int c_, float* slab_) { nM = M / BM; nN = N / BM; nwg = nM * nN; G = G_; c = c_; nt = K / BK; slab = slab_; }
    __device__ __forceinline__ void unit_of(int L, Unit& u) const {
        int wgid = L; { const int q = nwg / NXCD, r = nwg % NXCD, xcd = wgid % NXCD, off = wgid / NXCD; wgid = (xcd < r ? xcd * (q + 1) : r * (q + 1) + (xcd - r) * q) + off; }
        const int nig = WGM * nN, gid = wgid / nig, fm = gid * WGM, gsz = (nM - fm) < WGM ? (nM - fm) : WGM;
        u.pm = fm + ((wgid % nig) % gsz); u.pn = (wgid % nig) / gsz;
    }
    __device__ __forceinline__ bool next(int i, Unit& u) const {
        if (i == 0) { if (c >= nwg) return false; unit_of(c, u); u.k0 = 0; u.len = nt; u.kind = 0; return true; }
        if (i == 1 && c < 4 * (nwg - G)) {
            unit_of(G + (c >> 2), u);
            const int part = c & 3, lenp = (nt >> 2) & ~1, rem2 = (nt - 4 * lenp) >> 1;
            u.len = lenp + (part < rem2 ? 2 : 0); u.k0 = part * lenp + 2 * (part < rem2 ? part : rem2); u.kind = 1; return true;
        }
        return false;
    }
    __device__ __forceinline__ void a_ready(const Unit&) const {}
    __device__ __forceinline__ void done(const Unit&) const {}
    __device__ __forceinline__ void store_partial(const f32x4 (&acc)[2][2][4][2], int tid, int wid, int lane) const {
        typedef unsigned u32x4v __attribute__((ext_vector_type(4)));
        asm volatile("" : "+v"(tid));
        const __amdgpu_buffer_rsrc_t r = __builtin_amdgcn_make_buffer_rsrc((void*)(slab + (size_t)c * 65536), 0, 262144, 0x00020000);
        const int vo = tid * 16;
#pragma unroll
        for (int ai = 0; ai < 2; ++ai)
#pragma unroll
            for (int bj = 0; bj < 2; ++bj)
#pragma unroll
                for (int m = 0; m < 4; ++m) {
                    const f32x4 p0 = acc[ai][bj][m][0], p1 = acc[ai][bj][m][1]; u32x4v w;
                    asm("v_cvt_pk_bf16_f32 %0, %1, %2" : "=v"(w.x) : "v"(p0[0]), "v"(p0[1])); asm("v_cvt_pk_bf16_f32 %0, %1, %2" : "=v"(w.y) : "v"(p0[2]), "v"(p0[3]));
                    asm("v_cvt_pk_bf16_f32 %0, %1, %2" : "=v"(w.z) : "v"(p1[0]), "v"(p1[1])); asm("v_cvt_pk_bf16_f32 %0, %1, %2" : "=v"(w.w) : "v"(p1[2]), "v"(p1[3]));
                    __builtin_amdgcn_raw_buffer_store_b128(w, r, vo, ((ai * 2 + bj) * 4 + m) * 8192, 16);
                }
    }
    __device__ __forceinline__ void load_partial(f32x4 (&)[2][2][4][2], int, int, int) const {}
};

template <class Epi, class Sched, bool ALIGN_EPI = false, bool SP2 = false>
__device__ __forceinline__ void gemm_phase(PG8_LAS unsigned char* lds, const Gemm g, const Sched& S, const Epi& E, const int wave_s) {
    int tid_l = wave_s * 64 + hw_lane_id(); asm volatile("" : "+v"(tid_l));
    const int tid = tid_l, wid = __builtin_amdgcn_readfirstlane(tid >> 6), lane = tid & 63, wr = wid >> 2, wc = wid & 3, fr = lane & 15, fq = lane >> 4;
    const int K = g.K, nt = K / BK;
    unsigned voffA[2], voffB[2];
#pragma unroll
    for (int i = 0; i < 2; ++i) { int R, C; stage_rc(tid * 16 + i * 8192, R, C); const int Rb = Epi::PERM ? ((R & ~31) + perm32(R & 31)) : R;
        voffA[i] = (unsigned)(R * K + C) * 2u; voffB[i] = (unsigned)(Rb * K + C) * 2u; }
    const size_t kstep = (size_t)(BK * 2);
    const size_t hstep = (size_t)HALF * K * 2;
    const size_t tstep = 2 * hstep;
    const unsigned ldsw = (unsigned)wid * 1024u;
    const int aoff = lds_byte(wr * 64 + fr, fq * 8), boff = lds_byte(wc * 32 + fr, fq * 8);
#define PG8_SA(b, h) (((b) * 2 + (h)) * HTB)
#define PG8_SB(b, h) ((4 + (b) * 2 + (h)) * HTB)
#define PG8_STAGE(bufoff, gbase, voff) do { _Pragma("unroll") for (int _i = 0; _i < 2; ++_i) \
        __builtin_amdgcn_global_load_lds((const unsigned*)((const char*)(gbase) + (voff)[_i]), (PG8_LAS unsigned*)(lds + (bufoff) + ldsw + _i * 8192), 16, 0, 0); } while (0)
#define PG8_LDA(dst, b, h) do { _Pragma("unroll") for (int m = 0; m < 4; ++m) _Pragma("unroll") for (int k = 0; k < 2; ++k) dst[m][k] = *(const PG8_LAS bf16x8*)(lds + PG8_SA(b, h) + aoff + m * 2048 + k * 1024); } while (0)
#define PG8_LDB(dst, b, h) do { _Pragma("unroll") for (int n = 0; n < 2; ++n) _Pragma("unroll") for (int k = 0; k < 2; ++k) dst[n][k] = *(const PG8_LAS bf16x8*)(lds + PG8_SB(b, h) + boff + n * 2048 + k * 1024); } while (0)
#define PG8_MMA(ai, bj, At, Bt) do { __builtin_amdgcn_s_setprio(1); _Pragma("unroll") for (int m = 0; m < 4; ++m) _Pragma("unroll") for (int n = 0; n < 2; ++n) _Pragma("unroll") for (int k = 0; k < 2; ++k) \
        acc[ai][bj][m][n] = __builtin_amdgcn_mfma_f32_16x16x32_bf16(Bt[n][k], At[m][k], acc[ai][bj][m][n], 0, 0, 0); __builtin_amdgcn_s_setprio(0); } while (0)
#define PG8_WAIT_V(n) asm volatile("s_waitcnt vmcnt(" #n ")" ::: "memory")
#define PG8_WAIT_L(n) asm volatile("s_waitcnt lgkmcnt(" #n ")" ::: "memory")
#define PG8_BAR __builtin_amdgcn_s_barrier()
#define PG8_SCHED __builtin_amdgcn_sched_barrier(0)
    Unit cur, nxt; int ui = 0;
    if (!S.next(0, cur)) return;
    f32x4 acc[2][2][4][2];
#pragma unroll
    for (int a = 0; a < 2; ++a)
#pragma unroll
        for (int b = 0; b < 2; ++b)
#pragma unroll
            for (int m = 0; m < 4; ++m)
#pragma unroll
                for (int n = 0; n < 2; ++n) acc[a][b][m][n] = (f32x4){0.f, 0.f, 0.f, 0.f};
    if (Sched::STREAMK && cur.kind == 2) S.load_partial(acc, tid, wid, lane);
    if constexpr (Epi::INIT_ACC) { if (cur.kind == 0) E.init(acc, cur, wr, wc, fr, fq); }
    bf16x8 At[4][2], B0[2][2], B1[2][2];
    const char* cA = (const char*)g.A + (size_t)cur.pm * tstep + (size_t)cur.k0 * kstep; const char* cB = (const char*)g.Bt + (size_t)cur.pn * tstep + (size_t)cur.k0 * kstep;
    S.a_ready(cur);
    if constexpr (SP2) {
        PG8_STAGE(PG8_SB(0, 0), cB, voffB); PG8_STAGE(PG8_SB(0, 1), cB + hstep, voffB); PG8_STAGE(PG8_SA(0, 0), cA, voffA); PG8_STAGE(PG8_SA(0, 1), cA + hstep, voffA);
        if (wr == 1) PG8_BAR;
        PG8_WAIT_V(2); PG8_BAR;
        PG8_STAGE(PG8_SB(1, 0), cB + kstep, voffB); PG8_STAGE(PG8_SA(1, 0), cA + kstep, voffA); PG8_STAGE(PG8_SB(1, 1), cB + hstep + kstep, voffB);
        PG8_WAIT_V(6); PG8_BAR;
    } else {
        PG8_STAGE(PG8_SB(0, 0), cB, voffB); PG8_STAGE(PG8_SA(0, 0), cA, voffA); PG8_STAGE(PG8_SB(0, 1), cB + hstep, voffB); PG8_STAGE(PG8_SA(0, 1), cA + hstep, voffA);
        if (wr == 1) PG8_BAR;
        PG8_WAIT_V(4); PG8_BAR;
        PG8_STAGE(PG8_SB(1, 0), cB + kstep, voffB); PG8_STAGE(PG8_SA(1, 0), cA + kstep, voffA); PG8_STAGE(PG8_SB(1, 1), cB + hstep + kstep, voffB);
        PG8_WAIT_V(6); PG8_BAR;
    }
    for (;;) {
        const bool has_next = S.next(ui + 1, nxt);
        const char* nA = has_next ? (const char*)g.A + (size_t)nxt.pm * tstep + (size_t)nxt.k0 * kstep : cA; const char* nB = has_next ? (const char*)g.Bt + (size_t)nxt.pn * tstep + (size_t)nxt.k0 * kstep : cB;
        const int clen = cur.len;
        for (int t = 0; t < clen; t += 2) {
            const bool last = (t == clen - 2);
            const char* a1 = cA + (size_t)(t + 1) * kstep;
            const char* a2 = last ? nA : cA + (size_t)(t + 2) * kstep; const char* b2 = last ? nB : cB + (size_t)(t + 2) * kstep;
            const char* a3 = a2 + kstep; const char* b3 = b2 + kstep;
            if (last && has_next) S.a_ready(nxt);
            if constexpr (SP2) {
            PG8_LDB(B0, 0, 0); PG8_LDB(B1, 0, 1); PG8_SCHED; PG8_LDA(At, 0, 0); PG8_STAGE(PG8_SA(1, 1), a1 + hstep, voffA);
            PG8_WAIT_V(8); PG8_WAIT_L(0); PG8_BAR; PG8_MMA(0, 0, At, B0); PG8_MMA(0, 1, At, B1); PG8_BAR; PG8_SCHED;
            PG8_LDA(At, 0, 1); PG8_STAGE(PG8_SB(0, 0), b2, voffB); PG8_STAGE(PG8_SB(0, 1), b2 + hstep, voffB); PG8_STAGE(PG8_SA(0, 0), a2, voffA);
            PG8_WAIT_V(8); PG8_WAIT_L(0); PG8_BAR; PG8_MMA(1, 0, At, B0); PG8_MMA(1, 1, At, B1); PG8_BAR; PG8_SCHED;
            PG8_LDB(B0, 1, 0); PG8_LDB(B1, 1, 1); PG8_SCHED; PG8_LDA(At, 1, 0); PG8_STAGE(PG8_SA(0, 1), a2 + hstep, voffA);
            PG8_WAIT_V(8); PG8_WAIT_L(0); PG8_BAR; PG8_MMA(0, 0, At, B0); PG8_MMA(0, 1, At, B1); PG8_BAR; PG8_SCHED;
            PG8_LDA(At, 1, 1); PG8_STAGE(PG8_SB(1, 0), b3, voffB); PG8_STAGE(PG8_SB(1, 1), b3 + hstep, voffB); PG8_STAGE(PG8_SA(1, 0), a3, voffA);
            PG8_WAIT_V(8); PG8_WAIT_L(0); PG8_BAR; PG8_MMA(1, 0, At, B0); PG8_MMA(1, 1, At, B1); PG8_BAR; PG8_SCHED;
            } else {
            PG8_LDB(B0, 0, 0); PG8_SCHED; PG8_LDA(At, 0, 0); PG8_STAGE(PG8_SA(1, 1), a1 + hstep, voffA);
            PG8_WAIT_L(8); PG8_BAR; PG8_WAIT_L(0); PG8_MMA(0, 0, At, B0); PG8_BAR; PG8_SCHED;
            PG8_LDB(B1, 0, 1); PG8_STAGE(PG8_SB(0, 0), b2, voffB);
            PG8_BAR; PG8_WAIT_L(0); PG8_MMA(0, 1, At, B1); PG8_BAR;
            PG8_LDA(At, 0, 1); PG8_STAGE(PG8_SA(0, 0), a2, voffA);
            PG8_BAR; PG8_WAIT_L(0); PG8_MMA(1, 0, At, B0); PG8_BAR; PG8_SCHED;
            PG8_STAGE(PG8_SB(0, 1), b2 + hstep, voffB);
            PG8_WAIT_V(6); PG8_BAR; PG8_MMA(1, 1, At, B1); PG8_BAR;
            PG8_LDB(B0, 1, 0); PG8_SCHED; PG8_LDA(At, 1, 0); PG8_STAGE(PG8_SA(0, 1), a2 + hstep, voffA);
            PG8_WAIT_L(8); PG8_BAR; PG8_WAIT_L(0); PG8_MMA(0, 0, At, B0); PG8_BAR; PG8_SCHED;
            PG8_LDB(B1, 1, 1); PG8_STAGE(PG8_SB(1, 0), b3, voffB);
            PG8_BAR; PG8_WAIT_L(0); PG8_MMA(0, 1, At, B1); PG8_BAR;
            PG8_LDA(At, 1, 1); PG8_STAGE(PG8_SA(1, 0), a3, voffA);
            PG8_BAR; PG8_WAIT_L(0); PG8_MMA(1, 0, At, B0); PG8_BAR; PG8_SCHED;
            PG8_STAGE(PG8_SB(1, 1), b3 + hstep, voffB);
            PG8_WAIT_V(6); PG8_BAR; PG8_MMA(1, 1, At, B1); PG8_BAR;
            }
        }
        if constexpr (ALIGN_EPI) { if (wr == 0) PG8_BAR; }
        if constexpr (!Epi::AFTER_DRAIN) {
            int fr_l = fr, fq_l = fq; asm volatile("" : "+v"(fr_l), "+v"(fq_l));
            if constexpr (Sched::STREAMK) {
                if (cur.kind == 1) S.store_partial(acc, tid, wid, lane);
                else E(acc, cur, wr, wc, fr_l, fq_l);
            } else E(acc, cur, wr, wc, fr_l, fq_l);
            S.done(cur); }
        if (!has_next) break;
#define PG8_ZERO_ACC() do { _Pragma("unroll") for (int a = 0; a < 2; ++a) _Pragma("unroll") for (int b = 0; b < 2; ++b) _Pragma("unroll") for (int m = 0; m < 4; ++m) _Pragma("unroll") for (int n = 0; n < 2; ++n) acc[a][b][m][n] = (f32x4){0.f, 0.f, 0.f, 0.f}; } while (0)
        if constexpr (Epi::INIT_ACC) {
            if (Sched::STREAMK && nxt.kind == 2) S.load_partial(acc, tid, wid, lane);
            else if (nxt.kind == 0) { int fr_i = fr, fq_i = fq; asm volatile("" : "+v"(fr_i), "+v"(fq_i)); E.init(acc, nxt, wr, wc, fr_i, fq_i); }
            else PG8_ZERO_ACC();
        } else {
            if (Sched::STREAMK && nxt.kind == 2) S.load_partial(acc, tid, wid, lane);
            else PG8_ZERO_ACC();
        }
#undef PG8_ZERO_ACC
        cur = nxt; cA = nA; cB = nB; ++ui;
        if constexpr (ALIGN_EPI) { if (wr == 1) PG8_BAR; }
    }
    PG8_WAIT_V(0);
    if constexpr (!ALIGN_EPI) { if (wr == 0) PG8_BAR; }
    PG8_BAR;
    if constexpr (Epi::AFTER_DRAIN) { E.fused(acc, cur, wr, wc, fr, fq, lds, wid, lane); S.done(cur); }
#undef PG8_SA
#undef PG8_SB
#undef PG8_STAGE
#undef PG8_LDA
#undef PG8_LDB
#undef PG8_MMA
#undef PG8_WAIT_V
#undef PG8_WAIT_L
#undef PG8_BAR
#undef PG8_SCHED
}
}

#define LAS __attribute__((address_space(3)))
typedef unsigned short bf16_t;
typedef float f32x4 __attribute__((ext_vector_type(4)));
typedef float f32x2 __attribute__((ext_vector_type(2)));
typedef unsigned u32x4 __attribute__((ext_vector_type(4)));
typedef unsigned u32x2 __attribute__((ext_vector_type(2)));

constexpr int D = 1024, FF = 2816, DA = 512, DB = 512;
constexpr int NB_P = 8, TP = 2064, NB_S = 128, TS = 8, NMETA = 16, SEQ = 2048;
constexpr int MP = NB_P * TP;
constexpr int MR = MP + NB_S * TS;
constexpr int MPAD = 17664;
constexpr int NCH_P = 33;
constexpr int NQ_P = NB_P * NCH_P;
constexpr int NQ_S = (NB_S * TS) / 64;
constexpr int NQ = NQ_P + NQ_S;
constexpr float EPS = 1e-6f;
constexpr int NWAVES = 8;

enum { I_XP = 0, I_XS, I_SCA, I_SCB, I_SH, I_META, I_GF1, I_W1G, I_W1U, I_W1D, I_GMIX, I_WIN, I_CAW, I_CAB, I_LNG, I_LNB, I_CBW, I_CBB,
       I_WRG, I_BRG, I_WIG, I_BIG, I_LAM, I_WOUT, I_GF2, I_W2G, I_W2U, I_W2D, I_GFIN, N_IN };
constexpr size_t O_YP = 0, O_YS = O_YP + (size_t)NB_P * SEQ * D, O_CAP = O_YS + (size_t)NB_S * TS * D, O_CBP = O_CAP + (size_t)2 * NB_P * 30 * DA,
                 O_HP = O_CBP + (size_t)2 * NB_P * 3 * DB, O_CAS = O_HP + (size_t)2 * NB_P * DB, O_CBS = O_CAS + (size_t)2 * NB_S * 30 * DA,
                 O_HS = O_CBS + (size_t)2 * NB_S * 3 * DB, O_END = O_HS + (size_t)2 * NB_S * DB;

constexpr size_t WS_SS = 0;
constexpr size_t WS_SUMM = 0x80000;
constexpr size_t WS_LAST = 0x1A0000;
constexpr size_t WS_W = 0x400000;
constexpr size_t SZ_WGU = (size_t)2 * FF * D * 2, SZ_WD = (size_t)D * FF * 2, SZ_WIN = (size_t)2048 * D * 2, SZ_WOUT = (size_t)D * D * 2;
constexpr size_t WS_WGU1 = WS_W, WS_WD1 = WS_WGU1 + SZ_WGU, WS_WIN = WS_WD1 + SZ_WD, WS_WOUT = WS_WIN + SZ_WIN, WS_WGU2 = WS_WOUT + SZ_WOUT, WS_WD2 = WS_WGU2 + SZ_WGU;
constexpr size_t WS_X = WS_WD2 + SZ_WD;
constexpr size_t WS_XB = WS_X + (size_t)MPAD * D * 4;
constexpr size_t WS_ACT = WS_XB + (size_t)MPAD * D * 2;
constexpr size_t WS_U = WS_ACT, WS_BX = WS_U + (size_t)MPAD * 512 * 2, WS_GG = WS_BX + (size_t)MPAD * 512 * 2, WS_YAB = WS_GG + (size_t)MPAD * 512 * 2;
constexpr size_t WS_END = WS_ACT + (size_t)MPAD * FF * 2;
static_assert(WS_YAB + (size_t)MPAD * D * 2 <= WS_END, "mixer overlay fits");
static_assert(WS_END <= 268435456, "ws map fits 256 MiB");
static_assert(WS_SS + 7 * (size_t)MPAD * 4 <= WS_SUMM && WS_SUMM + (size_t)NQ * 512 * 8 <= WS_LAST && WS_LAST + (size_t)128 * 512 * 8 <= WS_W, "small buffers");

constexpr int LDS_BYTES = 147456;

__device__ __forceinline__ float bf2f(bf16_t b) { return __uint_as_float(((unsigned)b) << 16); }
__device__ __forceinline__ unsigned pk2(float lo, float hi) { unsigned r; asm("v_cvt_pk_bf16_f32 %0, %1, %2" : "=v"(r) : "v"(lo), "v"(hi)); return r; }
__device__ __forceinline__ unsigned f2bf(float f) { return pk2(f, f) & 0xffffu; }
__device__ __forceinline__ float fast_rcp(float x) { return __builtin_amdgcn_rcpf(x); }
__device__ __forceinline__ float sigmoid_f(float x) { return fast_rcp(1.0f + __expf(-x)); }
__device__ __forceinline__ float silu_f(float x) { return x * sigmoid_f(x); }
__device__ __forceinline__ float gelu_tanh_f(float x) {
    const float u = 0.7978845608028654f * (x + 0.044715f * x * x * x);
    return x * sigmoid_f(2.0f * u);
}
__device__ __forceinline__ float neg_expm1_f(float x) {
    const float p = -x * (1.0f + x * (0.5f + x * (0.16666667f + x * (0.041666668f + x * (0.0083333338f + x * (0.0013888889f + x * 0.0001984127f))))));
    const float q = 1.0f - __expf(x);
    return x > -0.35f ? p : q;
}
__device__ __forceinline__ float wave_sum(float v) {
#pragma unroll
    for (int o = 1; o < 64; o <<= 1) v += __shfl_xor(v, o);
    return v;
}

#define XB_TMO      128
#define XB_XCNT(j)  (256  + 64 * (j))
#define XB_XSUB(j)  (1280 + 64 * (j))
#define XB_XGEN(j)  (2304 + 64 * (j))
#define XB_TOP      3328
#define XB_TOPGEN   3392
#define XCD_BAR_WORDS 3456
#define XB_SPIN_CAP (1u << 18)

__device__ __forceinline__ unsigned xb_ld(unsigned* p)              { return __hip_atomic_load(p, __ATOMIC_RELAXED, __HIP_MEMORY_SCOPE_AGENT); }
__device__ __forceinline__ unsigned xb_add(unsigned* p, unsigned v) { return __hip_atomic_fetch_add(p, v, __ATOMIC_RELAXED, __HIP_MEMORY_SCOPE_AGENT); }
__device__ __forceinline__ unsigned xb_xcc_id() { return (unsigned)__builtin_amdgcn_s_getreg((3 << 11) | 20) & 0xFu; }
#define XB_SPIN(cond, bar) do { unsigned _sp = 0; while (cond) { __builtin_amdgcn_s_sleep(1); \
    if ((++_sp & 255u) == 0u) { if (xb_ld(&(bar)[XB_TMO])) break; if (_sp > XB_SPIN_CAP) { atomicAdd(&(bar)[XB_TMO], 1u); break; } } } } while (0)

struct XcdBarrier {
    unsigned* bar; unsigned x;
    volatile LAS unsigned* st;
};

__device__ __forceinline__ XcdBarrier xcd_barrier_post(unsigned* bar, volatile LAS unsigned* st) {
    XcdBarrier b; b.bar = bar; b.x = xb_xcc_id(); b.st = st;
    if (threadIdx.x == 0) (void)xb_add(&bar[XB_XCNT(b.x)], 1u);
    return b;
}
__device__ __forceinline__ void xcd_barrier_complete(unsigned* bar, unsigned x, unsigned& nloc, unsigned& nx) {
    const unsigned G = gridDim.x * gridDim.y * gridDim.z;
    unsigned sum, cnt, mine, sp = 0u;
    for (;;) {
        sum = 0u; cnt = 0u; mine = 0u;
#pragma unroll
        for (unsigned j = 0; j < 16; ++j) { const unsigned c = xb_ld(&bar[XB_XCNT(j)]); sum += c; cnt += (c > 0u) ? 1u : 0u; mine = (j == x) ? c : mine; }
        if (sum == G) break;
        __builtin_amdgcn_s_sleep(1);
        if ((++sp & 255u) == 0u) { if (xb_ld(&bar[XB_TMO])) break; if (sp > XB_SPIN_CAP) { atomicAdd(&bar[XB_TMO], 1u); break; } }
    }
    nloc = mine > 0u ? mine : 1u; nx = cnt > 0u ? cnt : 1u;
}

__device__ __forceinline__ void xcd_barrier(const XcdBarrier& b, const bool is_t0) {
    asm volatile("s_waitcnt vmcnt(0)" ::: "memory");
    __syncthreads();
    if (is_t0) {
        unsigned* bar = b.bar;
        __builtin_amdgcn_s_waitcnt(0);
        unsigned nloc = b.st[0], nx = b.st[1];
        if (nloc == 0u) { xcd_barrier_complete(bar, b.x, nloc, nx); b.st[0] = nloc; b.st[1] = nx; }
        const unsigned old = xb_add(&bar[XB_XSUB(b.x)], 1u);
        const unsigned gen = old / nloc;
        if (old + 1u == (gen + 1u) * nloc) {
            __builtin_amdgcn_fence(__ATOMIC_RELEASE, "agent");
            asm volatile("s_waitcnt vmcnt(0)" ::: "memory");
            const unsigned og = xb_add(&bar[XB_TOP], 1u);
            const unsigned tg = og / nx;
            if (og + 1u == (tg + 1u) * nx) xb_add(&bar[XB_TOPGEN], 1u);
            else XB_SPIN(xb_ld(&bar[XB_TOPGEN]) == tg, bar);
            __builtin_amdgcn_fence(__ATOMIC_ACQUIRE, "agent");
            xb_add(&bar[XB_XGEN(b.x)], 1u);
            asm volatile("s_waitcnt vmcnt(0)" ::: "memory");
        } else {
            XB_SPIN(xb_ld(&bar[XB_XGEN(b.x)]) == gen, bar);
            __builtin_amdgcn_fence(__ATOMIC_ACQUIRE, "agent");
            asm volatile("s_waitcnt vmcnt(0)" ::: "memory");
        }
    }
    __syncthreads();
}

constexpr size_t WS_BAR = 0x380000;
constexpr int LDS_BARST = 139264;
constexpr size_t WS_SKF = 0x390000;

struct EpiGU {
    static constexpr bool PERM = true, AFTER_DRAIN = false, INIT_ACC = false;
    bf16_t* ACT; const float* ss;
    __device__ __forceinline__ void operator()(const f32x4 (&acc)[2][2][4][2], const pg8::Unit& u, int wr, int wc, int fr, int fq) const {
        const int row0 = u.pm * 256 + wr * 64 + fr, col0 = u.pn * 128 + wc * 32 + 8 * fq;
        float rs[2][4];
#pragma unroll
        for (int ai = 0; ai < 2; ++ai)
#pragma unroll
            for (int m = 0; m < 4; ++m) rs[ai][m] = ss[row0 + ai * 128 + m * 16];
#pragma unroll
        for (int ai = 0; ai < 2; ++ai)
#pragma unroll
            for (int m = 0; m < 4; ++m) {
                const int r = row0 + ai * 128 + m * 16;
                const float rstd = __builtin_amdgcn_rsqf(rs[ai][m] * (1.0f / D) + EPS);
                float o[8];
#pragma unroll
                for (int n = 0; n < 2; ++n)
#pragma unroll
                    for (int e = 0; e < 4; ++e) { const float g = acc[ai][0][m][n][e] * rstd, up = acc[ai][1][m][n][e] * rstd; o[4 * n + e] = silu_f(g) * up; }
                u32x4 w; w.x = pk2(o[0], o[1]); w.y = pk2(o[2], o[3]); w.z = pk2(o[4], o[5]); w.w = pk2(o[6], o[7]);
                *(u32x4*)(ACT + (size_t)r * FF + col0) = w;
            }
    }
};
struct EpiRes {
    static constexpr bool PERM = true, AFTER_DRAIN = false, INIT_ACC = true;
    float* X; bf16_t* XB; float* ssn; float scale;
    __device__ __forceinline__ void init(f32x4 (&acc)[2][2][4][2], const pg8::Unit& u, int wr, int wc, int fr, int fq) const {
        const int row0 = u.pm * 256 + wr * 64 + fr, col0 = u.pn * 256 + wc * 32 + 8 * fq; const float inv = 1.0f / scale;
#pragma unroll
        for (int ai = 0; ai < 2; ++ai)
#pragma unroll
            for (int m = 0; m < 4; ++m)
#pragma unroll
                for (int bj = 0; bj < 2; ++bj) { const float* xp = X + (size_t)(row0 + ai * 128 + m * 16) * D + col0 + bj * 128; acc[ai][bj][m][0] = *(const f32x4*)xp * inv; acc[ai][bj][m][1] = *(const f32x4*)(xp + 4) * inv; }
    }
    __device__ __forceinline__ void operator()(const f32x4 (&acc)[2][2][4][2], const pg8::Unit& u, int wr, int wc, int fr, int fq) const {
        const int row0 = u.pm * 256 + wr * 64 + fr, col0 = u.pn * 256 + wc * 32 + 8 * fq;
#pragma unroll
        for (int ai = 0; ai < 2; ++ai)
#pragma unroll
            for (int m = 0; m < 4; ++m) {
                const int r = row0 + ai * 128 + m * 16; float q = 0.f;
#pragma unroll
                for (int bj = 0; bj < 2; ++bj) {
                    float* xp = X + (size_t)r * D + col0 + bj * 128;
                    const f32x4 v0 = acc[ai][bj][m][0] * scale, v1 = acc[ai][bj][m][1] * scale;
                    *(f32x4*)xp = v0; *(f32x4*)(xp + 4) = v1;
                    u32x4 w; w.x = pk2(v0[0], v0[1]); w.y = pk2(v0[2], v0[3]); w.z = pk2(v1[0], v1[1]); w.w = pk2(v1[2], v1[3]);
                    *(u32x4*)(XB + (size_t)r * D + col0 + bj * 128) = w;
                    q += (v0[0] * v0[0] + v0[1] * v0[1]) + (v0[2] * v0[2] + v0[3] * v0[3]) + (v1[0] * v1[0] + v1[1] * v1[1]) + (v1[2] * v1[2] + v1[3] * v1[3]);
                }
                q += __shfl_xor(q, 16); q += __shfl_xor(q, 32);
                if (fq == 0) atomicAdd(ssn + r, q);
            }
    }
};
struct EpiWin {
    static constexpr bool PERM = true, AFTER_DRAIN = false, INIT_ACC = false;
    bf16_t *U, *BX, *GG; const float* ss;
    __device__ __forceinline__ void operator()(const f32x4 (&acc)[2][2][4][2], const pg8::Unit& u, int wr, int wc, int fr, int fq) const {
        const int row0 = u.pm * 256 + wr * 64 + fr, col0 = (u.pn & 3) * 128 + wc * 32 + 8 * fq;
        const bool isA = u.pn < 4;
        float rs[2][4];
#pragma unroll
        for (int ai = 0; ai < 2; ++ai)
#pragma unroll
            for (int m = 0; m < 4; ++m) rs[ai][m] = ss[row0 + ai * 128 + m * 16];
#pragma unroll
        for (int ai = 0; ai < 2; ++ai)
#pragma unroll
            for (int m = 0; m < 4; ++m) {
                const int r = row0 + ai * 128 + m * 16;
                const float rstd = __builtin_amdgcn_rsqf(rs[ai][m] * (1.0f / D) + EPS);
                float a0[8], a1[8];
#pragma unroll
                for (int n = 0; n < 2; ++n)
#pragma unroll
                    for (int e = 0; e < 4; ++e) { a0[4 * n + e] = acc[ai][0][m][n][e] * rstd; a1[4 * n + e] = acc[ai][1][m][n][e] * rstd; }
                if (isA) {
                    float o[8];
#pragma unroll
                    for (int e = 0; e < 8; ++e) o[e] = a0[e] * sigmoid_f(a1[e]);
                    u32x4 w; w.x = pk2(o[0], o[1]); w.y = pk2(o[2], o[3]); w.z = pk2(o[4], o[5]); w.w = pk2(o[6], o[7]);
                    *(u32x4*)(U + (size_t)r * 512 + col0) = w;
                } else {
                    float o[8];
#pragma unroll
                    for (int e = 0; e < 8; ++e) o[e] = gelu_tanh_f(a1[e]);
                    u32x4 w; w.x = pk2(a0[0], a0[1]); w.y = pk2(a0[2], a0[3]); w.z = pk2(a0[4], a0[5]); w.w = pk2(a0[6], a0[7]);
                    *(u32x4*)(BX + (size_t)r * 512 + col0) = w;
                    u32x4 g; g.x = pk2(o[0], o[1]); g.y = pk2(o[2], o[3]); g.z = pk2(o[4], o[5]); g.w = pk2(o[6], o[7]);
                    *(u32x4*)(GG + (size_t)r * 512 + col0) = g;
                }
            }
    }
};

struct Args { const float* in[N_IN]; float* out; unsigned char* ws; int ph_lo, ph_hi; };
struct Frame {
    LAS unsigned char* lds;
    int tid, lane, wave, G;
    const float* const __attribute__((address_space(4)))* in; float* out; unsigned char* ws;
};
#define LDS_WAIT() asm volatile("s_waitcnt lgkmcnt(0)" ::: "memory")

template <class FrameT>
__device__ __forceinline__ void res_fixup(FrameT& F, const EpiRes& E, const pg8::DpSplit& S) {
    const int nleft = S.nwg - S.G, tid = F.tid, wid = tid >> 6, lane = tid & 63, wr = wid >> 2, wc = wid & 3, fr = lane & 15, fq = lane >> 4;
    for (int item = blockIdx.x; item < nleft * 8; item += F.G) {
        const int j = item >> 3, ai = (item >> 2) & 1, m = item & 3;
        pg8::Unit u; S.unit_of(S.G + j, u);
        const int r = u.pm * 256 + wr * 64 + fr + ai * 128 + m * 16, col0 = u.pn * 256 + wc * 32 + 8 * fq;
        float q = 0.f;
#pragma unroll
        for (int bj = 0; bj < 2; ++bj) {
            f32x4 a0 = {0.f, 0.f, 0.f, 0.f}, a1 = {0.f, 0.f, 0.f, 0.f};
#pragma unroll
            for (int p = 0; p < 4; ++p) {
                const float* sp = S.slab + (size_t)(4 * j + p) * 65536 + (size_t)(((ai * 2 + bj) * 4 + m) * 2048) + tid * 4;
                const u32x4 w = __builtin_nontemporal_load((const u32x4*)sp);
                a0 += (f32x4){__uint_as_float(w.x << 16), __uint_as_float(w.x & 0xffff0000u), __uint_as_float(w.y << 16), __uint_as_float(w.y & 0xffff0000u)};
                a1 += (f32x4){__uint_as_float(w.z << 16), __uint_as_float(w.z & 0xffff0000u), __uint_as_float(w.w << 16), __uint_as_float(w.w & 0xffff0000u)};
            }
            float* xp = E.X + (size_t)r * D + col0 + bj * 128;
            f32x4 v0 = *(f32x4*)xp, v1 = *(f32x4*)(xp + 4);
            v0 = v0 + a0 * E.scale; v1 = v1 + a1 * E.scale;
            *(f32x4*)xp = v0; *(f32x4*)(xp + 4) = v1;
            u32x4 w; w.x = pk2(v0[0], v0[1]); w.y = pk2(v0[2], v0[3]); w.z = pk2(v1[0], v1[1]); w.w = pk2(v1[2], v1[3]);
            *(u32x4*)(E.XB + (size_t)r * D + col0 + bj * 128) = w;
            q += (v0[0] * v0[0] + v0[1] * v0[1]) + (v0[2] * v0[2] + v0[3] * v0[3]) + (v1[0] * v1[0] + v1[1] * v1[1]) + (v1[2] * v1[2] + v1[3] * v1[3]);
        }
        q += __shfl_xor(q, 16); q += __shfl_xor(q, 32);
        if (fq == 0) atomicAdd(E.ssn + r, q);
    }
}


__device__ __forceinline__ void transpose_item(const float* W, int K, int N, bf16_t* WT, const float* g, int mode, LAS float* scr, int item, int lane) {
    const int nblk = N / 32, kb = item / nblk, nb = item % nblk, k0 = 64 * kb, n0 = 32 * nb;
    float tv[32];
#pragma unroll
    for (int i = 0; i < 32; ++i) { const int kk = 2 * i + (lane >> 5); tv[i] = __builtin_nontemporal_load(W + (size_t)(k0 + kk) * N + n0 + (lane & 31)); }
    if (g) {
#pragma unroll
        for (int i = 0; i < 32; ++i) tv[i] *= g[k0 + 2 * i + (lane >> 5)];
    }
#pragma unroll
    for (int i = 0; i < 32; ++i) scr[(2 * i + (lane >> 5)) * 33 + (lane & 31)] = tv[i];
    LDS_WAIT(); asm volatile("" ::: "memory");
    int d0;
    if (mode == 0) d0 = n0;
    else if (mode == 1) d0 = 256 * (n0 >> 7) + (n0 & 127);
    else if (mode == 2) d0 = 256 * (n0 >> 7) + 128 + (n0 & 127);
    else { const int seg = n0 >> 9, cc = n0 & 511; d0 = 256 * ((seg >> 1) * 4 + (cc >> 7)) + 128 * (seg & 1) + (cc & 127); }
    const int c = lane & 7;
#pragma unroll
    for (int j = 0; j < 4; ++j) { const int n = (lane >> 3) + 8 * j; const LAS float* s = scr + (8 * c) * 33 + n;
        u32x4 o; o.x = pk2(s[0 * 33], s[1 * 33]); o.y = pk2(s[2 * 33], s[3 * 33]); o.z = pk2(s[4 * 33], s[5 * 33]); o.w = pk2(s[6 * 33], s[7 * 33]);
        *(u32x4*)(WT + (size_t)(d0 + n) * K + k0 + 8 * c) = o; }
    LDS_WAIT(); asm volatile("" ::: "memory");
}
constexpr int IT_G = (D / 64) * (FF / 32), IT_D = (FF / 64) * (D / 32), IT_WIN = (D / 64) * (2048 / 32), IT_WOUT = (D / 64) * (D / 32);
__device__ __forceinline__ void convert_mats(Frame& F, int l, int id_lo, int id_hi, int gw, int NGW) {
    LAS float* scr = (LAS float*)(F.lds + F.wave * 16384);
    unsigned char* ws = F.ws;
    for (int id = id_lo; id < id_hi; ++id) {
        const int nit = (id == 0 || id == 4) ? 2 * IT_G : (id == 1 || id == 5) ? IT_D : (id == 2 ? IT_WIN : IT_WOUT);
        for (int it = gw; it < nit; it += NGW) {
            if (id == 0) { const bool up = it >= IT_G; transpose_item(F.in[up ? I_W1U : I_W1G] + (size_t)l * D * FF, D, FF, (bf16_t*)(ws + WS_WGU1), F.in[I_GF1] + l * D, up ? 2 : 1, scr, up ? it - IT_G : it, F.lane); }
            else if (id == 4) { const bool up = it >= IT_G; transpose_item(F.in[up ? I_W2U : I_W2G] + (size_t)l * D * FF, D, FF, (bf16_t*)(ws + WS_WGU2), F.in[I_GF2] + l * D, up ? 2 : 1, scr, up ? it - IT_G : it, F.lane); }
            else if (id == 1) transpose_item(F.in[I_W1D] + (size_t)l * D * FF, FF, D, (bf16_t*)(ws + WS_WD1), nullptr, 0, scr, it, F.lane);
            else if (id == 5) transpose_item(F.in[I_W2D] + (size_t)l * D * FF, FF, D, (bf16_t*)(ws + WS_WD2), nullptr, 0, scr, it, F.lane);
            else if (id == 2) transpose_item(F.in[I_WIN] + (size_t)l * D * 2048, D, 2048, (bf16_t*)(ws + WS_WIN), F.in[I_GMIX] + l * D, 3, scr, it, F.lane);
            else transpose_item(F.in[I_WOUT] + (size_t)l * D * D, D, D, (bf16_t*)(ws + WS_WOUT), nullptr, 0, scr, it, F.lane);
        }
    }
}

__device__ __forceinline__ void p0_prologue(Frame& F) {
    convert_mats(F, 0, 0, 3, blockIdx.x * NWAVES + F.wave, F.G * NWAVES);
    const int gw = blockIdx.x * NWAVES + F.wave, NGW = F.G * NWAVES;
    float* X = (float*)(F.ws + WS_X); bf16_t* XB = (bf16_t*)(F.ws + WS_XB); float* ss = (float*)(F.ws + WS_SS);
    for (int r = gw; r < MPAD; r += NGW) {
        const float* src = nullptr;
        if (r < MP) { const int b = r / TP, tt = r - b * TP; src = tt < NMETA ? F.in[I_META] + (size_t)tt * D : F.in[I_XP] + ((size_t)b * SEQ + (tt - NMETA)) * D; }
        else if (r < MR) src = F.in[I_XS] + (size_t)(r - MP) * D;
        f32x4 v[4]; float s = 0.f;
#pragma unroll
        for (int j = 0; j < 4; ++j) { v[j] = src ? __builtin_nontemporal_load((const f32x4*)src + F.lane + 64 * j) : (f32x4){0.f, 0.f, 0.f, 0.f}; s += (v[j][0] * v[j][0] + v[j][1] * v[j][1]) + (v[j][2] * v[j][2] + v[j][3] * v[j][3]); }
        s = wave_sum(s);
#pragma unroll
        for (int j = 0; j < 4; ++j) { ((f32x4*)(X + (size_t)r * D))[F.lane + 64 * j] = v[j];
            u32x2 w; w.x = pk2(v[j][0], v[j][1]); w.y = pk2(v[j][2], v[j][3]); ((u32x2*)(XB + (size_t)r * D))[F.lane + 64 * j] = w; }
        if (F.lane == 0) ss[r] = s;
    }
    { const int i = blockIdx.x * 512 + F.tid; if (i < 6 * MPAD) ss[MPAD + i] = 0.f; }
}

__device__ __forceinline__ void final_phase(Frame& F) {
    const int gw = blockIdx.x * NWAVES + F.wave, NGW = F.G * NWAVES;
    const float* X = (const float*)(F.ws + WS_X); const float* ss = (const float*)(F.ws + WS_SS) + 6 * MPAD; const float* g = F.in[I_GFIN];
    f32x4 gv[4];
#pragma unroll
    for (int j = 0; j < 4; ++j) gv[j] = ((const f32x4*)g)[F.lane + 64 * j];
    for (int r = gw; r < MR; r += NGW) {
        float* dst;
        if (r < MP) { const int b = r / TP, tt = r - b * TP; if (tt < NMETA) continue; dst = F.out + O_YP + ((size_t)b * SEQ + (tt - NMETA)) * D; }
        else dst = F.out + O_YS + (size_t)(r - MP) * D;
        const float rstd = __builtin_amdgcn_rsqf(ss[r] * (1.0f / D) + EPS);
#pragma unroll
        for (int j = 0; j < 4; ++j) { const f32x4 v = ((const f32x4*)(X + (size_t)r * D))[F.lane + 64 * j]; __builtin_nontemporal_store(v * rstd * gv[j], (f32x4*)dst + F.lane + 64 * j); }
    }
}

constexpr int LDS_WR = 0, LDS_WI = 16384, LDS_CBT = 32768, LDS_GRP = LDS_CBT + 4 * 64 * 68 * 4, LDS_RED = 0;

__device__ __forceinline__ float reduce_scatter32(float (&v)[32], int lane) {
#define RS_STEP(H, M) { const bool up = (lane & (M)) != 0; _Pragma("unroll") for (int i = 0; i < (H); ++i) { const float snd = up ? v[i] : v[i + (H)], kp = up ? v[i + (H)] : v[i]; v[i] = kp + __shfl_xor(snd, (M)); } }
    RS_STEP(16, 32) RS_STEP(8, 16) RS_STEP(4, 8) RS_STEP(2, 4) RS_STEP(1, 2)
#undef RS_STEP
    return v[0] + __shfl_xor(v[0], 1);
}

__device__ __forceinline__ void mix_job_a(Frame& F, int l, int sp, int gi) {
    const int tid = F.tid, c = 128 * gi + (tid & 127), sub = tid >> 7;
    const bf16_t* U = (const bf16_t*)(F.ws + WS_U); bf16_t* YAB = (bf16_t*)(F.ws + WS_YAB);
    const float* cw = F.in[I_CAW] + (size_t)l * 31 * DA;
    float w[31];
#pragma unroll
    for (int k = 0; k < 31; ++k) w[k] = cw[k * DA + c];
    const float cbias = F.in[I_CAB][l * DA + c], lg = F.in[I_LNG][l * DA + c], lb = F.in[I_LNB][l * DA + c];
    float acc[32];
#pragma unroll
    for (int t = 0; t < 32; ++t) acc[t] = cbias;
    int rowbase, nval;
    if (sp < 136) {
        const int b = sp / 17, k2 = sp - b * 17, nvalid = (k2 == 16) ? 16 : 128, seqrow0 = b * TP, tb = 128 * k2 + 32 * sub;
        nval = nvalid - 32 * sub; rowbase = seqrow0 + tb;
        if (nval > 0) {
#pragma unroll
            for (int tt = 0; tt < 62; ++tt) {
                const int ti = tb - 30 + tt;
                const float v = ti >= 0 ? bf2f(U[(size_t)(seqrow0 + ti) * 512 + c]) : 0.f;
#pragma unroll
                for (int t = 0; t < 32; ++t) { const int kk = tt - t; if (kk >= 0 && kk <= 30) acc[t] += w[kk] * v; }
            }
        }
    } else {
        nval = 32; const int s0 = 16 * (sp - 136) + 4 * sub; rowbase = MP + 8 * s0;
        const float* st = F.in[I_SCA] + (size_t)l * NB_S * 30 * DA;
#pragma unroll
        for (int hs = 0; hs < 4; ++hs) {
            const int s = s0 + hs, rowS = MP + 8 * s;
#pragma unroll
            for (int tt = 0; tt < 38; ++tt) {
                const float v = tt < 30 ? st[((size_t)s * 30 + tt) * DA + c] : bf2f(U[(size_t)(rowS + tt - 30) * 512 + c]);
#pragma unroll
                for (int t = 0; t < 8; ++t) { const int kk = tt - t; if (kk >= 0 && kk <= 30) acc[8 * hs + t] += w[kk] * v; }
            }
        }
    }
    LAS f32x2* red = (LAS f32x2*)(F.lds + LDS_RED);
    float s1[32], s2[32];
#pragma unroll
    for (int t = 0; t < 32; ++t) { s1[t] = acc[t]; s2[t] = acc[t] * acc[t]; }
    const float r1 = reduce_scatter32(s1, F.lane), r2 = reduce_scatter32(s2, F.lane);
    __syncthreads();
    if ((F.lane & 1) == 0) red[F.wave * 32 + (F.lane >> 1)] = (f32x2){r1, r2};
    __syncthreads();
    if (nval > 0) {
#pragma unroll
        for (int t = 0; t < 32; ++t) {
            const f32x2 a = red[F.wave * 32 + t], o = red[(F.wave ^ 1) * 32 + t];
            const float mean = (a.x + o.x) * (1.0f / 128.0f), var = (a.y + o.y) * (1.0f / 128.0f) - mean * mean;
            const float rstd = __builtin_amdgcn_rsqf(fmaxf(var, 0.f) + EPS);
            const float y = (acc[t] - mean) * rstd * lg + lb;
            if (t < nval) YAB[(size_t)(rowbase + t) * D + c] = (bf16_t)f2bf(silu_f(y));
        }
    }
}

constexpr int WJ_TILE = 9728;
constexpr int LDS_WT = 8 * WJ_TILE;
typedef short bf16x8_t __attribute__((ext_vector_type(8)));

__device__ __forceinline__ void mix_b_wave_jobs(Frame& F, int l) {
    const int lane = F.lane, wave = F.wave, fr = lane & 15, fq = lane >> 4, h = blockIdx.x & 7;
    const bf16_t* BX = (const bf16_t*)(F.ws + WS_BX);
    bf16_t* YAB = (bf16_t*)(F.ws + WS_YAB); bf16_t* PCG = (bf16_t*)(F.ws + WS_XB);
    LAS bf16_t* WT = (LAS bf16_t*)(F.lds + LDS_WT);
    LAS bf16_t* tile = (LAS bf16_t*)(F.lds + wave * WJ_TILE);
    __syncthreads();
    {
        const f32x4* gr = (const f32x4*)(F.in[I_WRG] + (size_t)(l * 8 + h) * 4096); const f32x4* gx = (const f32x4*)(F.in[I_WIG] + (size_t)(l * 8 + h) * 4096);
#pragma unroll
        for (int e = 0; e < 2; ++e) {
            const int idx = F.tid + e * 512, i = idx >> 4, j4 = (idx & 15) * 4;
            const f32x4 a = gr[idx], b = gx[idx];
#pragma unroll
            for (int d = 0; d < 4; ++d) { WT[(j4 + d) * 72 + i] = (bf16_t)f2bf(a[d]); WT[(64 + j4 + d) * 72 + i] = (bf16_t)f2bf(b[d]); }
        }
    }
    float bra[4], bix[4], sp[4];
#pragma unroll
    for (int nt = 0; nt < 4; ++nt) {
        const int c = 64 * h + 16 * nt + fr;
        bra[nt] = F.in[I_BRG][l * DB + c]; bix[nt] = F.in[I_BIG][l * DB + c];
        sp[nt] = log1pf(expf(-F.in[I_LAM][l * DB + c]));
    }
    __syncthreads();
    for (int q = (int)(blockIdx.x >> 3) * 8 + wave; q < NQ; q += 256) {
        const bool prompt = q < NQ_P;
        int row0, t0, nvalid;
        if (prompt) { const int b_ = q / NCH_P, k = q - b_ * NCH_P; row0 = b_ * TP + 64 * k; t0 = 64 * k; nvalid = (k == NCH_P - 1) ? 16 : 64; }
        else { row0 = MP + 64 * (q - NQ_P); t0 = 0; nvalid = 64; }
        int ln = lane; asm volatile("" : "+v"(ln));
#pragma unroll
        for (int i = 0; i < 9; ++i) {
            const int p = ln + 64 * i;
            if (p < 536) {
                const int rr = p >> 3, pc = p & 7, row = rr - 3;
                const bool okr = prompt ? (t0 + row >= 0) : (row >= 0);
                u32x4 v = *(const u32x4*)(BX + (size_t)(row0 + (okr ? row : 0)) * 512 + 64 * h + 8 * pc);
                if (!okr) v = (u32x4){0u, 0u, 0u, 0u};
                *(LAS u32x4*)(tile + rr * 72 + 8 * pc) = v;
            }
        }
        float wb[4][4], bb[4];
        { int fr_l = fr; asm volatile("" : "+v"(fr_l));
#pragma unroll
        for (int nt = 0; nt < 4; ++nt) {
            const int c = 64 * h + 16 * nt + fr_l;
#pragma unroll
            for (int k = 0; k < 4; ++k) wb[k][nt] = F.in[I_CBW][((size_t)l * 4 + k) * DB + c];
            bb[nt] = F.in[I_CBB][l * DB + c];
        } }
        float cbv[4][4][4];
#pragma unroll
        for (int mt = 0; mt < 4; ++mt)
#pragma unroll
            for (int nt = 0; nt < 4; ++nt) {
                const int tb = 16 * mt + 4 * fq; float x[7];
#pragma unroll
                for (int i = 0; i < 7; ++i) x[i] = bf2f(tile[(tb + i) * 72 + 16 * nt + fr]);
                if (!prompt && !(fq & 1)) {
                    const int s = 8 * (q - NQ_P) + 2 * mt + (fq >> 1);
                    const float* st = F.in[I_SCB] + ((size_t)l * NB_S + s) * 3 * DB + 64 * h + 16 * nt + fr;
                    x[0] = st[0]; x[1] = st[DB]; x[2] = st[2 * DB];
                }
#pragma unroll
                for (int e = 0; e < 4; ++e) cbv[mt][nt][e] = bb[nt] + wb[0][nt] * x[e] + wb[1][nt] * x[e + 1] + wb[2][nt] * x[e + 2] + wb[3][nt] * x[e + 3];
            }
        asm volatile("s_waitcnt lgkmcnt(0)" ::: "memory");
#pragma unroll
        for (int mt = 0; mt < 4; ++mt)
#pragma unroll
            for (int nt = 0; nt < 4; ++nt)
#pragma unroll
                for (int e = 0; e < 4; ++e) tile[(16 * mt + 4 * fq + e) * 72 + 16 * nt + fr] = (bf16_t)f2bf(cbv[mt][nt][e]);
        asm volatile("s_waitcnt lgkmcnt(0)" ::: "memory");
        float Pc[4] = {1.f, 1.f, 1.f, 1.f}, Hc[4] = {0.f, 0.f, 0.f, 0.f};
#pragma unroll
        for (int mt = 0; mt < 4; ++mt) {
            const bf16x8_t a0 = *(const LAS bf16x8_t*)(tile + (16 * mt + fr) * 72 + 8 * fq), a1 = *(const LAS bf16x8_t*)(tile + (16 * mt + fr) * 72 + 32 + 8 * fq);
#pragma unroll
            for (int nt = 0; nt < 4; ++nt) {
                const int c = 64 * h + 16 * nt + fr;
                const bf16x8_t br0 = *(const LAS bf16x8_t*)(WT + (16 * nt + fr) * 72 + 8 * fq), br1 = *(const LAS bf16x8_t*)(WT + (16 * nt + fr) * 72 + 32 + 8 * fq);
                const bf16x8_t bi0 = *(const LAS bf16x8_t*)(WT + (64 + 16 * nt + fr) * 72 + 8 * fq), bi1 = *(const LAS bf16x8_t*)(WT + (64 + 16 * nt + fr) * 72 + 32 + 8 * fq);
                f32x4 accR = {0.f, 0.f, 0.f, 0.f}, accI = {0.f, 0.f, 0.f, 0.f};
                accR = __builtin_amdgcn_mfma_f32_16x16x32_bf16(a0, br0, accR, 0, 0, 0); accR = __builtin_amdgcn_mfma_f32_16x16x32_bf16(a1, br1, accR, 0, 0, 0);
                accI = __builtin_amdgcn_mfma_f32_16x16x32_bf16(a0, bi0, accI, 0, 0, 0); accI = __builtin_amdgcn_mfma_f32_16x16x32_bf16(a1, bi1, accI, 0, 0, 0);
                float P4[4], H4[4]; float hp = 0.f, pp = 1.f;
#pragma unroll
                for (int e = 0; e < 4; ++e) {
                    const float r = sigmoid_f(accR[e] + bra[nt]), ig = sigmoid_f(accI[e] + bix[nt]);
                    const float la = -8.0f * r * sp[nt], a = __expf(la), bt = __builtin_amdgcn_sqrtf(neg_expm1_f(2.0f * la)) * (ig * bf2f(tile[(16 * mt + 4 * fq + e) * 72 + 16 * nt + fr]));
                    hp = a * hp + bt; pp = pp * a; H4[e] = hp; P4[e] = pp;
                }
                float pex = 1.f, hex = 0.f;
#pragma unroll
                for (int d = 3; d >= 1; --d) {
                    const float ps = __shfl(pp, lane - 16 * d), hs = __shfl(hp, lane - 16 * d);
                    const bool use = prompt ? (fq >= d) : (d == 1 && (fq & 1));
                    if (use) { hex = ps * hex + hs; pex = pex * ps; }
                }
                const float pin = prompt ? Pc[nt] * pex : pex, hin = prompt ? pex * Hc[nt] + hex : hex;
                float Pf[4], Hf[4];
#pragma unroll
                for (int e = 0; e < 4; ++e) { Hf[e] = H4[e] + P4[e] * hin; Pf[e] = P4[e] * pin; }
                Pc[nt] = __shfl(Pf[3], fr + 48); Hc[nt] = __shfl(Hf[3], fr + 48);
#pragma unroll
                for (int e = 0; e < 4; ++e) {
                    const int tl = 16 * mt + 4 * fq + e;
                    if (tl < nvalid) { const size_t row = (size_t)(row0 + tl); YAB[row * D + 512 + c] = (bf16_t)f2bf(Hf[e]); PCG[row * 512 + c] = (bf16_t)f2bf(Pf[e]); }
                }
                if (prompt) { if (16 * (mt + 1) == nvalid && fq == 3) ((f32x2*)(F.ws + WS_SUMM))[(size_t)q * 512 + c] = (f32x2){Pf[3], Hf[3]}; }
                else if (fq & 1) { const int s = 8 * (q - NQ_P) + 2 * mt + (fq >> 1); ((f32x2*)(F.ws + WS_LAST))[(size_t)s * 512 + c] = (f32x2){Pf[3], Hf[3]}; }
            }
        }
    }
}

constexpr int LDS_ARED = 98304;
__device__ __forceinline__ float reduce_scatter16(float (&v)[16], int lane) {
#define RS_STEP(H, M) { const bool up = (lane & (M)) != 0; _Pragma("unroll") for (int i = 0; i < (H); ++i) { const float snd = up ? v[i] : v[i + (H)], kp = up ? v[i + (H)] : v[i]; v[i] = kp + __shfl_xor(snd, (M)); } }
    RS_STEP(8, 32) RS_STEP(4, 16) RS_STEP(2, 8) RS_STEP(1, 4)
#undef RS_STEP
    float r = v[0]; r += __shfl_xor(r, 2); r += __shfl_xor(r, 1); return r;
}
__device__ __forceinline__ void mix_a_wave_jobs(Frame& F, int l) {
    const int lane = F.lane, wave = F.wave, gi = wave & 3, c0 = 128 * gi + 2 * lane;
    const bf16_t* U = (const bf16_t*)(F.ws + WS_U); bf16_t* YAB = (bf16_t*)(F.ws + WS_YAB);
    const float* cw = F.in[I_CAW] + (size_t)l * 31 * DA;
    f32x2 w[31];
#pragma unroll
    for (int k = 0; k < 31; ++k) w[k] = *(const f32x2*)(cw + k * DA + c0);
    const f32x2 cbv = *(const f32x2*)(F.in[I_CAB] + l * DA + c0), lgv = *(const f32x2*)(F.in[I_LNG] + l * DA + c0), lbv = *(const f32x2*)(F.in[I_LNB] + l * DA + c0);
    LAS f32x2* red = (LAS f32x2*)(F.lds + LDS_ARED + wave * 128);
    for (int tb = 511 - ((int)blockIdx.x * 2 + (wave >> 2)); tb < 1096; tb += 512) {
        f32x2 a[16];
#pragma unroll
        for (int t = 0; t < 16; ++t) a[t] = cbv;
        int rowbase;
        if (tb < 1032) {
            const int b = tb / 129, kb = tb - b * 129, t0 = 16 * kb, seqrow0 = b * TP; rowbase = seqrow0 + t0;
            unsigned raw[46];
#pragma unroll
            for (int tt = 0; tt < 46; ++tt) { const int ti = t0 - 30 + tt; raw[tt] = *(const unsigned*)(U + (size_t)(seqrow0 + (ti < 0 ? 0 : ti)) * 512 + c0); }
#pragma unroll
            for (int tt = 0; tt < 46; ++tt) {
                const unsigned rw = ((t0 - 30 + tt) >= 0) ? raw[tt] : 0u;
                const f32x2 v = {__uint_as_float(rw << 16), __uint_as_float(rw & 0xffff0000u)};
#pragma unroll
                for (int t = 0; t < 16; ++t) { const int kk = tt - t; if (kk >= 0 && kk <= 30) a[t] += w[kk] * v; }
            }
        } else {
            const int s0 = 2 * (tb - 1032); rowbase = MP + 8 * s0;
            const float* st = F.in[I_SCA] + (size_t)l * NB_S * 30 * DA;
#pragma unroll
            for (int hs = 0; hs < 2; ++hs) {
                const int s = s0 + hs, rowS = MP + 8 * s;
#pragma unroll
                for (int tt = 0; tt < 38; ++tt) {
                    f32x2 v;
                    if (tt < 30) v = __builtin_nontemporal_load((const f32x2*)(st + ((size_t)s * 30 + tt) * DA + c0));
                    else { const unsigned rw = *(const unsigned*)(U + (size_t)(rowS + tt - 30) * 512 + c0); v = (f32x2){__uint_as_float(rw << 16), __uint_as_float(rw & 0xffff0000u)}; }
#pragma unroll
                    for (int t = 0; t < 8; ++t) { const int kk = tt - t; if (kk >= 0 && kk <= 30) a[8 * hs + t] += w[kk] * v; }
                }
            }
        }
        float s1[16], s2[16];
#pragma unroll
        for (int t = 0; t < 16; ++t) { s1[t] = a[t].x + a[t].y; s2[t] = a[t].x * a[t].x + a[t].y * a[t].y; }
        const float r1 = reduce_scatter16(s1, lane), r2 = reduce_scatter16(s2, lane);
        if ((lane & 3) == 0) red[lane >> 2] = (f32x2){r1, r2};
        asm volatile("s_waitcnt lgkmcnt(0)" ::: "memory");
#pragma unroll
        for (int t = 0; t < 16; ++t) {
            const f32x2 st_ = red[t];
            const float mean = st_.x * (1.0f / 128.0f), var = st_.y * (1.0f / 128.0f) - mean * mean;
            const float rstd = __builtin_amdgcn_rsqf(fmaxf(var, 0.f) + EPS);
            const f32x2 y = (a[t] - mean) * rstd * lgv + lbv;
            *(unsigned*)(YAB + (size_t)(rowbase + t) * D + c0) = pk2(silu_f(y.x), silu_f(y.y));
        }
        asm volatile("s_waitcnt lgkmcnt(0)" ::: "memory");
    }
}

__device__ __forceinline__ void mix_job_state(Frame& F, int l, int s) {
    const int c = F.tid;
    const bf16_t* U = (const bf16_t*)(F.ws + WS_U); const bf16_t* BX = (const bf16_t*)(F.ws + WS_BX);
    if (s < NB_P) {
        const int b = s; float* oa = F.out + O_CAP + ((size_t)l * NB_P + b) * 30 * DA; float* ob = F.out + O_CBP + ((size_t)l * NB_P + b) * 3 * DB;
#pragma unroll 10
        for (int i = 0; i < 30; ++i) __builtin_nontemporal_store(bf2f(U[(size_t)(b * TP + TP - 30 + i) * 512 + c]), oa + i * DA + c);
#pragma unroll
        for (int i = 0; i < 3; ++i) __builtin_nontemporal_store(bf2f(BX[(size_t)(b * TP + TP - 3 + i) * 512 + c]), ob + i * DB + c);
    } else {
        const int b = s - NB_P, rowS = MP + 8 * b; float* oa = F.out + O_CAS + ((size_t)l * NB_S + b) * 30 * DA; float* ob = F.out + O_CBS + ((size_t)l * NB_S + b) * 3 * DB;
        const float* st = F.in[I_SCA] + ((size_t)l * NB_S + b) * 30 * DA;
#pragma unroll 11
        for (int i = 0; i < 22; ++i) __builtin_nontemporal_store(__builtin_nontemporal_load(st + (8 + i) * DA + c), oa + i * DA + c);
#pragma unroll
        for (int i = 22; i < 30; ++i) __builtin_nontemporal_store(bf2f(U[(size_t)(rowS + i - 22) * 512 + c]), oa + i * DA + c);
#pragma unroll
        for (int i = 0; i < 3; ++i) __builtin_nontemporal_store(bf2f(BX[(size_t)(rowS + 5 + i) * 512 + c]), ob + i * DB + c);
    }
}

__device__ __forceinline__ void mix_a_phase(Frame& F, int l, int sel) {
    if (sel & 1) mix_b_wave_jobs(F, l);
    if (!(sel & 2)) return;
    { int t_ = F.tid; asm volatile("" : "+v"(t_)); F.tid = t_; F.lane = t_ & 63; }
    mix_a_wave_jobs(F, l);
    { int t_ = F.tid; asm volatile("" : "+v"(t_)); F.tid = t_; F.lane = t_ & 63; }
    const int b = blockIdx.x;
    if (b >= 64 && b - 64 < NB_P + NB_S) mix_job_state(F, l, b - 64);
}

__device__ __forceinline__ void mix_c_phase(Frame& F, int l, int rep) {
    const int c = F.tid;
    bf16_t* YAB = (bf16_t*)(F.ws + WS_YAB); const bf16_t* PCG = (const bf16_t*)(F.ws + WS_XB); const bf16_t* GGp = (const bf16_t*)(F.ws + WS_GG);
    const f32x2* SUMM = (const f32x2*)(F.ws + WS_SUMM); const f32x2* LAST = (const f32x2*)(F.ws + WS_LAST);
    for (int job = blockIdx.x; job < NQ * 2; job += F.G) {
        const int q = job >> 1, hh = job & 1;
        if (q < NQ_P) {
            const int b = q / NCH_P, k = q - b * NCH_P, nvalid = (k == NCH_P - 1) ? 16 : 64, row0 = b * TP + 64 * k;
            if (32 * hh >= nvalid) continue;
            float carry = 0.f;
            {
                f32x2 ph[32];
#pragma unroll
                for (int e = 0; e < 32; ++e) { const int kk = e < k ? e : 0; ph[e] = SUMM[(size_t)(b * NCH_P + kk) * 512 + c]; }
#pragma unroll
                for (int e = 0; e < 32; ++e) { const float px = e < k ? ph[e].x : 1.f, py = e < k ? ph[e].y : 0.f; carry = px * carry + py; }
            }
            const int r1 = (32 * hh + 32 < nvalid) ? 32 * hh + 32 : nvalid;
            for (int r = 32 * hh; r < r1; ++r) {
                const size_t row = row0 + r;
                const float y = (bf2f(YAB[row * D + 512 + c]) + bf2f(PCG[row * 512 + c]) * carry) * bf2f(GGp[row * 512 + c]);
                if (rep) ((bf16_t*)(F.ws + WS_U))[row * 512 + c] = (bf16_t)f2bf(y); else
                YAB[row * D + 512 + c] = (bf16_t)f2bf(y);
            }
            if (k == NCH_P - 1 && hh == 0) { const f32x2 ph = SUMM[(size_t)q * 512 + c]; F.out[O_HP + ((size_t)l * NB_P + b) * DB + c] = ph.y + ph.x * carry; }
        } else {
            const int row0 = MP + 64 * (q - NQ_P);
            for (int r = 32 * hh; r < 32 * hh + 32; ++r) {
                const int s = 8 * (q - NQ_P) + (r >> 3); const size_t row = row0 + r;
                const float carry = F.in[I_SH][((size_t)l * NB_S + s) * DB + c];
                const float y = (bf2f(YAB[row * D + 512 + c]) + bf2f(PCG[row * 512 + c]) * carry) * bf2f(GGp[row * 512 + c]);
                if (rep) ((bf16_t*)(F.ws + WS_U))[row * 512 + c] = (bf16_t)f2bf(y); else
                YAB[row * D + 512 + c] = (bf16_t)f2bf(y);
                if ((r & 7) == 7) { const f32x2 ph = LAST[(size_t)s * 512 + c]; F.out[O_HS + ((size_t)l * NB_S + s) * DB + c] = ph.y + ph.x * carry; }
            }
        }
    }
}

constexpr int NPH = 18;
#ifndef PHMASK
#define PHMASK 127
#endif
#define DUPMASK 0
#define MIXSEL 1
__global__ void __launch_bounds__(NWAVES * 64, 2) mega_fwd(Args args) {
    extern __shared__ __attribute__((aligned(16))) unsigned char lds[];
    Frame F;
    F.lds = (LAS unsigned char*)lds; F.G = gridDim.x;
    if (threadIdx.x < 2) ((volatile LAS unsigned*)(F.lds + LDS_BARST))[threadIdx.x] = 0u;
    __syncthreads();
    if (args.ph_hi - args.ph_lo > 1) (void)xcd_barrier_post((unsigned*)(args.ws + WS_BAR), (volatile LAS unsigned*)(F.lds + LDS_BARST));
    const int ph_lo = args.ph_lo, ph_hi = args.ph_hi;
    const int wave_s = __builtin_amdgcn_readfirstlane(threadIdx.x >> 6);
    for (int st = 2 * ph_lo; st < 2 * ph_hi; ++st) {
        const int ph = st >> 1, rep = st & 1;
        bool run = true;
        if (rep == 1) { const int ty = (ph == 0) ? 1 : (ph == NPH - 1) ? 2 : (int)((0x0804084020100804ull >> (8 * ((ph - 1) & 7))) & 255ull);
            run = (DUPMASK & ty) != 0; }
        if (run) {
        const __attribute__((address_space(4))) unsigned char* kp = (const __attribute__((address_space(4))) unsigned char*)__builtin_amdgcn_kernarg_segment_ptr();
        asm volatile("" : "+s"(kp));
        const __attribute__((address_space(4))) Args* ap = (const __attribute__((address_space(4))) Args*)kp;
        F.in = ap->in; F.out = ap->out; F.ws = ap->ws;
        { int t_ = wave_s * 64 + hw_lane_id(); asm volatile("" : "+v"(t_)); F.tid = t_; F.lane = t_ & 63; F.wave = wave_s; }
        unsigned char* ws = F.ws;
        float* SS = (float*)(ws + WS_SS);
        if ((PHMASK & 1) && ph == 0) p0_prologue(F);
        else if ((PHMASK & 2) && ph == NPH - 1) final_phase(F);
        else {
            const int l = (ph - 1) >> 3, s = (ph - 1) & 7;
            if ((PHMASK & 4) && (s == 0 || s == 6)) {
                pg8::Gemm g{(const bf16_t*)(ws + WS_XB), (const bf16_t*)(ws + (s == 0 ? WS_WGU1 : WS_WGU2)), MPAD, 2 * FF, D};
                pg8::StaticOrder S; S.init(MPAD, 2 * FF, D, F.G, (int)blockIdx.x);
                EpiGU E{(bf16_t*)(ws + WS_ACT), SS + (size_t)(s == 0 ? 3 * l : 3 * l + 2) * MPAD};
                pg8::gemm_phase<EpiGU, pg8::StaticOrder, true, true>(F.lds, g, S, E, wave_s);
            } else if ((PHMASK & 8) && (s == 1 || s == 7 || s == 5)) {
                const bool down = (s != 5);
                pg8::Gemm g{(const bf16_t*)(ws + (down ? WS_ACT : WS_YAB)), (const bf16_t*)(ws + (s == 1 ? WS_WD1 : (s == 7 ? WS_WD2 : WS_WOUT))), MPAD, D, down ? FF : D};
                pg8::DpSplit S; S.init(MPAD, D, down ? FF : D, F.G, (int)blockIdx.x, F.out);
                EpiRes E{(float*)(ws + WS_X), (bf16_t*)(ws + WS_XB), (rep ? (float*)(ws + 0x300000) : SS + (size_t)(s == 1 ? 3 * l + 1 : (s == 5 ? 3 * l + 2 : 3 * l + 3)) * MPAD), rep ? 0.0f : (down ? 0.5f : 1.0f)};
                pg8::gemm_phase<EpiRes, pg8::DpSplit, true, true>(F.lds, g, S, E, wave_s);
                if (blockIdx.x >= 80 && rep == 0) {
                    const int gw = ((int)blockIdx.x - 80) * NWAVES + F.wave, NGW = (F.G - 80) * NWAVES;
                    if (l == 0 && s == 1) { convert_mats(F, 0, 3, 5, gw, NGW); }
                    else if (l == 0 && s == 5) convert_mats(F, 0, 5, 6, gw, NGW);
                    else if (l == 0 && s == 7) convert_mats(F, 1, 2, 3, gw, NGW);
                    else if (l == 1 && s == 1) convert_mats(F, 1, 3, 5, gw, NGW);
                    else if (l == 1 && s == 5) convert_mats(F, 1, 5, 6, gw, NGW);
                }
                { XcdBarrier xb; xb.bar = (unsigned*)(ws + WS_BAR); xb.x = xb_xcc_id(); xb.st = (volatile LAS unsigned*)(F.lds + LDS_BARST); xcd_barrier(xb, wave_s == 0 && hw_lane_id() == 0); }
                res_fixup(F, E, S);
            } else if ((PHMASK & 16) && s == 2) {
                pg8::Gemm g{(const bf16_t*)(ws + WS_XB), (const bf16_t*)(ws + WS_WIN), MPAD, 2048, D};
                pg8::StaticOrder S; S.init(MPAD, 2048, D, F.G, (int)blockIdx.x);
                EpiWin E{(bf16_t*)(ws + WS_U), (bf16_t*)(ws + WS_BX), (bf16_t*)(ws + WS_GG), SS + (size_t)(3 * l + 1) * MPAD};
                pg8::gemm_phase<EpiWin, pg8::StaticOrder, true, true>(F.lds, g, S, E, wave_s);
                if (l == 0 && rep == 0 && blockIdx.x >= 40) {
                    convert_mats(F, 1, 0, 2, ((int)blockIdx.x - 40) * NWAVES + F.wave, (F.G - 40) * NWAVES);
                }
            } else if ((PHMASK & 32) && s == 3) mix_a_phase(F, l, rep ? MIXSEL : 3);
            else if ((PHMASK & 64) && s == 4) mix_c_phase(F, l, rep);
        }
        }
        if (rep == 1 && ph + 1 < ph_hi) {
            const __attribute__((address_space(4))) Args* ap2 = (const __attribute__((address_space(4))) Args*)__builtin_amdgcn_kernarg_segment_ptr();
            unsigned* barw = (unsigned*)(ap2->ws + WS_BAR);
            if (ph_hi > 1000) cg::this_grid().sync();
            XcdBarrier xb; xb.bar = barw; xb.x = xb_xcc_id(); xb.st = (volatile LAS unsigned*)(F.lds + LDS_BARST);
            xcd_barrier(xb, wave_s == 0 && hw_lane_id() == 0);
        }
    }
}

#ifndef MK_FUSED
#define MK_FUSED 1
#endif
extern "C" void kernel_launch(void* const* d_in, const int* in_sizes, int n_in, void* d_out, int out_size, void* d_ws, size_t ws_size, hipStream_t stream) {
    static int grid = 0;
    if (grid == 0) {
        if (n_in != N_IN || (size_t)out_size != O_END || ws_size < WS_END) { fprintf(stderr, "kernel_launch: unexpected shapes: n_in %d out %d ws %zu (need %zu)\n", n_in, out_size, ws_size, (size_t)WS_END); grid = -1; return; }
        int dev = 0, cus = 0, per_cu = 0;
        hipGetDevice(&dev); hipDeviceGetAttribute(&cus, hipDeviceAttributeMultiprocessorCount, dev);
        if (hipFuncSetAttribute((const void*)mega_fwd, hipFuncAttributeMaxDynamicSharedMemorySize, LDS_BYTES) != hipSuccess) { fprintf(stderr, "kernel_launch: hipFuncSetAttribute failed\n"); grid = -1; return; }
        if (hipOccupancyMaxActiveBlocksPerMultiprocessor(&per_cu, (const void*)mega_fwd, NWAVES * 64, LDS_BYTES) != hipSuccess || per_cu < 1) { fprintf(stderr, "kernel_launch: occupancy query failed (%d)\n", per_cu); (void)hipGetLastError(); per_cu = 1; }
        grid = cus * 1;
        fprintf(stderr, "kernel_launch: cus %d per_cu %d grid %d ws %zu\n", cus, per_cu, grid, ws_size);
    }
    if (grid < 0) return;
    Args a{};
    for (int i = 0; i < N_IN; ++i) a.in[i] = (const float*)d_in[i];
    a.out = (float*)d_out; a.ws = (unsigned char*)d_ws;
#if MK_FUSED
    a.ph_lo = 0; a.ph_hi = NPH;
    if (hipMemsetAsync((unsigned char*)d_ws + WS_BAR, 0, 0x10000, stream) != hipSuccess) { fprintf(stderr, "kernel_launch: memset of the barrier words failed\n"); return; }
    void* kargs[] = {&a};
    hipError_t e = hipLaunchCooperativeKernel((const void*)mega_fwd, dim3(grid), dim3(NWAVES * 64), kargs, LDS_BYTES, stream);
    if (e != hipSuccess) fprintf(stderr, "cooperative launch failed: %s (grid %d)\n", hipGetErrorString(e), grid);
#else
    for (int ph = 0; ph < NPH; ++ph) { a.ph_lo = ph; a.ph_hi = ph + 1; hipLaunchKernelGGL(mega_fwd, dim3(grid), dim3(NWAVES * 64), LDS_BYTES, stream, a); }
#endif
}
```

```cpp
#include <hip/hip_runtime.h>
#include <hip/hip_cooperative_groups.h>
#include <cstdio>
#include <cstdint>
namespace cg = cooperative_groups;
__device__ __forceinline__ int hw_lane_id() { int l; asm volatile("v_mbcnt_lo_u32_b32 %0, -1, 0\n\tv_mbcnt_hi_u32_b32 %0, -1, %0" : "=v"(l)); return l; }
namespace pg8 {
#define PG8_LAS __attribute__((address_space(3)))
typedef unsigned short bf16_t;
typedef short bf16x8 __attribute__((ext_vector_type(8)));
typedef float f32x4 __attribute__((ext_vector_type(4)));
typedef unsigned u32x4 __attribute__((ext_vector_type(4)));
constexpr int BM = 256, BK = 64, HALF = 128, HTB = HALF * BK * 2  , STAGE_BYTES = 8 * HTB, NXCD = 8, WGM = 8;

__host__ __device__ __forceinline__ int lds_byte(int r, int c) { const int st = (r >> 4) * 2 + (c >> 5), rr = r & 15, cc = c & 31, ob = rr * 64 + cc * 2; return st * 1024 + (ob ^ (((ob >> 9) & 1) << 5)); }
__host__ __device__ __forceinline__ void stage_rc(int b, int& R, int& C) { const int st = b / 1024, sb = b % 1024, swz = sb ^ (((sb >> 9) & 1) << 5); R = (st >> 1) * 16 + swz / 64; C = (st & 1) * 32 + (swz % 64) / 2; }
__host__ __device__ __forceinline__ int perm32(int rho) { const int n = rho >> 4, i = rho & 15; return 8 * (i >> 2) + 4 * n + (i & 3); }

struct Unit { int pm, pn, k0, len, kind; };
struct Gemm { const bf16_t* A; const bf16_t* Bt; int M, N, K; };

struct StaticOrder {
    static constexpr bool STREAMK = false;
    int nM, nN, nwg, G, c, nt;
    __host__ __device__ void init(int M, int N, int K, int G_, int c_) { nM = M / BM; nN = N / BM; nwg = nM * nN; G = G_; c = c_; nt = K / BK; }
    __host__ __device__ bool next(int i, Unit& u) const {
        const long L = (long)i * G + c; if (L >= nwg) return false;
        int wgid = (int)L; { const int q = nwg / NXCD, r = nwg % NXCD, xcd = wgid % NXCD, off = wgid / NXCD; wgid = (xcd < r ? xcd * (q + 1) : r * (q + 1) + (xcd - r) * q) + off; }
        const int nig = WGM * nN, gid = wgid / nig, fm = gid * WGM, gsz = (nM - fm) < WGM ? (nM - fm) : WGM;
        u.pm = fm + ((wgid % nig) % gsz); u.pn = (wgid % nig) / gsz; u.k0 = 0; u.len = nt; u.kind = 0; return true;
    }
    __device__ __forceinline__ void a_ready(const Unit&) const {}
    __device__ __forceinline__ void done(const Unit&) const {}
    __device__ __forceinline__ void store_partial(const f32x4 (&)[2][2][4][2], int, int, int) const {}
    __device__ __forceinline__ void load_partial(f32x4 (&)[2][2][4][2], int, int, int) const {}
};
struct DpSplit {
    static constexpr bool STREAMK = true;
    int nM, nN, nwg, G, c, nt; float* slab;
    __device__ __forceinline__ void init(int M, int N, int K, int G_, int c_, float* slab_) { nM = M / BM; nN = N / BM; nwg = nM * nN; G = G_; c = c_; nt = K / BK; slab = slab_; }
    __device__ __forceinline__ void unit_of(int L, Unit& u) const {
        int wgid = L; { const int q = nwg / NXCD, r = nwg % NXCD, xcd = wgid % NXCD, off = wgid / NXCD; wgid = (xcd < r ? xcd * (q + 1) : r * (q + 1) + (xcd - r) * q) + off; }
        const int nig = WGM * nN, gid = wgid / nig, fm = gid * WGM, gsz = (nM - fm) < WGM ? (nM - fm) : WGM;
        u.pm = fm + ((wgid % nig) % gsz); u.pn = (wgid % nig) / gsz;
    }
    __device__ __forceinline__ bool next(int i, Unit& u) const {
        if (i == 0) { if (c >= nwg) return false; unit_of(c, u); u.k0 = 0; u.len = nt; u.kind = 0; return true; }
        if (i == 1 && c < 4 * (nwg - G)) {
            unit_of(G + (c >> 2), u);
            const int part = c & 3, lenp = (nt >> 2) & ~1, rem2 = (nt - 4 * lenp) >> 1;
            u.len = lenp + (part < rem2 ? 2 : 0); u.k0 = part * lenp + 2 * (part < rem2 ? part : rem2); u.kind = 1; return true;
        }
        return false;
    }
    __device__ __forceinline__ void a_ready(const Unit&) const {}
    __device__ __forceinline__ void done(const Unit&) const {}
    __device__ __forceinline__ void store_partial(const f32x4 (&acc)[2][2][4][2], int tid, int wid, int lane) const {
        typedef unsigned u32x4v __attribute__((ext_vector_type(4)));
        asm volatile("" : "+v"(tid));
        const __amdgpu_buffer_rsrc_t r = __builtin_amdgcn_make_buffer_rsrc((void*)(slab + (size_t)c * 65536), 0, 262144, 0x00020000);
        const int vo = tid * 16;
#pragma unroll
        for (int ai = 0; ai < 2; ++ai)
#pragma unroll
            for (int bj = 0; bj < 2; ++bj)
#pragma unroll
                for (int m = 0; m < 4; ++m) {
                    const f32x4 p0 = acc[ai][bj][m][0], p1 = acc[ai][bj][m][1]; u32x4v w;
                    asm("v_cvt_pk_bf16_f32 %0, %1, %2" : "=v"(w.x) : "v"(p0[0]), "v"(p0[1])); asm("v_cvt_pk_bf16_f32 %0, %1, %2" : "=v"(w.y) : "v"(p0[2]), "v"(p0[3]));
                    asm("v_cvt_pk_bf16_f32 %0, %1, %2" : "=v"(w.z) : "v"(p1[0]), "v"(p1[1])); asm("v_cvt_pk_bf16_f32 %0, %1, %2" : "=v"(w.w) : "v"(p1[2]), "v"(p1[3]));
                    __builtin_amdgcn_raw_buffer_store_b128(w, r, vo, ((ai * 2 + bj) * 4 + m) * 8192, 0);
                }
    }
    __device__ __forceinline__ void load_partial(f32x4 (&)[2][2][4][2], int, int, int) const {}
};

template <class Epi, class Sched, bool ALIGN_EPI = false, bool SP2 = false>
__device__ __forceinline__ void gemm_phase(PG8_LAS unsigned char* lds, const Gemm g, const Sched& S, const Epi& E, const int wave_s) {
    int tid_l = wave_s * 64 + hw_lane_id(); asm volatile("" : "+v"(tid_l));
    const int tid = tid_l, wid = __builtin_amdgcn_readfirstlane(tid >> 6), lane = tid & 63, wr = wid >> 2, wc = wid & 3, fr = lane & 15, fq = lane >> 4;
    const int K = g.K, nt = K / BK;
    unsigned voffA[2], voffB[2];
#pragma unroll
    for (int i = 0; i < 2; ++i) { int R, C; stage_rc(tid * 16 + i * 8192, R, C); const int Rb = Epi::PERM ? ((R & ~31) + perm32(R & 31)) : R;
        voffA[i] = (unsigned)(R * K + C) * 2u; voffB[i] = (unsigned)(Rb * K + C) * 2u; }
    const size_t kstep = (size_t)(BK * 2);
    const size_t hstep = (size_t)HALF * K * 2;
    const size_t tstep = 2 * hstep;
    const unsigned ldsw = (unsigned)wid * 1024u;
    const int aoff = lds_byte(wr * 64 + fr, fq * 8), boff = lds_byte(wc * 32 + fr, fq * 8);
#define PG8_SA(b, h) (((b) * 2 + (h)) * HTB)
#define PG8_SB(b, h) ((4 + (b) * 2 + (h)) * HTB)
#define PG8_STAGE(bufoff, gbase, voff) do { _Pragma("unroll") for (int _i = 0; _i < 2; ++_i) \
        __builtin_amdgcn_global_load_lds((const unsigned*)((const char*)(gbase) + (voff)[_i]), (PG8_LAS unsigned*)(lds + (bufoff) + ldsw + _i * 8192), 16, 0, 0); } while (0)
#define PG8_LDA(dst, b, h) do { _Pragma("unroll") for (int m = 0; m < 4; ++m) _Pragma("unroll") for (int k = 0; k < 2; ++k) dst[m][k] = *(const PG8_LAS bf16x8*)(lds + PG8_SA(b, h) + aoff + m * 2048 + k * 1024); } while (0)
#define PG8_LDB(dst, b, h) do { _Pragma("unroll") for (int n = 0; n < 2; ++n) _Pragma("unroll") for (int k = 0; k < 2; ++k) dst[n][k] = *(const PG8_LAS bf16x8*)(lds + PG8_SB(b, h) + boff + n * 2048 + k * 1024); } while (0)
#define PG8_MMA(ai, bj, At, Bt) do { __builtin_amdgcn_s_setprio(1); _Pragma("unroll") for (int m = 0; m < 4; ++m) _Pragma("unroll") for (int n = 0; n < 2; ++n) _Pragma("unroll") for (int k = 0; k < 2; ++k) \
        acc[ai][bj][m][n] = __builtin_amdgcn_mfma_f32_16x16x32_bf16(Bt[n][k], At[m][k], acc[ai][bj][m][n], 0, 0, 0); __builtin_amdgcn_s_setprio(0); } while (0)
#define PG8_WAIT_V(n) asm volatile("s_waitcnt vmcnt(" #n ")" ::: "memory")
#define PG8_WAIT_L(n) asm volatile("s_waitcnt lgkmcnt(" #n ")" ::: "memory")
#define PG8_BAR __builtin_amdgcn_s_barrier()
#define PG8_SCHED __builtin_amdgcn_sched_barrier(0)
    Unit cur, nxt; int ui = 0;
    if (!S.next(0, cur)) return;
    f32x4 acc[2][2][4][2];
#pragma unroll
    for (int a = 0; a < 2; ++a)
#pragma unroll
        for (int b = 0; b < 2; ++b)
#pragma unroll
            for (int m = 0; m < 4; ++m)
#pragma unroll
                for (int n = 0; n < 2; ++n) acc[a][b][m][n] = (f32x4){0.f, 0.f, 0.f, 0.f};
    if (Sched::STREAMK && cur.kind == 2) S.load_partial(acc, tid, wid, lane);
    if constexpr (Epi::INIT_ACC) { if (cur.kind == 0) E.init(acc, cur, wr, wc, fr, fq); }
    bf16x8 At[4][2], B0[2][2], B1[2][2];
    const char* cA = (const char*)g.A + (size_t)cur.pm * tstep + (size_t)cur.k0 * kstep; const char* cB = (const char*)g.Bt + (size_t)cur.pn * tstep + (size_t)cur.k0 * kstep;
    S.a_ready(cur);
    if constexpr (SP2) {
        PG8_STAGE(PG8_SB(0, 0), cB, voffB); PG8_STAGE(PG8_SB(0, 1), cB + hstep, voffB); PG8_STAGE(PG8_SA(0, 0), cA, voffA); PG8_STAGE(PG8_SA(0, 1), cA + hstep, voffA);
        if (wr == 1) PG8_BAR;
        PG8_WAIT_V(2); PG8_BAR;
        PG8_STAGE(PG8_SB(1, 0), cB + kstep, voffB); PG8_STAGE(PG8_SA(1, 0), cA + kstep, voffA); PG8_STAGE(PG8_SB(1, 1), cB + hstep + kstep, voffB);
        PG8_WAIT_V(6); PG8_BAR;
    } else {
        PG8_STAGE(PG8_SB(0, 0), cB, voffB); PG8_STAGE(PG8_SA(0, 0), cA, voffA); PG8_STAGE(PG8_SB(0, 1), cB + hstep, voffB); PG8_STAGE(PG8_SA(0, 1), cA + hstep, voffA);
        if (wr == 1) PG8_BAR;
        PG8_WAIT_V(4); PG8_BAR;
        PG8_STAGE(PG8_SB(1, 0), cB + kstep, voffB); PG8_STAGE(PG8_SA(1, 0), cA + kstep, voffA); PG8_STAGE(PG8_SB(1, 1), cB + hstep + kstep, voffB);
        PG8_WAIT_V(6); PG8_BAR;
    }
    for (;;) {
        const bool has_next = S.next(ui + 1, nxt);
        const char* nA = has_next ? (const char*)g.A + (size_t)nxt.pm * tstep + (size_t)nxt.k0 * kstep : cA; const char* nB = has_next ? (const char*)g.Bt + (size_t)nxt.pn * tstep + (size_t)nxt.k0 * kstep : cB;
        const int clen = cur.len;
        for (int t = 0; t < clen; t += 2) {
            const bool last = (t == clen - 2);
            const char* a1 = cA + (size_t)(t + 1) * kstep;
            const char* a2 = last ? nA : cA + (size_t)(t + 2) * kstep; const char* b2 = last ? nB : cB + (size_t)(t + 2) * kstep;
            const char* a3 = a2 + kstep; const char* b3 = b2 + kstep;
            if (last && has_next) S.a_ready(nxt);
            if constexpr (SP2) {
            PG8_LDB(B0, 0, 0); PG8_LDB(B1, 0, 1); PG8_SCHED; PG8_LDA(At, 0, 0); PG8_STAGE(PG8_SA(1, 1), a1 + hstep, voffA);
            PG8_WAIT_V(8); PG8_WAIT_L(0); PG8_BAR; PG8_MMA(0, 0, At, B0); PG8_MMA(0, 1, At, B1); PG8_BAR; PG8_SCHED;
            PG8_LDA(At, 0, 1); PG8_STAGE(PG8_SB(0, 0), b2, voffB); PG8_STAGE(PG8_SB(0, 1), b2 + hstep, voffB); PG8_STAGE(PG8_SA(0, 0), a2, voffA);
            PG8_WAIT_V(8); PG8_WAIT_L(0); PG8_BAR; PG8_MMA(1, 0, At, B0); PG8_MMA(1, 1, At, B1); PG8_BAR; PG8_SCHED;
            PG8_LDB(B0, 1, 0); PG8_LDB(B1, 1, 1); PG8_SCHED; PG8_LDA(At, 1, 0); PG8_STAGE(PG8_SA(0, 1), a2 + hstep, voffA);
            PG8_WAIT_V(8); PG8_WAIT_L(0); PG8_BAR; PG8_MMA(0, 0, At, B0); PG8_MMA(0, 1, At, B1); PG8_BAR; PG8_SCHED;
            PG8_LDA(At, 1, 1); PG8_STAGE(PG8_SB(1, 0), b3, voffB); PG8_STAGE(PG8_SB(1, 1), b3 + hstep, voffB); PG8_STAGE(PG8_SA(1, 0), a3, voffA);
            PG8_WAIT_V(8); PG8_WAIT_L(0); PG8_BAR; PG8_MMA(1, 0, At, B0); PG8_MMA(1, 1, At, B1); PG8_BAR; PG8_SCHED;
            } else {
            PG8_LDB(B0, 0, 0); PG8_SCHED; PG8_LDA(At, 0, 0); PG8_STAGE(PG8_SA(1, 1), a1 + hstep, voffA);
            PG8_WAIT_L(8); PG8_BAR; PG8_WAIT_L(0); PG8_MMA(0, 0, At, B0); PG8_BAR; PG8_SCHED;
            PG8_LDB(B1, 0, 1); PG8_STAGE(PG8_SB(0, 0), b2, voffB);
            PG8_BAR; PG8_WAIT_L(0); PG8_MMA(0, 1, At, B1); PG8_BAR;
            PG8_LDA(At, 0, 1); PG8_STAGE(PG8_SA(0, 0), a2, voffA);
            PG8_BAR; PG8_WAIT_L(0); PG8_MMA(1, 0, At, B0); PG8_BAR; PG8_SCHED;
            PG8_STAGE(PG8_SB(0, 1), b2 + hstep, voffB);
            PG8_WAIT_V(6); PG8_BAR; PG8_MMA(1, 1, At, B1); PG8_BAR;
            PG8_LDB(B0, 1, 0); PG8_SCHED; PG8_LDA(At, 1, 0); PG8_STAGE(PG8_SA(0, 1), a2 + hstep, voffA);
            PG8_WAIT_L(8); PG8_BAR; PG8_WAIT_L(0); PG8_MMA(0, 0, At, B0); PG8_BAR; PG8_SCHED;
            PG8_LDB(B1, 1, 1); PG8_STAGE(PG8_SB(1, 0), b3, voffB);
            PG8_BAR; PG8_WAIT_L(0); PG8_MMA(0, 1, At, B1); PG8_BAR;
            PG8_LDA(At, 1, 1); PG8_STAGE(PG8_SA(1, 0), a3, voffA);
            PG8_BAR; PG8_WAIT_L(0); PG8_MMA(1, 0, At, B0); PG8_BAR; PG8_SCHED;
            PG8_STAGE(PG8_SB(1, 1), b3 + hstep, voffB);
            PG8_WAIT_V(6); PG8_BAR; PG8_MMA(1, 1, At, B1); PG8_BAR;
            }
        }
        if constexpr (ALIGN_EPI) { if (wr == 0) PG8_BAR; }
        if constexpr (!Epi::AFTER_DRAIN) {
            int fr_l = fr, fq_l = fq; asm volatile("" : "+v"(fr_l), "+v"(fq_l));
            if constexpr (Sched::STREAMK) {
                if (cur.kind == 1) S.store_partial(acc, tid, wid, lane);
                else E(acc, cur, wr, wc, fr_l, fq_l);
            } else E(acc, cur, wr, wc, fr_l, fq_l);
            S.done(cur); }
        if (!has_next) break;
#define PG8_ZERO_ACC() do { _Pragma("unroll") for (int a = 0; a < 2; ++a) _Pragma("unroll") for (int b = 0; b < 2; ++b) _Pragma("unroll") for (int m = 0; m < 4; ++m) _Pragma("unroll") for (int n = 0; n < 2; ++n) acc[a][b][m][n] = (f32x4){0.f, 0.f, 0.f, 0.f}; } while (0)
        if constexpr (Epi::INIT_ACC) {
            if (Sched::STREAMK && nxt.kind == 2) S.load_partial(acc, tid, wid, lane);
            else if (nxt.kind == 0) { int fr_i = fr, fq_i = fq; asm volatile("" : "+v"(fr_i), "+v"(fq_i)); E.init(acc, nxt, wr, wc, fr_i, fq_i); }
            else PG8_ZERO_ACC();
        } else {
            if (Sched::STREAMK && nxt.kind == 2) S.load_partial(acc, tid, wid, lane);
            else PG8_ZERO_ACC();
        }
#undef PG8_ZERO_ACC
        cur = nxt; cA = nA; cB = nB; ++ui;
        if constexpr (ALIGN_EPI) { if (wr == 1) PG8_BAR; }
    }
    PG8_WAIT_V(0);
    if constexpr (!ALIGN_EPI) { if (wr == 0) PG8_BAR; }
    PG8_BAR;
    if constexpr (Epi::AFTER_DRAIN) { E.fused(acc, cur, wr, wc, fr, fq, lds, wid, lane); S.done(cur); }
#undef PG8_SA
#undef PG8_SB
#undef PG8_STAGE
#undef PG8_LDA
#undef PG8_LDB
#undef PG8_MMA
#undef PG8_WAIT_V
#undef PG8_WAIT_L
#undef PG8_BAR
#undef PG8_SCHED
}
}

#define LAS __attribute__((address_space(3)))
typedef unsigned short bf16_t;
typedef float f32x4 __attribute__((ext_vector_type(4)));
typedef float f32x2 __attribute__((ext_vector_type(2)));
typedef unsigned u32x4 __attribute__((ext_vector_type(4)));
typedef unsigned u32x2 __attribute__((ext_vector_type(2)));

constexpr int D = 1024, FF = 2816, DA = 512, DB = 512;
constexpr int NB_P = 8, TP = 2064, NB_S = 128, TS = 8, NMETA = 16, SEQ = 2048;
constexpr int MP = NB_P * TP;
constexpr int MR = MP + NB_S * TS;
constexpr int MPAD = 17664;
constexpr int NCH_P = 33;
constexpr int NQ_P = NB_P * NCH_P;
constexpr int NQ_S = (NB_S * TS) / 64;
constexpr int NQ = NQ_P + NQ_S;
constexpr float EPS = 1e-6f;
constexpr int NWAVES = 8;

enum { I_XP = 0, I_XS, I_SCA, I_SCB, I_SH, I_META, I_GF1, I_W1G, I_W1U, I_W1D, I_GMIX, I_WIN, I_CAW, I_CAB, I_LNG, I_LNB, I_CBW, I_CBB,
       I_WRG, I_BRG, I_WIG, I_BIG, I_LAM, I_WOUT, I_GF2, I_W2G, I_W2U, I_W2D, I_GFIN, N_IN };
constexpr size_t O_YP = 0, O_YS = O_YP + (size_t)NB_P * SEQ * D, O_CAP = O_YS + (size_t)NB_S * TS * D, O_CBP = O_CAP + (size_t)2 * NB_P * 30 * DA,
                 O_HP = O_CBP + (size_t)2 * NB_P * 3 * DB, O_CAS = O_HP + (size_t)2 * NB_P * DB, O_CBS = O_CAS + (size_t)2 * NB_S * 30 * DA,
                 O_HS = O_CBS + (size_t)2 * NB_S * 3 * DB, O_END = O_HS + (size_t)2 * NB_S * DB;

constexpr size_t WS_SS = 0;
constexpr size_t WS_SUMM = 0x80000;
constexpr size_t WS_LAST = 0x1A0000;
constexpr size_t WS_W = 0x400000;
constexpr size_t SZ_WGU = (size_t)2 * FF * D * 2, SZ_WD = (size_t)D * FF * 2, SZ_WIN = (size_t)2048 * D * 2, SZ_WOUT = (size_t)D * D * 2;
constexpr size_t WS_WGU1 = WS_W, WS_WD1 = WS_WGU1 + SZ_WGU, WS_WIN = WS_WD1 + SZ_WD, WS_WOUT = WS_WIN + SZ_WIN, WS_WGU2 = WS_WOUT + SZ_WOUT, WS_WD2 = WS_WGU2 + SZ_WGU;
constexpr size_t WS_X = WS_WD2 + SZ_WD;
constexpr size_t WS_XB = WS_X + (size_t)MPAD * D * 4;
constexpr size_t WS_ACT = WS_XB + (size_t)MPAD * D * 2;
constexpr size_t WS_U = WS_ACT, WS_BX = WS_U + (size_t)MPAD * 512 * 2, WS_GG = WS_BX + (size_t)MPAD * 512 * 2, WS_YAB = WS_GG + (size_t)MPAD * 512 * 2;
constexpr size_t WS_END = WS_ACT + (size_t)MPAD * FF * 2;
static_assert(WS_YAB + (size_t)MPAD * D * 2 <= WS_END, "mixer overlay fits");
static_assert(WS_END <= 268435456, "ws map fits 256 MiB");
static_assert(WS_SS + 7 * (size_t)MPAD * 4 <= WS_SUMM && WS_SUMM + (size_t)NQ * 512 * 8 <= WS_LAST && WS_LAST + (size_t)128 * 512 * 8 <= WS_W, "small buffers");

constexpr int LDS_BYTES = 147456;

__device__ __forceinline__ float bf2f(bf16_t b) { return __uint_as_float(((unsigned)b) << 16); }
__device__ __forceinline__ unsigned pk2(float lo, float hi) { unsigned r; asm("v_cvt_pk_bf16_f32 %0, %1, %2" : "=v"(r) : "v"(lo), "v"(hi)); return r; }
__device__ __forceinline__ unsigned f2bf(float f) { return pk2(f, f) & 0xffffu; }
__device__ __forceinline__ float fast_rcp(float x) { return __builtin_amdgcn_rcpf(x); }
__device__ __forceinline__ float sigmoid_f(float x) { return fast_rcp(1.0f + __expf(-x)); }
__device__ __forceinline__ float silu_f(float x) { return x * sigmoid_f(x); }
__device__ __forceinline__ float gelu_tanh_f(float x) {
    const float u = 0.7978845608028654f * (x + 0.044715f * x * x * x);
    return x * sigmoid_f(2.0f * u);
}
__device__ __forceinline__ float neg_expm1_f(float x) {
    const float p = -x * (1.0f + x * (0.5f + x * (0.16666667f + x * (0.041666668f + x * (0.0083333338f + x * (0.0013888889f + x * 0.0001984127f))))));
    const float q = 1.0f - __expf(x);
    return x > -0.35f ? p : q;
}
__device__ __forceinline__ float wave_sum(float v) {
#pragma unroll
    for (int o = 1; o < 64; o <<= 1) v += __shfl_xor(v, o);
    return v;
}

#define XB_TMO      128
#define XB_XCNT(j)  (256  + 64 * (j))
#define XB_XSUB(j)  (1280 + 64 * (j))
#define XB_XGEN(j)  (2304 + 64 * (j))
#define XB_TOP      3328
#define XB_TOPGEN   3392
#define XCD_BAR_WORDS 3456
#define XB_SPIN_CAP (1u << 18)

__device__ __forceinline__ unsigned xb_ld(unsigned* p)              { return __hip_atomic_load(p, __ATOMIC_RELAXED, __HIP_MEMORY_SCOPE_AGENT); }
__device__ __forceinline__ unsigned xb_add(unsigned* p, unsigned v) { return __hip_atomic_fetch_add(p, v, __ATOMIC_RELAXED, __HIP_MEMORY_SCOPE_AGENT); }
__device__ __forceinline__ unsigned xb_xcc_id() { return (unsigned)__builtin_amdgcn_s_getreg((3 << 11) | 20) & 0xFu; }
#define XB_SPIN(cond, bar) do { unsigned _sp = 0; while (cond) { __builtin_amdgcn_s_sleep(1); \
    if ((++_sp & 255u) == 0u) { if (xb_ld(&(bar)[XB_TMO])) break; if (_sp > XB_SPIN_CAP) { atomicAdd(&(bar)[XB_TMO], 1u); break; } } } } while (0)

struct XcdBarrier {
    unsigned* bar; unsigned x;
    volatile LAS unsigned* st;
};

__device__ __forceinline__ XcdBarrier xcd_barrier_post(unsigned* bar, volatile LAS unsigned* st) {
    XcdBarrier b; b.bar = bar; b.x = xb_xcc_id(); b.st = st;
    if (threadIdx.x == 0) (void)xb_add(&bar[XB_XCNT(b.x)], 1u);
    return b;
}
__device__ __forceinline__ void xcd_barrier_complete(unsigned* bar, unsigned x, unsigned& nloc, unsigned& nx) {
    const unsigned G = gridDim.x * gridDim.y * gridDim.z;
    unsigned sum, cnt, mine, sp = 0u;
    for (;;) {
        sum = 0u; cnt = 0u; mine = 0u;
#pragma unroll
        for (unsigned j = 0; j < 16; ++j) { const unsigned c = xb_ld(&bar[XB_XCNT(j)]); sum += c; cnt += (c > 0u) ? 1u : 0u; mine = (j == x) ? c : mine; }
        if (sum == G) break;
        __builtin_amdgcn_s_sleep(1);
        if ((++sp & 255u) == 0u) { if (xb_ld(&bar[XB_TMO])) break; if (sp > XB_SPIN_CAP) { atomicAdd(&bar[XB_TMO], 1u); break; } }
    }
    nloc = mine > 0u ? mine : 1u; nx = cnt > 0u ? cnt : 1u;
}

__device__ __forceinline__ void xcd_barrier(const XcdBarrier& b, const bool is_t0) {
    asm volatile("s_waitcnt vmcnt(0)" ::: "memory");
    __syncthreads();
    if (is_t0) {
        unsigned* bar = b.bar;
        __builtin_amdgcn_s_waitcnt(0);
        unsigned nloc = b.st[0], nx = b.st[1];
        if (nloc == 0u) { xcd_barrier_complete(bar, b.x, nloc, nx); b.st[0] = nloc; b.st[1] = nx; }
        const unsigned old = xb_add(&bar[XB_XSUB(b.x)], 1u);
        const unsigned gen = old / nloc;
        if (old + 1u == (gen + 1u) * nloc) {
            __builtin_amdgcn_fence(__ATOMIC_RELEASE, "agent");
            asm volatile("s_waitcnt vmcnt(0)" ::: "memory");
            const unsigned og = xb_add(&bar[XB_TOP], 1u);
            const unsigned tg = og / nx;
            if (og + 1u == (tg + 1u) * nx) xb_add(&bar[XB_TOPGEN], 1u);
            else XB_SPIN(xb_ld(&bar[XB_TOPGEN]) == tg, bar);
            __builtin_amdgcn_fence(__ATOMIC_ACQUIRE, "agent");
            xb_add(&bar[XB_XGEN(b.x)], 1u);
            asm volatile("s_waitcnt vmcnt(0)" ::: "memory");
        } else {
            XB_SPIN(xb_ld(&bar[XB_XGEN(b.x)]) == gen, bar);
            __builtin_amdgcn_fence(__ATOMIC_ACQUIRE, "agent");
            asm volatile("s_waitcnt vmcnt(0)" ::: "memory");
        }
    }
    __syncthreads();
}

constexpr size_t WS_BAR = 0x380000;
constexpr int LDS_BARST = 139264;
constexpr size_t WS_SKF = 0x390000;

struct EpiGU {
    static constexpr bool PERM = true, AFTER_DRAIN = false, INIT_ACC = false;
    bf16_t* ACT; const float* ss;
    __device__ __forceinline__ void operator()(const f32x4 (&acc)[2][2][4][2], const pg8::Unit& u, int wr, int wc, int fr, int fq) const {
        const int row0 = u.pm * 256 + wr * 64 + fr, col0 = u.pn * 128 + wc * 32 + 8 * fq;
        float rs[2][4];
#pragma unroll
        for (int ai = 0; ai < 2; ++ai)
#pragma unroll
            for (int m = 0; m < 4; ++m) rs[ai][m] = ss[row0 + ai * 128 + m * 16];
#pragma unroll
        for (int ai = 0; ai < 2; ++ai)
#pragma unroll
            for (int m = 0; m < 4; ++m) {
                const int r = row0 + ai * 128 + m * 16;
                const float rstd = __builtin_amdgcn_rsqf(rs[ai][m] * (1.0f / D) + EPS);
                float o[8];
#pragma unroll
                for (int n = 0; n < 2; ++n)
#pragma unroll
                    for (int e = 0; e < 4; ++e) { const float g = acc[ai][0][m][n][e] * rstd, up = acc[ai][1][m][n][e] * rstd; o[4 * n + e] = silu_f(g) * up; }
                u32x4 w; w.x = pk2(o[0], o[1]); w.y = pk2(o[2], o[3]); w.z = pk2(o[4], o[5]); w.w = pk2(o[6], o[7]);
                *(u32x4*)(ACT + (size_t)r * FF + col0) = w;
            }
    }
};
struct EpiRes {
    static constexpr bool PERM = true, AFTER_DRAIN = false, INIT_ACC = true;
    float* X; bf16_t* XB; float* ssn; float scale;
    __device__ __forceinline__ void init(f32x4 (&acc)[2][2][4][2], const pg8::Unit& u, int wr, int wc, int fr, int fq) const {
        const int row0 = u.pm * 256 + wr * 64 + fr, col0 = u.pn * 256 + wc * 32 + 8 * fq; const float inv = 1.0f / scale;
#pragma unroll
        for (int ai = 0; ai < 2; ++ai)
#pragma unroll
            for (int m = 0; m < 4; ++m)
#pragma unroll
                for (int bj = 0; bj < 2; ++bj) { const float* xp = X + (size_t)(row0 + ai * 128 + m * 16) * D + col0 + bj * 128; acc[ai][bj][m][0] = *(const f32x4*)xp * inv; acc[ai][bj][m][1] = *(const f32x4*)(xp + 4) * inv; }
    }
    __device__ __forceinline__ void operator()(const f32x4 (&acc)[2][2][4][2], const pg8::Unit& u, int wr, int wc, int fr, int fq) const {
        const int row0 = u.pm * 256 + wr * 64 + fr, col0 = u.pn * 256 + wc * 32 + 8 * fq;
#pragma unroll
        for (int ai = 0; ai < 2; ++ai)
#pragma unroll
            for (int m = 0; m < 4; ++m) {
                const int r = row0 + ai * 128 + m * 16; float q = 0.f;
#pragma unroll
                for (int bj = 0; bj < 2; ++bj) {
                    float* xp = X + (size_t)r * D + col0 + bj * 128;
                    const f32x4 v0 = acc[ai][bj][m][0] * scale, v1 = acc[ai][bj][m][1] * scale;
                    *(f32x4*)xp = v0; *(f32x4*)(xp + 4) = v1;
                    u32x4 w; w.x = pk2(v0[0], v0[1]); w.y = pk2(v0[2], v0[3]); w.z = pk2(v1[0], v1[1]); w.w = pk2(v1[2], v1[3]);
                    *(u32x4*)(XB + (size_t)r * D + col0 + bj * 128) = w;
                    q += (v0[0] * v0[0] + v0[1] * v0[1]) + (v0[2] * v0[2] + v0[3] * v0[3]) + (v1[0] * v1[0] + v1[1] * v1[1]) + (v1[2] * v1[2] + v1[3] * v1[3]);
                }
                q += __shfl_xor(q, 16); q += __shfl_xor(q, 32);
                if (fq == 0) atomicAdd(ssn + r, q);
            }
    }
};
struct EpiWin {
    static constexpr bool PERM = true, AFTER_DRAIN = false, INIT_ACC = false;
    bf16_t *U, *BX, *GG; const float* ss;
    __device__ __forceinline__ void operator()(const f32x4 (&acc)[2][2][4][2], const pg8::Unit& u, int wr, int wc, int fr, int fq) const {
        const int row0 = u.pm * 256 + wr * 64 + fr, col0 = (u.pn & 3) * 128 + wc * 32 + 8 * fq;
        const bool isA = u.pn < 4;
        float rs[2][4];
#pragma unroll
        for (int ai = 0; ai < 2; ++ai)
#pragma unroll
            for (int m = 0; m < 4; ++m) rs[ai][m] = ss[row0 + ai * 128 + m * 16];
#pragma unroll
        for (int ai = 0; ai < 2; ++ai)
#pragma unroll
            for (int m = 0; m < 4; ++m) {
                const int r = row0 + ai * 128 + m * 16;
                const float rstd = __builtin_amdgcn_rsqf(rs[ai][m] * (1.0f / D) + EPS);
                float a0[8], a1[8];
#pragma unroll
                for (int n = 0; n < 2; ++n)
#pragma unroll
                    for (int e = 0; e < 4; ++e) { a0[4 * n + e] = acc[ai][0][m][n][e] * rstd; a1[4 * n + e] = acc[ai][1][m][n][e] * rstd; }
                if (isA) {
                    float o[8];
#pragma unroll
                    for (int e = 0; e < 8; ++e) o[e] = a0[e] * sigmoid_f(a1[e]);
                    u32x4 w; w.x = pk2(o[0], o[1]); w.y = pk2(o[2], o[3]); w.z = pk2(o[4], o[5]); w.w = pk2(o[6], o[7]);
                    *(u32x4*)(U + (size_t)r * 512 + col0) = w;
                } else {
                    float o[8];
#pragma unroll
                    for (int e = 0; e < 8; ++e) o[e] = gelu_tanh_f(a1[e]);
                    u32x4 w; w.x = pk2(a0[0], a0[1]); w.y = pk2(a0[2], a0[3]); w.z = pk2(a0[4], a0[5]); w.w = pk2(a0[6], a0[7]);
                    *(u32x4*)(BX + (size_t)r * 512 + col0) = w;
                    u32x4 g; g.x = pk2(o[0], o[1]); g.y = pk2(o[2], o[3]); g.z = pk2(o[4], o[5]); g.w = pk2(o[6], o[7]);
                    *(u32x4*)(GG + (size_t)r * 512 + col0) = g;
                }
            }
    }
};

struct Args { const float* in[N_IN]; float* out; unsigned char* ws; int ph_lo, ph_hi; };
struct Frame {
    LAS unsigned char* lds;
    int tid, lane, wave, G;
    const float* const __attribute__((address_space(4)))* in; float* out; unsigned char* ws;
};
#define LDS_WAIT() asm volatile("s_waitcnt lgkmcnt(0)" ::: "memory")

template <class FrameT>
__device__ __forceinline__ void res_fixup(FrameT& F, const EpiRes& E, const pg8::DpSplit& S) {
    const int nleft = S.nwg - S.G, tid = F.tid, wid = tid >> 6, lane = tid & 63, wr = wid >> 2, wc = wid & 3, fr = lane & 15, fq = lane >> 4;
    for (int item = blockIdx.x; item < nleft * 8; item += F.G) {
        const int j = item >> 3, ai = (item >> 2) & 1, m = item & 3;
        pg8::Unit u; S.unit_of(S.G + j, u);
        const int r = u.pm * 256 + wr * 64 + fr + ai * 128 + m * 16, col0 = u.pn * 256 + wc * 32 + 8 * fq;
        float q = 0.f;
#pragma unroll
        for (int bj = 0; bj < 2; ++bj) {
            f32x4 a0 = {0.f, 0.f, 0.f, 0.f}, a1 = {0.f, 0.f, 0.f, 0.f};
#pragma unroll
            for (int p = 0; p < 4; ++p) {
                const float* sp = S.slab + (size_t)(4 * j + p) * 65536 + (size_t)(((ai * 2 + bj) * 4 + m) * 2048) + tid * 4;
                const u32x4 w = __builtin_nontemporal_load((const u32x4*)sp);
                a0 += (f32x4){__uint_as_float(w.x << 16), __uint_as_float(w.x & 0xffff0000u), __uint_as_float(w.y << 16), __uint_as_float(w.y & 0xffff0000u)};
                a1 += (f32x4){__uint_as_float(w.z << 16), __uint_as_float(w.z & 0xffff0000u), __uint_as_float(w.w << 16), __uint_as_float(w.w & 0xffff0000u)};
            }
            float* xp = E.X + (size_t)r * D + col0 + bj * 128;
            f32x4 v0 = *(f32x4*)xp, v1 = *(f32x4*)(xp + 4);
            v0 = v0 + a0 * E.scale; v1 = v1 + a1 * E.scale;
            *(f32x4*)xp = v0; *(f32x4*)(xp + 4) = v1;
            u32x4 w; w.x = pk2(v0[0], v0[1]); w.y = pk2(v0[2], v0[3]); w.z = pk2(v1[0], v1[1]); w.w = pk2(v1[2], v1[3]);
            *(u32x4*)(E.XB + (size_t)r * D + col0 + bj * 128) = w;
            q += (v0[0] * v0[0] + v0[1] * v0[1]) + (v0[2] * v0[2] + v0[3] * v0[3]) + (v1[0] * v1[0] + v1[1] * v1[1]) + (v1[2] * v1[2] + v1[3] * v1[3]);
        }
        q += __shfl_xor(q, 16); q += __shfl_xor(q, 32);
        if (fq == 0) atomicAdd(E.ssn + r, q);
    }
}


__device__ __forceinline__ void transpose_item(const float* W, int K, int N, bf16_t* WT, const float* g, int mode, LAS float* scr, int item, int lane) {
    const int nblk = N / 32, kb = item / nblk, nb = item % nblk, k0 = 64 * kb, n0 = 32 * nb;
    float tv[32];
#pragma unroll
    for (int i = 0; i < 32; ++i) { const int kk = 2 * i + (lane >> 5); tv[i] = __builtin_nontemporal_load(W + (size_t)(k0 + kk) * N + n0 + (lane & 31)); }
    if (g) {
#pragma unroll
        for (int i = 0; i < 32; ++i) tv[i] *= g[k0 + 2 * i + (lane >> 5)];
    }
#pragma unroll
    for (int i = 0; i < 32; ++i) scr[(2 * i + (lane >> 5)) * 33 + (lane & 31)] = tv[i];
    LDS_WAIT(); asm volatile("" ::: "memory");
    int d0;
    if (mode == 0) d0 = n0;
    else if (mode == 1) d0 = 256 * (n0 >> 7) + (n0 & 127);
    else if (mode == 2) d0 = 256 * (n0 >> 7) + 128 + (n0 & 127);
    else { const int seg = n0 >> 9, cc = n0 & 511; d0 = 256 * ((seg >> 1) * 4 + (cc >> 7)) + 128 * (seg & 1) + (cc & 127); }
    const int c = lane & 7;
#pragma unroll
    for (int j = 0; j < 4; ++j) { const int n = (lane >> 3) + 8 * j; const LAS float* s = scr + (8 * c) * 33 + n;
        u32x4 o; o.x = pk2(s[0 * 33], s[1 * 33]); o.y = pk2(s[2 * 33], s[3 * 33]); o.z = pk2(s[4 * 33], s[5 * 33]); o.w = pk2(s[6 * 33], s[7 * 33]);
        *(u32x4*)(WT + (size_t)(d0 + n) * K + k0 + 8 * c) = o; }
    LDS_WAIT(); asm volatile("" ::: "memory");
}
constexpr int IT_G = (D / 64) * (FF / 32), IT_D = (FF / 64) * (D / 32), IT_WIN = (D / 64) * (2048 / 32), IT_WOUT = (D / 64) * (D / 32);
__device__ __forceinline__ void convert_mats(Frame& F, int l, int id_lo, int id_hi, int gw, int NGW) {
    LAS float* scr = (LAS float*)(F.lds + F.wave * 16384);
    unsigned char* ws = F.ws;
    for (int id = id_lo; id < id_hi; ++id) {
        const int nit = (id == 0 || id == 4) ? 2 * IT_G : (id == 1 || id == 5) ? IT_D : (id == 2 ? IT_WIN : IT_WOUT);
        for (int it = gw; it < nit; it += NGW) {
            if (id == 0) { const bool up = it >= IT_G; transpose_item(F.in[up ? I_W1U : I_W1G] + (size_t)l * D * FF, D, FF, (bf16_t*)(ws + WS_WGU1), F.in[I_GF1] + l * D, up ? 2 : 1, scr, up ? it - IT_G : it, F.lane); }
            else if (id == 4) { const bool up = it >= IT_G; transpose_item(F.in[up ? I_W2U : I_W2G] + (size_t)l * D * FF, D, FF, (bf16_t*)(ws + WS_WGU2), F.in[I_GF2] + l * D, up ? 2 : 1, scr, up ? it - IT_G : it, F.lane); }
            else if (id == 1) transpose_item(F.in[I_W1D] + (size_t)l * D * FF, FF, D, (bf16_t*)(ws + WS_WD1), nullptr, 0, scr, it, F.lane);
            else if (id == 5) transpose_item(F.in[I_W2D] + (size_t)l * D * FF, FF, D, (bf16_t*)(ws + WS_WD2), nullptr, 0, scr, it, F.lane);
            else if (id == 2) transpose_item(F.in[I_WIN] + (size_t)l * D * 2048, D, 2048, (bf16_t*)(ws + WS_WIN), F.in[I_GMIX] + l * D, 3, scr, it, F.lane);
            else transpose_item(F.in[I_WOUT] + (size_t)l * D * D, D, D, (bf16_t*)(ws + WS_WOUT), nullptr, 0, scr, it, F.lane);
        }
    }
}

__device__ __forceinline__ void p0_prologue(Frame& F) {
    convert_mats(F, 0, 0, 3, blockIdx.x * NWAVES + F.wave, F.G * NWAVES);
    const int gw = blockIdx.x * NWAVES + F.wave, NGW = F.G * NWAVES;
    float* X = (float*)(F.ws + WS_X); bf16_t* XB = (bf16_t*)(F.ws + WS_XB); float* ss = (float*)(F.ws + WS_SS);
    for (int r = gw; r < MPAD; r += NGW) {
        const float* src = nullptr;
        if (r < MP) { const int b = r / TP, tt = r - b * TP; src = tt < NMETA ? F.in[I_META] + (size_t)tt * D : F.in[I_XP] + ((size_t)b * SEQ + (tt - NMETA)) * D; }
        else if (r < MR) src = F.in[I_XS] + (size_t)(r - MP) * D;
        f32x4 v[4]; float s = 0.f;
#pragma unroll
        for (int j = 0; j < 4; ++j) { v[j] = src ? __builtin_nontemporal_load((const f32x4*)src + F.lane + 64 * j) : (f32x4){0.f, 0.f, 0.f, 0.f}; s += (v[j][0] * v[j][0] + v[j][1] * v[j][1]) + (v[j][2] * v[j][2] + v[j][3] * v[j][3]); }
        s = wave_sum(s);
#pragma unroll
        for (int j = 0; j < 4; ++j) { ((f32x4*)(X + (size_t)r * D))[F.lane + 64 * j] = v[j];
            u32x2 w; w.x = pk2(v[j][0], v[j][1]); w.y = pk2(v[j][2], v[j][3]); ((u32x2*)(XB + (size_t)r * D))[F.lane + 64 * j] = w; }
        if (F.lane == 0) ss[r] = s;
    }
    { const int i = blockIdx.x * 512 + F.tid; if (i < 6 * MPAD) ss[MPAD + i] = 0.f; }
}

__device__ __forceinline__ void final_phase(Frame& F) {
    const int gw = blockIdx.x * NWAVES + F.wave, NGW = F.G * NWAVES;
    const float* X = (const float*)(F.ws + WS_X); const float* ss = (const float*)(F.ws + WS_SS) + 6 * MPAD; const float* g = F.in[I_GFIN];
    f32x4 gv[4];
#pragma unroll
    for (int j = 0; j < 4; ++j) gv[j] = ((const f32x4*)g)[F.lane + 64 * j];
    for (int r = gw; r < MR; r += NGW) {
        float* dst;
        if (r < MP) { const int b = r / TP, tt = r - b * TP; if (tt < NMETA) continue; dst = F.out + O_YP + ((size_t)b * SEQ + (tt - NMETA)) * D; }
        else dst = F.out + O_YS + (size_t)(r - MP) * D;
        const float rstd = __builtin_amdgcn_rsqf(ss[r] * (1.0f / D) + EPS);
#pragma unroll
        for (int j = 0; j < 4; ++j) { const f32x4 v = ((const f32x4*)(X + (size_t)r * D))[F.lane + 64 * j]; __builtin_nontemporal_store(v * rstd * gv[j], (f32x4*)dst + F.lane + 64 * j); }
    }
}

constexpr int LDS_WR = 0, LDS_WI = 16384, LDS_CBT = 32768, LDS_GRP = LDS_CBT + 4 * 64 * 68 * 4, LDS_RED = 0;

__device__ __forceinline__ float reduce_scatter32(float (&v)[32], int lane) {
#define RS_STEP(H, M) { const bool up = (lane & (M)) != 0; _Pragma("unroll") for (int i = 0; i < (H); ++i) { const float snd = up ? v[i] : v[i + (H)], kp = up ? v[i + (H)] : v[i]; v[i] = kp + __shfl_xor(snd, (M)); } }
    RS_STEP(16, 32) RS_STEP(8, 16) RS_STEP(4, 8) RS_STEP(2, 4) RS_STEP(1, 2)
#undef RS_STEP
    return v[0] + __shfl_xor(v[0], 1);
}

__device__ __forceinline__ void mix_job_a(Frame& F, int l, int sp, int gi) {
    const int tid = F.tid, c = 128 * gi + (tid & 127), sub = tid >> 7;
    const bf16_t* U = (const bf16_t*)(F.ws + WS_U); bf16_t* YAB = (bf16_t*)(F.ws + WS_YAB);
    const float* cw = F.in[I_CAW] + (size_t)l * 31 * DA;
    float w[31];
#pragma unroll
    for (int k = 0; k < 31; ++k) w[k] = cw[k * DA + c];
    const float cbias = F.in[I_CAB][l * DA + c], lg = F.in[I_LNG][l * DA + c], lb = F.in[I_LNB][l * DA + c];
    float acc[32];
#pragma unroll
    for (int t = 0; t < 32; ++t) acc[t] = cbias;
    int rowbase, nval;
    if (sp < 136) {
        const int b = sp / 17, k2 = sp - b * 17, nvalid = (k2 == 16) ? 16 : 128, seqrow0 = b * TP, tb = 128 * k2 + 32 * sub;
        nval = nvalid - 32 * sub; rowbase = seqrow0 + tb;
        if (nval > 0) {
#pragma unroll
            for (int tt = 0; tt < 62; ++tt) {
                const int ti = tb - 30 + tt;
                const float v = ti >= 0 ? bf2f(U[(size_t)(seqrow0 + ti) * 512 + c]) : 0.f;
#pragma unroll
                for (int t = 0; t < 32; ++t) { const int kk = tt - t; if (kk >= 0 && kk <= 30) acc[t] += w[kk] * v; }
            }
        }
    } else {
        nval = 32; const int s0 = 16 * (sp - 136) + 4 * sub; rowbase = MP + 8 * s0;
        const float* st = F.in[I_SCA] + (size_t)l * NB_S * 30 * DA;
#pragma unroll
        for (int hs = 0; hs < 4; ++hs) {
            const int s = s0 + hs, rowS = MP + 8 * s;
#pragma unroll
            for (int tt = 0; tt < 38; ++tt) {
                const float v = tt < 30 ? st[((size_t)s * 30 + tt) * DA + c] : bf2f(U[(size_t)(rowS + tt - 30) * 512 + c]);
#pragma unroll
                for (int t = 0; t < 8; ++t) { const int kk = tt - t; if (kk >= 0 && kk <= 30) acc[8 * hs + t] += w[kk] * v; }
            }
        }
    }
    LAS f32x2* red = (LAS f32x2*)(F.lds + LDS_RED);
    float s1[32], s2[32];
#pragma unroll
    for (int t = 0; t < 32; ++t) { s1[t] = acc[t]; s2[t] = acc[t] * acc[t]; }
    const float r1 = reduce_scatter32(s1, F.lane), r2 = reduce_scatter32(s2, F.lane);
    __syncthreads();
    if ((F.lane & 1) == 0) red[F.wave * 32 + (F.lane >> 1)] = (f32x2){r1, r2};
    __syncthreads();
    if (nval > 0) {
#pragma unroll
        for (int t = 0; t < 32; ++t) {
            const f32x2 a = red[F.wave * 32 + t], o = red[(F.wave ^ 1) * 32 + t];
            const float mean = (a.x + o.x) * (1.0f / 128.0f), var = (a.y + o.y) * (1.0f / 128.0f) - mean * mean;
            const float rstd = __builtin_amdgcn_rsqf(fmaxf(var, 0.f) + EPS);
            const float y = (acc[t] - mean) * rstd * lg + lb;
            if (t < nval) YAB[(size_t)(rowbase + t) * D + c] = (bf16_t)f2bf(silu_f(y));
        }
    }
}

constexpr int WJ_TILE = 9728;
constexpr int LDS_WT = 8 * WJ_TILE;
typedef short bf16x8_t __attribute__((ext_vector_type(8)));

__device__ __forceinline__ void mix_b_wave_jobs(Frame& F, int l) {
    const int lane = F.lane, wave = F.wave, fr = lane & 15, fq = lane >> 4, h = blockIdx.x & 7;
    const bf16_t* BX = (const bf16_t*)(F.ws + WS_BX);
    bf16_t* YAB = (bf16_t*)(F.ws + WS_YAB); bf16_t* PCG = (bf16_t*)(F.ws + WS_XB);
    LAS bf16_t* WT = (LAS bf16_t*)(F.lds + LDS_WT);
    LAS bf16_t* tile = (LAS bf16_t*)(F.lds + wave * WJ_TILE);
    __syncthreads();
    {
        const f32x4* gr = (const f32x4*)(F.in[I_WRG] + (size_t)(l * 8 + h) * 4096); const f32x4* gx = (const f32x4*)(F.in[I_WIG] + (size_t)(l * 8 + h) * 4096);
#pragma unroll
        for (int e = 0; e < 2; ++e) {
            const int idx = F.tid + e * 512, i = idx >> 4, j4 = (idx & 15) * 4;
            const f32x4 a = gr[idx], b = gx[idx];
#pragma unroll
            for (int d = 0; d < 4; ++d) { WT[(j4 + d) * 72 + i] = (bf16_t)f2bf(a[d]); WT[(64 + j4 + d) * 72 + i] = (bf16_t)f2bf(b[d]); }
        }
    }
    float bra[4], bix[4], sp[4];
#pragma unroll
    for (int nt = 0; nt < 4; ++nt) {
        const int c = 64 * h + 16 * nt + fr;
        bra[nt] = F.in[I_BRG][l * DB + c]; bix[nt] = F.in[I_BIG][l * DB + c];
        sp[nt] = log1pf(expf(-F.in[I_LAM][l * DB + c]));
    }
    __syncthreads();
    for (int q = (int)(blockIdx.x >> 3) * 8 + wave; q < NQ; q += 256) {
        const bool prompt = q < NQ_P;
        int row0, t0, nvalid;
        if (prompt) { const int b_ = q / NCH_P, k = q - b_ * NCH_P; row0 = b_ * TP + 64 * k; t0 = 64 * k; nvalid = (k == NCH_P - 1) ? 16 : 64; }
        else { row0 = MP + 64 * (q - NQ_P); t0 = 0; nvalid = 64; }
        int ln = lane; asm volatile("" : "+v"(ln));
#pragma unroll
        for (int i = 0; i < 9; ++i) {
            const int p = ln + 64 * i;
            if (p < 536) {
                const int rr = p >> 3, pc = p & 7, row = rr - 3;
                const bool okr = prompt ? (t0 + row >= 0) : (row >= 0);
                u32x4 v = *(const u32x4*)(BX + (size_t)(row0 + (okr ? row : 0)) * 512 + 64 * h + 8 * pc);
                if (!okr) v = (u32x4){0u, 0u, 0u, 0u};
                *(LAS u32x4*)(tile + rr * 72 + 8 * pc) = v;
            }
        }
        float wb[4][4], bb[4];
        { int fr_l = fr; asm volatile("" : "+v"(fr_l));
#pragma unroll
        for (int nt = 0; nt < 4; ++nt) {
            const int c = 64 * h + 16 * nt + fr_l;
#pragma unroll
            for (int k = 0; k < 4; ++k) wb[k][nt] = F.in[I_CBW][((size_t)l * 4 + k) * DB + c];
            bb[nt] = F.in[I_CBB][l * DB + c];
        } }
        float cbv[4][4][4];
#pragma unroll
        for (int mt = 0; mt < 4; ++mt)
#pragma unroll
            for (int nt = 0; nt < 4; ++nt) {
                const int tb = 16 * mt + 4 * fq; float x[7];
#pragma unroll
                for (int i = 0; i < 7; ++i) x[i] = bf2f(tile[(tb + i) * 72 + 16 * nt + fr]);
                if (!prompt && !(fq & 1)) {
                    const int s = 8 * (q - NQ_P) + 2 * mt + (fq >> 1);
                    const float* st = F.in[I_SCB] + ((size_t)l * NB_S + s) * 3 * DB + 64 * h + 16 * nt + fr;
                    x[0] = st[0]; x[1] = st[DB]; x[2] = st[2 * DB];
                }
#pragma unroll
                for (int e = 0; e < 4; ++e) cbv[mt][nt][e] = bb[nt] + wb[0][nt] * x[e] + wb[1][nt] * x[e + 1] + wb[2][nt] * x[e + 2] + wb[3][nt] * x[e + 3];
            }
        asm volatile("s_waitcnt lgkmcnt(0)" ::: "memory");
#pragma unroll
        for (int mt = 0; mt < 4; ++mt)
#pragma unroll
            for (int nt = 0; nt < 4; ++nt)
#pragma unroll
                for (int e = 0; e < 4; ++e) tile[(16 * mt + 4 * fq + e) * 72 + 16 * nt + fr] = (bf16_t)f2bf(cbv[mt][nt][e]);
        asm volatile("s_waitcnt lgkmcnt(0)" ::: "memory");
        float Pc[4] = {1.f, 1.f, 1.f, 1.f}, Hc[4] = {0.f, 0.f, 0.f, 0.f};
#pragma unroll
        for (int mt = 0; mt < 4; ++mt) {
            const bf16x8_t a0 = *(const LAS bf16x8_t*)(tile + (16 * mt + fr) * 72 + 8 * fq), a1 = *(const LAS bf16x8_t*)(tile + (16 * mt + fr) * 72 + 32 + 8 * fq);
#pragma unroll
            for (int nt = 0; nt < 4; ++nt) {
                const int c = 64 * h + 16 * nt + fr;
                const bf16x8_t br0 = *(const LAS bf16x8_t*)(WT + (16 * nt + fr) * 72 + 8 * fq), br1 = *(const LAS bf16x8_t*)(WT + (16 * nt + fr) * 72 + 32 + 8 * fq);
                const bf16x8_t bi0 = *(const LAS bf16x8_t*)(WT + (64 + 16 * nt + fr) * 72 + 8 * fq), bi1 = *(const LAS bf16x8_t*)(WT + (64 + 16 * nt + fr) * 72 + 32 + 8 * fq);
                f32x4 accR = {0.f, 0.f, 0.f, 0.f}, accI = {0.f, 0.f, 0.f, 0.f};
                accR = __builtin_amdgcn_mfma_f32_16x16x32_bf16(a0, br0, accR, 0, 0, 0); accR = __builtin_amdgcn_mfma_f32_16x16x32_bf16(a1, br1, accR, 0, 0, 0);
                accI = __builtin_amdgcn_mfma_f32_16x16x32_bf16(a0, bi0, accI, 0, 0, 0); accI = __builtin_amdgcn_mfma_f32_16x16x32_bf16(a1, bi1, accI, 0, 0, 0);
                float P4[4], H4[4]; float hp = 0.f, pp = 1.f;
#pragma unroll
                for (int e = 0; e < 4; ++e) {
                    const float r = sigmoid_f(accR[e] + bra[nt]), ig = sigmoid_f(accI[e] + bix[nt]);
                    const float la = -8.0f * r * sp[nt], a = __expf(la), bt = __builtin_amdgcn_sqrtf(neg_expm1_f(2.0f * la)) * (ig * bf2f(tile[(16 * mt + 4 * fq + e) * 72 + 16 * nt + fr]));
                    hp = a * hp + bt; pp = pp * a; H4[e] = hp; P4[e] = pp;
                }
                float pex = 1.f, hex = 0.f;
#pragma unroll
                for (int d = 3; d >= 1; --d) {
                    const float ps = __shfl(pp, lane - 16 * d), hs = __shfl(hp, lane - 16 * d);
                    const bool use = prompt ? (fq >= d) : (d == 1 && (fq & 1));
                    if (use) { hex = ps * hex + hs; pex = pex * ps; }
                }
                const float pin = prompt ? Pc[nt] * pex : pex, hin = prompt ? pex * Hc[nt] + hex : hex;
                float Pf[4], Hf[4];
#pragma unroll
                for (int e = 0; e < 4; ++e) { Hf[e] = H4[e] + P4[e] * hin; Pf[e] = P4[e] * pin; }
                Pc[nt] = __shfl(Pf[3], fr + 48); Hc[nt] = __shfl(Hf[3], fr + 48);
#pragma unroll
                for (int e = 0; e < 4; ++e) {
                    const int tl = 16 * mt + 4 * fq + e;
                    if (tl < nvalid) { const size_t row = (size_t)(row0 + tl); YAB[row * D + 512 + c] = (bf16_t)f2bf(Hf[e]); PCG[row * 512 + c] = (bf16_t)f2bf(Pf[e]); }
                }
                if (prompt) { if (16 * (mt + 1) == nvalid && fq == 3) ((f32x2*)(F.ws + WS_SUMM))[(size_t)q * 512 + c] = (f32x2){Pf[3], Hf[3]}; }
                else if (fq & 1) { const int s = 8 * (q - NQ_P) + 2 * mt + (fq >> 1); ((f32x2*)(F.ws + WS_LAST))[(size_t)s * 512 + c] = (f32x2){Pf[3], Hf[3]}; }
            }
        }
    }
}

constexpr int LDS_ARED = 98304;
__device__ __forceinline__ float reduce_scatter16(float (&v)[16], int lane) {
#define RS_STEP(H, M) { const bool up = (lane & (M)) != 0; _Pragma("unroll") for (int i = 0; i < (H); ++i) { const float snd = up ? v[i] : v[i + (H)], kp = up ? v[i + (H)] : v[i]; v[i] = kp + __shfl_xor(snd, (M)); } }
    RS_STEP(8, 32) RS_STEP(4, 16) RS_STEP(2, 8) RS_STEP(1, 4)
#undef RS_STEP
    float r = v[0]; r += __shfl_xor(r, 2); r += __shfl_xor(r, 1); return r;
}
__device__ __forceinline__ void mix_a_wave_jobs(Frame& F, int l) {
    const int lane = F.lane, wave = F.wave, gi = wave & 3, c0 = 128 * gi + 2 * lane;
    const bf16_t* U = (const bf16_t*)(F.ws + WS_U); bf16_t* YAB = (bf16_t*)(F.ws + WS_YAB);
    const float* cw = F.in[I_CAW] + (size_t)l * 31 * DA;
    f32x2 w[31];
#pragma unroll
    for (int k = 0; k < 31; ++k) w[k] = *(const f32x2*)(cw + k * DA + c0);
    const f32x2 cbv = *(const f32x2*)(F.in[I_CAB] + l * DA + c0), lgv = *(const f32x2*)(F.in[I_LNG] + l * DA + c0), lbv = *(const f32x2*)(F.in[I_LNB] + l * DA + c0);
    LAS f32x2* red = (LAS f32x2*)(F.lds + LDS_ARED + wave * 128);
    for (int tb = 511 - ((int)blockIdx.x * 2 + (wave >> 2)); tb < 1096; tb += 512) {
        f32x2 a[16];
#pragma unroll
        for (int t = 0; t < 16; ++t) a[t] = cbv;
        int rowbase;
        if (tb < 1032) {
            const int b = tb / 129, kb = tb - b * 129, t0 = 16 * kb, seqrow0 = b * TP; rowbase = seqrow0 + t0;
            unsigned raw[46];
#pragma unroll
            for (int tt = 0; tt < 46; ++tt) { const int ti = t0 - 30 + tt; raw[tt] = *(const unsigned*)(U + (size_t)(seqrow0 + (ti < 0 ? 0 : ti)) * 512 + c0); }
#pragma unroll
            for (int tt = 0; tt < 46; ++tt) {
                const unsigned rw = ((t0 - 30 + tt) >= 0) ? raw[tt] : 0u;
                const f32x2 v = {__uint_as_float(rw << 16), __uint_as_float(rw & 0xffff0000u)};
#pragma unroll
                for (int t = 0; t < 16; ++t) { const int kk = tt - t; if (kk >= 0 && kk <= 30) a[t] += w[kk] * v; }
            }
        } else {
            const int s0 = 2 * (tb - 1032); rowbase = MP + 8 * s0;
            const float* st = F.in[I_SCA] + (size_t)l * NB_S * 30 * DA;
#pragma unroll
            for (int hs = 0; hs < 2; ++hs) {
                const int s = s0 + hs, rowS = MP + 8 * s;
#pragma unroll
                for (int tt = 0; tt < 38; ++tt) {
                    f32x2 v;
                    if (tt < 30) v = __builtin_nontemporal_load((const f32x2*)(st + ((size_t)s * 30 + tt) * DA + c0));
                    else { const unsigned rw = *(const unsigned*)(U + (size_t)(rowS + tt - 30) * 512 + c0); v = (f32x2){__uint_as_float(rw << 16), __uint_as_float(rw & 0xffff0000u)}; }
#pragma unroll
                    for (int t = 0; t < 8; ++t) { const int kk = tt - t; if (kk >= 0 && kk <= 30) a[8 * hs + t] += w[kk] * v; }
                }
            }
        }
        float s1[16], s2[16];
#pragma unroll
        for (int t = 0; t < 16; ++t) { s1[t] = a[t].x + a[t].y; s2[t] = a[t].x * a[t].x + a[t].y * a[t].y; }
        const float r1 = reduce_scatter16(s1, lane), r2 = reduce_scatter16(s2, lane);
        if ((lane & 3) == 0) red[lane >> 2] = (f32x2){r1, r2};
        asm volatile("s_waitcnt lgkmcnt(0)" ::: "memory");
#pragma unroll
        for (int t = 0; t < 16; ++t) {
            const f32x2 st_ = red[t];
            const float mean = st_.x * (1.0f / 128.0f), var = st_.y * (1.0f / 128.0f) - mean * mean;
            const float rstd = __builtin_amdgcn_rsqf(fmaxf(var, 0.f) + EPS);
            const f32x2 y = (a[t] - mean) * rstd * lgv + lbv;
            *(unsigned*)(YAB + (size_t)(rowbase + t) * D + c0) = pk2(silu_f(y.x), silu_f(y.y));
        }
        asm volatile("s_waitcnt lgkmcnt(0)" ::: "memory");
    }
}

__device__ __forceinline__ void mix_job_state(Frame& F, int l, int s) {
    const int c = F.tid;
    const bf16_t* U = (const bf16_t*)(F.ws + WS_U); const bf16_t* BX = (const bf16_t*)(F.ws + WS_BX);
    if (s < NB_P) {
        const int b = s; float* oa = F.out + O_CAP + ((size_t)l * NB_P + b) * 30 * DA; float* ob = F.out + O_CBP + ((size_t)l * NB_P + b) * 3 * DB;
#pragma unroll 10
        for (int i = 0; i < 30; ++i) __builtin_nontemporal_store(bf2f(U[(size_t)(b * TP + TP - 30 + i) * 512 + c]), oa + i * DA + c);
#pragma unroll
        for (int i = 0; i < 3; ++i) __builtin_nontemporal_store(bf2f(BX[(size_t)(b * TP + TP - 3 + i) * 512 + c]), ob + i * DB + c);
    } else {
        const int b = s - NB_P, rowS = MP + 8 * b; float* oa = F.out + O_CAS + ((size_t)l * NB_S + b) * 30 * DA; float* ob = F.out + O_CBS + ((size_t)l * NB_S + b) * 3 * DB;
        const float* st = F.in[I_SCA] + ((size_t)l * NB_S + b) * 30 * DA;
#pragma unroll 11
        for (int i = 0; i < 22; ++i) __builtin_nontemporal_store(__builtin_nontemporal_load(st + (8 + i) * DA + c), oa + i * DA + c);
#pragma unroll
        for (int i = 22; i < 30; ++i) __builtin_nontemporal_store(bf2f(U[(size_t)(rowS + i - 22) * 512 + c]), oa + i * DA + c);
#pragma unroll
        for (int i = 0; i < 3; ++i) __builtin_nontemporal_store(bf2f(BX[(size_t)(rowS + 5 + i) * 512 + c]), ob + i * DB + c);
    }
}

__device__ __forceinline__ void mix_a_phase(Frame& F, int l, int sel) {
    if (sel & 1) mix_b_wave_jobs(F, l);
    if (!(sel & 2)) return;
    { int t_ = F.tid; asm volatile("" : "+v"(t_)); F.tid = t_; F.lane = t_ & 63; }
    mix_a_wave_jobs(F, l);
    { int t_ = F.tid; asm volatile("" : "+v"(t_)); F.tid = t_; F.lane = t_ & 63; }
    const int b = blockIdx.x;
    if (b >= 64 && b - 64 < NB_P + NB_S) mix_job_state(F, l, b - 64);
}

__device__ __forceinline__ void mix_c_phase(Frame& F, int l, int rep) {
    const int c = F.tid;
    bf16_t* YAB = (bf16_t*)(F.ws + WS_YAB); const bf16_t* PCG = (const bf16_t*)(F.ws + WS_XB); const bf16_t* GGp = (const bf16_t*)(F.ws + WS_GG);
    const f32x2* SUMM = (const f32x2*)(F.ws + WS_SUMM); const f32x2* LAST = (const f32x2*)(F.ws + WS_LAST);
    for (int job = blockIdx.x; job < NQ * 2; job += F.G) {
        const int q = job >> 1, hh = job & 1;
        if (q < NQ_P) {
            const int b = q / NCH_P, k = q - b * NCH_P, nvalid = (k == NCH_P - 1) ? 16 : 64, row0 = b * TP + 64 * k;
            if (32 * hh >= nvalid) continue;
            float carry = 0.f;
            {
                f32x2 ph[32];
#pragma unroll
                for (int e = 0; e < 32; ++e) { const int kk = e < k ? e : 0; ph[e] = SUMM[(size_t)(b * NCH_P + kk) * 512 + c]; }
#pragma unroll
                for (int e = 0; e < 32; ++e) { const float px = e < k ? ph[e].x : 1.f, py = e < k ? ph[e].y : 0.f; carry = px * carry + py; }
            }
            const int r1 = (32 * hh + 32 < nvalid) ? 32 * hh + 32 : nvalid;
            for (int r = 32 * hh; r < r1; ++r) {
                const size_t row = row0 + r;
                const float y = (bf2f(YAB[row * D + 512 + c]) + bf2f(PCG[row * 512 + c]) * carry) * bf2f(GGp[row * 512 + c]);
                if (rep) ((bf16_t*)(F.ws + WS_U))[row * 512 + c] = (bf16_t)f2bf(y); else
                YAB[row * D + 512 + c] = (bf16_t)f2bf(y);
            }
            if (k == NCH_P - 1 && hh == 0) { const f32x2 ph = SUMM[(size_t)q * 512 + c]; F.out[O_HP + ((size_t)l * NB_P + b) * DB + c] = ph.y + ph.x * carry; }
        } else {
            const int row0 = MP + 64 * (q - NQ_P);
            for (int r = 32 * hh; r < 32 * hh + 32; ++r) {
                const int s = 8 * (q - NQ_P) + (r >> 3); const size_t row = row0 + r;
                const float carry = F.in[I_SH][((size_t)l * NB_S + s) * DB + c];
                const float y = (bf2f(YAB[row * D + 512 + c]) + bf2f(PCG[row * 512 + c]) * carry) * bf2f(GGp[row * 512 + c]);
                if (rep) ((bf16_t*)(F.ws + WS_U))[row * 512 + c] = (bf16_t)f2bf(y); else
                YAB[row * D + 512 + c] = (bf16_t)f2bf(y);
                if ((r & 7) == 7) { const f32x2 ph = LAST[(size_t)s * 512 + c]; F.out[O_HS + ((size_t)l * NB_S + s) * DB + c] = ph.y + ph.x * carry; }
            }
        }
    }
}

constexpr int NPH = 18;
#ifndef PHMASK
#define PHMASK 127
#endif
#define DUPMASK 0
#define MIXSEL 1
__global__ void __launch_bounds__(NWAVES * 64, 2) mega_fwd(Args args) {
    extern __shared__ __attribute__((aligned(16))) unsigned char lds[];
    Frame F;
    F.lds = (LAS unsigned char*)lds; F.G = gridDim.x;
    if (threadIdx.x < 2) ((volatile LAS unsigned*)(F.lds + LDS_BARST))[threadIdx.x] = 0u;
    __syncthreads();
    if (args.ph_hi - args.ph_lo > 1) (void)xcd_barrier_post((unsigned*)(args.ws + WS_BAR), (volatile LAS unsigned*)(F.lds + LDS_BARST));
    const int ph_lo = args.ph_lo, ph_hi = args.ph_hi;
    const int wave_s = __builtin_amdgcn_readfirstlane(threadIdx.x >> 6);
    for (int st = 2 * ph_lo; st < 2 * ph_hi; ++st) {
        const int ph = st >> 1, rep = st & 1;
        bool run = true;
        if (rep == 1) { const int ty = (ph == 0) ? 1 : (ph == NPH - 1) ? 2 : (int)((0x0804084020100804ull >> (8 * ((ph - 1) & 7))) & 255ull);
            run = (DUPMASK & ty) != 0; }
        if (run) {
        const __attribute__((address_space(4))) unsigned char* kp = (const __attribute__((address_space(4))) unsigned char*)__builtin_amdgcn_kernarg_segment_ptr();
        asm volatile("" : "+s"(kp));
        const __attribute__((address_space(4))) Args* ap = (const __attribute__((address_space(4))) Args*)kp;
        F.in = ap->in; F.out = ap->out; F.ws = ap->ws;
        { int t_ = wave_s * 64 + hw_lane_id(); asm volatile("" : "+v"(t_)); F.tid = t_; F.lane = t_ & 63; F.wave = wave_s; }
        unsigned char* ws = F.ws;
        float* SS = (float*)(ws + WS_SS);
        if ((PHMASK & 1) && ph == 0) p0_prologue(F);
        else if ((PHMASK & 2) && ph == NPH - 1) final_phase(F);
        else {
            const int l = (ph - 1) >> 3, s = (ph - 1) & 7;
            if ((PHMASK & 4) && (s == 0 || s == 6)) {
                pg8::Gemm g{(const bf16_t*)(ws + WS_XB), (const bf16_t*)(ws + (s == 0 ? WS_WGU1 : WS_WGU2)), MPAD, 2 * FF, D};
                pg8::StaticOrder S; S.init(MPAD, 2 * FF, D, F.G, (int)blockIdx.x);
                EpiGU E{(bf16_t*)(ws + WS_ACT), SS + (size_t)(s == 0 ? 3 * l : 3 * l + 2) * MPAD};
                pg8::gemm_phase<EpiGU, pg8::StaticOrder, true, true>(F.lds, g, S, E, wave_s);
            } else if ((PHMASK & 8) && (s == 1 || s == 7 || s == 5)) {
                const bool down = (s != 5);
                pg8::Gemm g{(const bf16_t*)(ws + (down ? WS_ACT : WS_YAB)), (const bf16_t*)(ws + (s == 1 ? WS_WD1 : (s == 7 ? WS_WD2 : WS_WOUT))), MPAD, D, down ? FF : D};
                pg8::DpSplit S; S.init(MPAD, D, down ? FF : D, F.G, (int)blockIdx.x, F.out);
                EpiRes E{(float*)(ws + WS_X), (bf16_t*)(ws + WS_XB), (rep ? (float*)(ws + 0x300000) : SS + (size_t)(s == 1 ? 3 * l + 1 : (s == 5 ? 3 * l + 2 : 3 * l + 3)) * MPAD), rep ? 0.0f : (down ? 0.5f : 1.0f)};
                pg8::gemm_phase<EpiRes, pg8::DpSplit, true, true>(F.lds, g, S, E, wave_s);
                if (blockIdx.x >= 80 && rep == 0) {
                    const int gw = ((int)blockIdx.x - 80) * NWAVES + F.wave, NGW = (F.G - 80) * NWAVES;
                    if (l == 0 && s == 1) { convert_mats(F, 0, 3, 5, gw, NGW); }
                    else if (l == 0 && s == 5) convert_mats(F, 0, 5, 6, gw, NGW);
                    else if (l == 0 && s == 7) convert_mats(F, 1, 2, 3, gw, NGW);
                    else if (l == 1 && s == 1) convert_mats(F, 1, 3, 5, gw, NGW);
                    else if (l == 1 && s == 5) convert_mats(F, 1, 5, 6, gw, NGW);
                }
                { XcdBarrier xb; xb.bar = (unsigned*)(ws + WS_BAR); xb.x = xb_xcc_id(); xb.st = (volatile LAS unsigned*)(F.lds + LDS_BARST); xcd_barrier(xb, wave_s == 0 && hw_lane_id() == 0); }
                res_fixup(F, E, S);
            } else if ((PHMASK & 16) && s == 2) {
                pg8::Gemm g{(const bf16_t*)(ws + WS_XB), (const bf16_t*)(ws + WS_WIN), MPAD, 2048, D};
                pg8::StaticOrder S; S.init(MPAD, 2048, D, F.G, (int)blockIdx.x);
                EpiWin E{(bf16_t*)(ws + WS_U), (bf16_t*)(ws + WS_BX), (bf16_t*)(ws + WS_GG), SS + (size_t)(3 * l + 1) * MPAD};
                pg8::gemm_phase<EpiWin, pg8::StaticOrder, true, true>(F.lds, g, S, E, wave_s);
                if (l == 0 && rep == 0 && blockIdx.x >= 40) {
                    convert_mats(F, 1, 0, 2, ((int)blockIdx.x - 40) * NWAVES + F.wave, (F.G - 40) * NWAVES);
                }
            } else if ((PHMASK & 32) && s == 3) mix_a_phase(F, l, rep ? MIXSEL : 3);
            else if ((PHMASK & 64) && s == 4) mix_c_phase(F, l, rep);
        }
        }
        if (rep == 1 && ph + 1 < ph_hi) {
            const __attribute__((address_space(4))) Args* ap2 = (const __attribute__((address_space(4))) Args*)__builtin_amdgcn_kernarg_segment_ptr();
            unsigned* barw = (unsigned*)(ap2->ws + WS_BAR);
            if (ph_hi > 1000) cg::this_grid().sync();
            XcdBarrier xb; xb.bar = barw; xb.x = xb_xcc_id(); xb.st = (volatile LAS unsigned*)(F.lds + LDS_BARST);
            xcd_barrier(xb, wave_s == 0 && hw_lane_id() == 0);
        }
    }
}

#ifndef MK_FUSED
#define MK_FUSED 1
#endif
extern "C" void kernel_launch(void* const* d_in, const int* in_sizes, int n_in, void* d_out, int out_size, void* d_ws, size_t ws_size, hipStream_t stream) {
    static int grid = 0;
    if (grid == 0) {
        if (n_in != N_IN || (size_t)out_size != O_END || ws_size < WS_END) { fprintf(stderr, "kernel_launch: unexpected shapes: n_in %d out %d ws %zu (need %zu)\n", n_in, out_size, ws_size, (size_t)WS_END); grid = -1; return; }
        int dev = 0, cus = 0, per_cu = 0;
        hipGetDevice(&dev); hipDeviceGetAttribute(&cus, hipDeviceAttributeMultiprocessorCount, dev);
        if (hipFuncSetAttribute((const void*)mega_fwd, hipFuncAttributeMaxDynamicSharedMemorySize, LDS_BYTES) != hipSuccess) { fprintf(stderr, "kernel_launch: hipFuncSetAttribute failed\n"); grid = -1; return; }
        if (hipOccupancyMaxActiveBlocksPerMultiprocessor(&per_cu, (const void*)mega_fwd, NWAVES * 64, LDS_BYTES) != hipSuccess || per_cu < 1) { fprintf(stderr, "kernel_launch: occupancy query failed (%d)\n", per_cu); (void)hipGetLastError(); per_cu = 1; }
        grid = cus * 1;
        fprintf(stderr, "kernel_launch: cus %d per_cu %d grid %d ws %zu\n", cus, per_cu, grid, ws_size);
    }
    if (grid < 0) return;
    Args a{};
    for (int i = 0; i < N_IN; ++i) a.in[i] = (const float*)d_in[i];
    a.out = (float*)d_out; a.ws = (unsigned char*)d_ws;
#if MK_FUSED
    a.ph_lo = 0; a.ph_hi = NPH;
    if (hipMemsetAsync((unsigned char*)d_ws + WS_BAR, 0, 0x10000, stream) != hipSuccess) { fprintf(stderr, "kernel_launch: memset of the barrier words failed\n"); return; }
    void* kargs[] = {&a};
    hipError_t e = hipLaunchCooperativeKernel((const void*)mega_fwd, dim3(grid), dim3(NWAVES * 64), kargs, LDS_BYTES, stream);
    if (e != hipSuccess) fprintf(stderr, "cooperative launch failed: %s (grid %d)\n", hipGetErrorString(e), grid);
#else
    for (int ph = 0; ph < NPH; ++ph) { a.ph_lo = ph; a.ph_hi = ph + 1; hipLaunchKernelGGL(mega_fwd, dim3(grid), dim3(NWAVES * 64), LDS_BYTES, stream, a); }
#endif
}
```
